# Optimizing an MI355X kernel written in HIP

```python
import jax, jax.numpy as jnp
from jax import lax
import numpy as np


D_MODEL = 1024
BATCH = 8
SEQ = 2048
DEPTH = 4

GRID_W = 64
CTX_LEN = 256
N_HEADS = 8
QK_NOPE = 64
QK_ROPE = 32
V_DIM = 64
Q_LORA = 256
KV_LORA = 128
ROPE_BASE = 10000.0
Q_BLOCK = 128
SGU_DIM = 256
SGU_HEADS = 4
CHUNK = 128
POOL_DIM = 256
POOL_WINDOWS = (2, 4, 8, 16)
N_POOL = len(POOL_WINDOWS)
POOL_GDIM = POOL_DIM // N_POOL
FOURIER_DIM = 256
FOURIER_HEADS = 4
ATTN_DIM = N_HEADS * V_DIM
MIX_DIM = ATTN_DIM + SGU_DIM + POOL_DIM + FOURIER_DIM
OFF_Q = 0
OFF_KV = OFF_Q + Q_LORA
OFF_KR = OFF_KV + KV_LORA
OFF_SGU = OFF_KR + QK_ROPE
OFF_POOL = OFF_SGU + 2 * SGU_DIM
OFF_FOURIER = OFF_POOL + POOL_DIM
IN_DIM = OFF_FOURIER + FOURIER_DIM
D_FF = ((8 * D_MODEL + 3 * 256 - 1) // (3 * 256)) * 256
LN_EPS = 1e-6
DEEPNORM_ALPHA = (2.0 * DEPTH) ** 0.25
DEEPNORM_BETA = (8.0 * DEPTH) ** -0.25

kernel_name = 'hybrid_parallel_mixer_dit'


def layer_norm(x, g, b):
    xf = x.astype(jnp.float32)
    mu = jnp.mean(xf, axis=-1, keepdims=True)
    var = jnp.mean(jnp.square(xf - mu), axis=-1, keepdims=True)
    return ((xf - mu) * lax.rsqrt(var + LN_EPS)).astype(x.dtype) * g + b


def rms_norm(x, g):
    xf = x.astype(jnp.float32)
    return (xf * lax.rsqrt(jnp.mean(jnp.square(xf), axis=-1, keepdims=True) + LN_EPS)).astype(x.dtype) * g


def axial_rope_angles(length):
    rows = length // GRID_W
    row = jnp.repeat(jnp.arange(rows), GRID_W).astype(jnp.float32)
    col = jnp.tile(jnp.arange(GRID_W), rows).astype(jnp.float32)
    n_freq = QK_ROPE // 4
    inv_freq = ROPE_BASE ** (-jnp.arange(n_freq, dtype=jnp.float32) / n_freq)
    return row[:, None] * inv_freq, col[:, None] * inv_freq


def rotate(x, ang):
    k = x.shape[-1] // 2
    x1, x2 = x[..., :k], x[..., k:]
    cos = jnp.cos(ang)[None, :, None, :].astype(x.dtype)
    sin = jnp.sin(ang)[None, :, None, :].astype(x.dtype)
    return jnp.concatenate([x1 * cos - x2 * sin, x1 * sin + x2 * cos], axis=-1)


def axial_rope(x, angles):
    ang_r, ang_c = angles
    half = x.shape[-1] // 2
    return jnp.concatenate([rotate(x[..., :half], ang_r), rotate(x[..., half:], ang_c)], axis=-1)


def mla_qkv(proj, q_norm, w_uq, kv_norm, w_uk, w_uv, angles):
    B, L, _ = proj.shape
    cq = rms_norm(proj[..., OFF_Q:OFF_KV], q_norm)
    ckv = rms_norm(proj[..., OFF_KV:OFF_KR], kv_norm)
    k_rope = proj[..., OFF_KR:OFF_SGU][:, :, None, :]
    q = (cq @ w_uq).reshape(B, L, N_HEADS, QK_NOPE + QK_ROPE)
    k_nope = (ckv @ w_uk).reshape(B, L, N_HEADS, QK_NOPE)
    v = (ckv @ w_uv).reshape(B, L, N_HEADS, V_DIM)
    q_nope, q_rope = q[..., :QK_NOPE], q[..., QK_NOPE:]
    if angles is not None:
        q_rope = axial_rope(q_rope, angles)
        k_rope = axial_rope(k_rope, angles)
    q = jnp.concatenate([q_nope, q_rope], axis=-1)
    k = jnp.concatenate([k_nope, jnp.broadcast_to(k_rope, (B, L, N_HEADS, QK_ROPE))], axis=-1)
    return q, k, v


def attend(q, k, v):
    s = jnp.einsum('bqhd,bkhd->bhqk', q, k).astype(jnp.float32) * (QK_NOPE + QK_ROPE) ** -0.5
    p = jax.nn.softmax(s, axis=-1).astype(v.dtype)
    return jnp.einsum('bhqk,bkhd->bqhd', p, v)


def blocked_attend(q, k, v):
    B, L, H, d = q.shape
    nb = L // Q_BLOCK
    qb = q.reshape(B, nb, Q_BLOCK, H, d).transpose(1, 0, 2, 3, 4)
    ob = lax.map(lambda qi: attend(qi, k, v), qb)
    return ob.transpose(1, 0, 2, 3, 4).reshape(B, L, H * V_DIM)


def spatial_gating(uv, g, b, w_s, b_s):
    B, L, _ = uv.shape
    u, v = uv[..., :SGU_DIM], uv[..., SGU_DIM:]
    v = layer_norm(v, g, b).reshape(B, L // CHUNK, CHUNK, SGU_HEADS, SGU_DIM // SGU_HEADS)
    mixed = jnp.einsum('gpq,bnqgc->bnpgc', w_s, v) + b_s.T[:, :, None]
    return u * mixed.reshape(B, L, SGU_DIM)


def multiscale_pool(p, w_pool, pool_scale):
    B, L, _ = p.shape
    cs = jnp.concatenate([jnp.zeros((B, 1, POOL_DIM), jnp.float32),
                          jnp.cumsum(p.astype(jnp.float32), axis=1)], axis=1)
    t = jnp.arange(L)
    outs = []
    for gi, w in enumerate(POOL_WINDOWS):
        lo = jnp.clip(t - w // 2, 0, L)
        hi = jnp.clip(t + w // 2, 0, L)
        seg = cs[:, :, gi * POOL_GDIM:(gi + 1) * POOL_GDIM]
        mean = (seg[:, hi] - seg[:, lo]) / (hi - lo).astype(jnp.float32)[None, :, None]
        tok = p[..., gi * POOL_GDIM:(gi + 1) * POOL_GDIM]
        outs.append((mean.astype(p.dtype) - tok) @ w_pool[gi])
    return jnp.concatenate(outs, axis=-1) * pool_scale


def fourier_mix(f, w_f):
    B, L, _ = f.shape
    fh = f.astype(jnp.float32).reshape(B, L, FOURIER_HEADS, FOURIER_DIM // FOURIER_HEADS)
    spec = jnp.fft.fft2(fh, axes=(1, 3), norm='ortho').real
    return spec.astype(f.dtype).reshape(B, L, FOURIER_DIM) @ w_f


def local_mixers(proj, sgu_g, sgu_b, w_s, b_s, w_pool, pool_scale, w_f):
    return jnp.concatenate([
        spatial_gating(proj[..., OFF_SGU:OFF_POOL], sgu_g, sgu_b, w_s, b_s),
        multiscale_pool(proj[..., OFF_POOL:OFF_FOURIER], w_pool, pool_scale),
        fourier_mix(proj[..., OFF_FOURIER:IN_DIM], w_f),
    ], axis=-1)


def residual_tail(x, mix, g1, sh2, sc2, g2, w_out, ln1g, ln1b, w1, w3, w2, ln2g, ln2b):
    x = layer_norm(DEEPNORM_ALPHA * x + g1 * (mix @ w_out), ln1g, ln1b)
    h = x * (1.0 + sc2) + sh2
    ffn = (jax.nn.silu(h @ w1) * (h @ w3)) @ w2
    return layer_norm(DEEPNORM_ALPHA * x + g2 * ffn, ln2g, ln2b)


def setup_inputs(seed: int = 0) -> dict:
    key = jax.random.key(seed)
    ks = jax.random.split(key, 32)
    f32 = jnp.float32

    def nrm(k, shape, scale):
        return jax.random.normal(k, shape, f32) * scale

    def gain(k, shape):
        return 1.0 + 0.02 * jax.random.normal(k, shape, f32)

    beta = DEEPNORM_BETA
    return {
        'x': nrm(ks[0], (BATCH, SEQ, D_MODEL), 1.0),
        'c': nrm(ks[1], (BATCH, D_MODEL), 1.0),
        'ctx': nrm(ks[2], (BATCH, CTX_LEN, D_MODEL), 1.0),
        'c_ctx': nrm(ks[3], (D_MODEL,), 1.0),
        'w_mod': nrm(ks[4], (DEPTH, D_MODEL, 6 * D_MODEL), 0.5 * D_MODEL ** -0.5),
        'b_mod': nrm(ks[5], (DEPTH, 6 * D_MODEL), 0.02),
        'w_in': nrm(ks[6], (DEPTH, D_MODEL, IN_DIM), D_MODEL ** -0.5),
        'q_norm': gain(ks[7], (DEPTH, Q_LORA)),
        'w_uq': nrm(ks[8], (DEPTH, Q_LORA, N_HEADS * (QK_NOPE + QK_ROPE)), Q_LORA ** -0.5),
        'kv_norm': gain(ks[9], (DEPTH, KV_LORA)),
        'w_uk': nrm(ks[10], (DEPTH, KV_LORA, N_HEADS * QK_NOPE), KV_LORA ** -0.5),
        'w_uv': nrm(ks[11], (DEPTH, KV_LORA, N_HEADS * V_DIM), KV_LORA ** -0.5),
        'sgu_ln_g': gain(ks[12], (DEPTH, SGU_DIM)),
        'sgu_ln_b': nrm(ks[13], (DEPTH, SGU_DIM), 0.02),
        'w_spatial': nrm(ks[14], (DEPTH, SGU_HEADS, CHUNK, CHUNK), CHUNK ** -0.5),
        'b_spatial': gain(ks[15], (DEPTH, SGU_HEADS, CHUNK)),
        'w_pool': nrm(ks[16], (DEPTH, N_POOL, POOL_GDIM, POOL_GDIM), POOL_GDIM ** -0.5),
        'pool_scale': gain(ks[17], (DEPTH, POOL_DIM)),
        'w_fourier': nrm(ks[18], (DEPTH, FOURIER_DIM, FOURIER_DIM), FOURIER_DIM ** -0.5),
        'w_out': nrm(ks[19], (DEPTH, MIX_DIM, D_MODEL), beta * MIX_DIM ** -0.5),
        'ln1_g': gain(ks[20], (DEPTH, D_MODEL)),
        'ln1_b': nrm(ks[21], (DEPTH, D_MODEL), 0.02),
        'w_ffn1': nrm(ks[22], (DEPTH, D_MODEL, D_FF), D_MODEL ** -0.5),
        'w_ffn3': nrm(ks[23], (DEPTH, D_MODEL, D_FF), D_MODEL ** -0.5),
        'w_ffn2': nrm(ks[24], (DEPTH, D_FF, D_MODEL), beta * D_FF ** -0.5),
        'ln2_g': gain(ks[25], (DEPTH, D_MODEL)),
        'ln2_b': nrm(ks[26], (DEPTH, D_MODEL), 0.02),
    }


def reference(x, c, ctx, c_ctx, w_mod, b_mod, w_in, q_norm, w_uq, kv_norm, w_uk, w_uv,
              sgu_ln_g, sgu_ln_b, w_spatial, b_spatial, w_pool, pool_scale, w_fourier,
              w_out, ln1_g, ln1_b, w_ffn1, w_ffn3, w_ffn2, ln2_g, ln2_b):
    B, L, _ = x.shape
    angles = axial_rope_angles(L)
    silu_c = jax.nn.silu(c)
    silu_cc = jax.nn.silu(c_ctx)
    x_ctx = ctx
    for l in range(DEPTH):
        last = l == DEPTH - 1
        mod = silu_c @ w_mod[l] + b_mod[l]
        sh1, sc1, g1, sh2, sc2, g2 = [m[:, None, :] for m in jnp.split(mod, 6, axis=-1)]
        mod_c = silu_cc @ w_mod[l] + b_mod[l]
        sh1c, sc1c, g1c, sh2c, sc2c, g2c = jnp.split(mod_c, 6, axis=-1)

        h = x * (1.0 + sc1) + sh1
        h_c = x_ctx * (1.0 + sc1c) + sh1c
        proj = h @ w_in[l]
        proj_c = h_c @ w_in[l]

        q, k, v = mla_qkv(proj, q_norm[l], w_uq[l], kv_norm[l], w_uk[l], w_uv[l], angles)
        q_c, k_c, v_c = mla_qkv(proj_c, q_norm[l], w_uq[l], kv_norm[l], w_uk[l], w_uv[l], None)

        attn = blocked_attend(q, jnp.concatenate([k_c, k], axis=1), jnp.concatenate([v_c, v], axis=1))
        mix = jnp.concatenate([attn, local_mixers(proj, sgu_ln_g[l], sgu_ln_b[l], w_spatial[l], b_spatial[l],
                                                  w_pool[l], pool_scale[l], w_fourier[l])], axis=-1)
        x_new = residual_tail(x, mix, g1, sh2, sc2, g2, w_out[l], ln1_g[l], ln1_b[l],
                              w_ffn1[l], w_ffn3[l], w_ffn2[l], ln2_g[l], ln2_b[l])

        if not last:
            attn_c = attend(q_c, k_c, v_c).reshape(B, x_ctx.shape[1], ATTN_DIM)
            mix_c = jnp.concatenate([attn_c, local_mixers(proj_c, sgu_ln_g[l], sgu_ln_b[l], w_spatial[l],
                                                          b_spatial[l], w_pool[l], pool_scale[l],
                                                          w_fourier[l])], axis=-1)
            x_ctx = residual_tail(x_ctx, mix_c, g1c, sh2c, sc2c, g2c, w_out[l], ln1_g[l], ln1_b[l],
                                  w_ffn1[l], w_ffn3[l], w_ffn2[l], ln2_g[l], ln2_b[l])
        x = x_new
    return x
```

```cpp
#include <hip/hip_runtime.h>
#include <hip/hip_cooperative_groups.h>
#include <cstdio>
#include <cstdint>
namespace cg = cooperative_groups;
__device__ __forceinline__ int otid() { int t = threadIdx.x; asm volatile("" : "+v"(t)); return t; }
namespace pg8 {
#define PG8_LAS __attribute__((address_space(3)))
typedef unsigned short bf16_t;
typedef short bf16x8 __attribute__((ext_vector_type(8)));
typedef float f32x4 __attribute__((ext_vector_type(4)));
typedef unsigned u32x4 __attribute__((ext_vector_type(4)));
constexpr int BM = 256, BK = 64, HALF = 128, HTB = HALF * BK * 2  , STAGE_BYTES = 8 * HTB, NXCD = 8, WGM = 8;

__host__ __device__ __forceinline__ int lds_byte(int r, int c) { const int st = (r >> 4) * 2 + (c >> 5), rr = r & 15, cc = c & 31, ob = rr * 64 + cc * 2; return st * 1024 + (ob ^ (((ob >> 9) & 1) << 5)); }
__host__ __device__ __forceinline__ void stage_rc(int b, int& R, int& C) { const int st = b / 1024, sb = b % 1024, swz = sb ^ (((sb >> 9) & 1) << 5); R = (st >> 1) * 16 + swz / 64; C = (st & 1) * 32 + (swz % 64) / 2; }
__host__ __device__ __forceinline__ int perm32(int rho) { const int n = rho >> 4, i = rho & 15; return 8 * (i >> 2) + 4 * n + (i & 3); }

struct Unit { int pm, pn; };
struct Gemm { const bf16_t* A; const bf16_t* Bt; int M, N; };

struct StaticOrder {
    int nM, nN, nwg, G, c;
    __host__ __device__ void init(int M, int N, int G_, int c_) { nM = M / BM; nN = N / BM; nwg = nM * nN; G = G_; c = c_; }
    __host__ __device__ bool next(int i, Unit& u) const {
        const long L = (long)i * G + c; if (L >= nwg) return false;
        int wgid = (int)L; { const int q = nwg / NXCD, r = nwg % NXCD, xcd = wgid % NXCD, off = wgid / NXCD; wgid = (xcd < r ? xcd * (q + 1) : r * (q + 1) + (xcd - r) * q) + off; }
        const int nig = WGM * nN, gid = wgid / nig, fm = gid * WGM, gsz = (nM - fm) < WGM ? (nM - fm) : WGM;
        u.pm = fm + ((wgid % nig) % gsz); u.pn = (wgid % nig) / gsz; return true;
    }
    __device__ __forceinline__ void a_ready(const Unit&) const {}
    __device__ __forceinline__ void done(const Unit&) const {}
};


template <class Epi, class Sched, bool ALIGN_EPI, bool SP2, int LDA, int LDB, int KDIM>
__device__ __forceinline__ void gemm_phase(PG8_LAS unsigned char* lds, const Gemm g, const Sched& S, const Epi& E) {
    const int tid = otid(), wid = __builtin_amdgcn_readfirstlane(tid >> 6), lane = tid & 63, wr = wid >> 2, wc = wid & 3, fr = lane & 15, fq = lane >> 4;
    constexpr int K = KDIM, nt = K / BK;
    unsigned voffA[2], voffB[2];
#pragma unroll
    for (int i = 0; i < 2; ++i) { int R, C; stage_rc(tid * 16 + i * 8192, R, C); const int Rb = Epi::PERM ? ((R & ~31) + perm32(R & 31)) : R;
        voffA[i] = (unsigned)(R * LDA + C) * 2u; voffB[i] = (unsigned)(Rb * LDB + C) * 2u; }
    constexpr size_t kstep = (size_t)(BK * 2);
    constexpr size_t hstepA = (size_t)HALF * LDA * 2, hstepB = (size_t)HALF * LDB * 2;
    constexpr size_t tstepA = 2 * hstepA, tstepB = 2 * hstepB;
    const unsigned ldsw = (unsigned)wid * 1024u;
    const int aoff = lds_byte(wr * 64 + fr, fq * 8), boff = lds_byte(wc * 32 + fr, fq * 8);
#define PG8_SA(b, h) (((b) * 2 + (h)) * HTB)
#define PG8_SB(b, h) ((4 + (b) * 2 + (h)) * HTB)
#define PG8_STAGE(bufoff, gbase, voff) do { _Pragma("unroll") for (int _i = 0; _i < 2; ++_i) \
        __builtin_amdgcn_global_load_lds((const unsigned*)((const char*)(gbase) + (voff)[_i]), (PG8_LAS unsigned*)(lds + (bufoff) + ldsw + _i * 8192), 16, 0, 0); } while (0)
#define PG8_LDA(dst, b, h) do { _Pragma("unroll") for (int m = 0; m < 4; ++m) _Pragma("unroll") for (int k = 0; k < 2; ++k) dst[m][k] = *(const PG8_LAS bf16x8*)(lds + PG8_SA(b, h) + aoff + m * 2048 + k * 1024); } while (0)
#define PG8_LDB(dst, b, h) do { _Pragma("unroll") for (int n = 0; n < 2; ++n) _Pragma("unroll") for (int k = 0; k < 2; ++k) dst[n][k] = *(const PG8_LAS bf16x8*)(lds + PG8_SB(b, h) + boff + n * 2048 + k * 1024); } while (0)
#define PG8_MMA(ai, bj, At, Bt) do { __builtin_amdgcn_s_setprio(1); _Pragma("unroll") for (int m = 0; m < 4; ++m) _Pragma("unroll") for (int n = 0; n < 2; ++n) _Pragma("unroll") for (int k = 0; k < 2; ++k) \
        acc[ai][bj][m][n] = __builtin_amdgcn_mfma_f32_16x16x32_bf16(Bt[n][k], At[m][k], acc[ai][bj][m][n], 0, 0, 0); __builtin_amdgcn_s_setprio(0); } while (0)
#define PG8_WAIT_V(n) asm volatile("s_waitcnt vmcnt(" #n ")" ::: "memory")
#define PG8_WAIT_L(n) asm volatile("s_waitcnt lgkmcnt(" #n ")" ::: "memory")
#define PG8_BAR __builtin_amdgcn_s_barrier()
#define PG8_SCHED __builtin_amdgcn_sched_barrier(0)
    Unit cur, nxt; int ui = 0;
    if (!S.next(0, cur)) return;
    float zf = 0.f; asm volatile("" : "+v"(zf));
    f32x4 acc[2][2][4][2];
#pragma unroll
    for (int a = 0; a < 2; ++a)
#pragma unroll
        for (int b = 0; b < 2; ++b)
#pragma unroll
            for (int m = 0; m < 4; ++m)
#pragma unroll
                for (int n = 0; n < 2; ++n) acc[a][b][m][n] = (f32x4){zf, zf, zf, zf};
    bf16x8 At[4][2], B0[2][2], B1[2][2];
    const char* cA = (const char*)g.A + (size_t)cur.pm * tstepA; const char* cB = (const char*)g.Bt + (size_t)cur.pn * tstepB;
    S.a_ready(cur);
    if constexpr (SP2) {
        PG8_STAGE(PG8_SB(0, 0), cB, voffB); PG8_STAGE(PG8_SB(0, 1), cB + hstepB, voffB); PG8_STAGE(PG8_SA(0, 0), cA, voffA); PG8_STAGE(PG8_SA(0, 1), cA + hstepA, voffA);
        if (wr == 1) PG8_BAR;
        PG8_WAIT_V(2); PG8_BAR;
        PG8_STAGE(PG8_SB(1, 0), cB + kstep, voffB); PG8_STAGE(PG8_SA(1, 0), cA + kstep, voffA); PG8_STAGE(PG8_SB(1, 1), cB + hstepB + kstep, voffB);
        PG8_WAIT_V(6); PG8_BAR;
    } else {
        PG8_STAGE(PG8_SB(0, 0), cB, voffB); PG8_STAGE(PG8_SA(0, 0), cA, voffA); PG8_STAGE(PG8_SB(0, 1), cB + hstepB, voffB); PG8_STAGE(PG8_SA(0, 1), cA + hstepA, voffA);
        if (wr == 1) PG8_BAR;
        PG8_WAIT_V(4); PG8_BAR;
        PG8_STAGE(PG8_SB(1, 0), cB + kstep, voffB); PG8_STAGE(PG8_SA(1, 0), cA + kstep, voffA); PG8_STAGE(PG8_SB(1, 1), cB + hstepB + kstep, voffB);
        PG8_WAIT_V(6); PG8_BAR;
    }
    for (;;) {
        const bool has_next = S.next(ui + 1, nxt);
        const char* nA = has_next ? (const char*)g.A + (size_t)nxt.pm * tstepA : cA; const char* nB = has_next ? (const char*)g.Bt + (size_t)nxt.pn * tstepB : cB;
#pragma nounroll
        for (int t = 0; t < nt; t += 2) {
            const bool last = (t == nt - 2);
            const char* a1 = cA + (size_t)(t + 1) * kstep;
            const char* a2 = last ? nA : cA + (size_t)(t + 2) * kstep; const char* b2 = last ? nB : cB + (size_t)(t + 2) * kstep;
            const char* a3 = a2 + kstep; const char* b3 = b2 + kstep;
            if (last && has_next) S.a_ready(nxt);
            if constexpr (SP2) {
            PG8_LDB(B0, 0, 0); PG8_LDB(B1, 0, 1); PG8_SCHED; PG8_LDA(At, 0, 0); PG8_STAGE(PG8_SA(1, 1), a1 + hstepA, voffA);
            PG8_WAIT_V(8); PG8_WAIT_L(0); PG8_BAR; PG8_MMA(0, 0, At, B0); PG8_MMA(0, 1, At, B1); PG8_BAR; PG8_SCHED;
            PG8_LDA(At, 0, 1); PG8_STAGE(PG8_SB(0, 0), b2, voffB); PG8_STAGE(PG8_SB(0, 1), b2 + hstepB, voffB); PG8_STAGE(PG8_SA(0, 0), a2, voffA);
            PG8_WAIT_V(8); PG8_WAIT_L(0); PG8_BAR; PG8_MMA(1, 0, At, B0); PG8_MMA(1, 1, At, B1); PG8_BAR; PG8_SCHED;
            PG8_LDB(B0, 1, 0); PG8_LDB(B1, 1, 1); PG8_SCHED; PG8_LDA(At, 1, 0); PG8_STAGE(PG8_SA(0, 1), a2 + hstepA, voffA);
            PG8_WAIT_V(8); PG8_WAIT_L(0); PG8_BAR; PG8_MMA(0, 0, At, B0); PG8_MMA(0, 1, At, B1); PG8_BAR; PG8_SCHED;
            PG8_LDA(At, 1, 1); PG8_STAGE(PG8_SB(1, 0), b3, voffB); PG8_STAGE(PG8_SB(1, 1), b3 + hstepB, voffB); PG8_STAGE(PG8_SA(1, 0), a3, voffA);
            PG8_WAIT_V(8); PG8_WAIT_L(0); PG8_BAR; PG8_MMA(1, 0, At, B0); PG8_MMA(1, 1, At, B1); PG8_BAR; PG8_SCHED;
            } else {
            PG8_LDB(B0, 0, 0); PG8_SCHED; PG8_LDA(At, 0, 0); PG8_STAGE(PG8_SA(1, 1), a1 + hstepA, voffA);
            PG8_WAIT_L(8); PG8_BAR; PG8_WAIT_L(0); PG8_MMA(0, 0, At, B0); PG8_BAR; PG8_SCHED;
            PG8_LDB(B1, 0, 1); PG8_STAGE(PG8_SB(0, 0), b2, voffB);
            PG8_BAR; PG8_WAIT_L(0); PG8_MMA(0, 1, At, B1); PG8_BAR;
            PG8_LDA(At, 0, 1); PG8_STAGE(PG8_SA(0, 0), a2, voffA);
            PG8_BAR; PG8_WAIT_L(0); PG8_MMA(1, 0, At, B0); PG8_BAR; PG8_SCHED;
            PG8_STAGE(PG8_SB(0, 1), b2 + hstepB, voffB);
            PG8_WAIT_V(6); PG8_BAR; PG8_MMA(1, 1, At, B1); PG8_BAR;
            PG8_LDB(B0, 1, 0); PG8_SCHED; PG8_LDA(At, 1, 0); PG8_STAGE(PG8_SA(0, 1), a2 + hstepA, voffA);
            PG8_WAIT_L(8); PG8_BAR; PG8_WAIT_L(0); PG8_MMA(0, 0, At, B0); PG8_BAR; PG8_SCHED;
            PG8_LDB(B1, 1, 1); PG8_STAGE(PG8_SB(1, 0), b3, voffB);
            PG8_BAR; PG8_WAIT_L(0); PG8_MMA(0, 1, At, B1); PG8_BAR;
            PG8_LDA(At, 1, 1); PG8_STAGE(PG8_SA(1, 0), a3, voffA);
            PG8_BAR; PG8_WAIT_L(0); PG8_MMA(1, 0, At, B0); PG8_BAR; PG8_SCHED;
            PG8_STAGE(PG8_SB(1, 1), b3 + hstepB, voffB);
            PG8_WAIT_V(6); PG8_BAR; PG8_MMA(1, 1, At, B1); PG8_BAR;
            }
        }
        if constexpr (ALIGN_EPI) { if (wr == 0) PG8_BAR; }
        if constexpr (!Epi::AFTER_DRAIN) { int fr2 = fr, fq2 = fq; asm volatile("" : "+v"(fr2), "+v"(fq2));
            E(acc, cur, wr, wc, fr2, fq2); S.done(cur); }
        if (!has_next) break;
#pragma unroll
        for (int a = 0; a < 2; ++a)
#pragma unroll
            for (int b = 0; b < 2; ++b)
#pragma unroll
                for (int m = 0; m < 4; ++m)
#pragma unroll
                    for (int n = 0; n < 2; ++n) acc[a][b][m][n] = (f32x4){zf, zf, zf, zf};
        cur = nxt; cA = nA; cB = nB; ++ui;
        if constexpr (ALIGN_EPI) { if (wr == 1) PG8_BAR; }
    }
    PG8_WAIT_V(0);
    if constexpr (!ALIGN_EPI) { if (wr == 0) PG8_BAR; }
    PG8_BAR;
    if constexpr (Epi::AFTER_DRAIN) { E.fused(acc, cur, wr, wc, fr, fq, lds, wid, lane); S.done(cur); }
#undef PG8_SA
#undef PG8_SB
#undef PG8_STAGE
#undef PG8_LDA
#undef PG8_LDB
#undef PG8_MMA
#undef PG8_WAIT_V
#undef PG8_WAIT_L
#undef PG8_BAR
#undef PG8_SCHED
}
}

#define LAS __attribute__((address_space(3)))
typedef unsigned short bf16;
typedef float f32x2 __attribute__((ext_vector_type(2)));
typedef float f32x4 __attribute__((ext_vector_type(4)));
typedef float f32x16 __attribute__((ext_vector_type(16)));
typedef short bf16x8 __attribute__((ext_vector_type(8)));
typedef unsigned u32x4 __attribute__((ext_vector_type(4)));
typedef unsigned u32x2 __attribute__((ext_vector_type(2)));
typedef __bf16 bf16x2_t __attribute__((ext_vector_type(2)));
#define DI __device__ __forceinline__

DI unsigned pk2(float lo, float hi) { f32x2 v = {lo, hi}; bf16x2_t b = __builtin_convertvector(v, bf16x2_t); return __builtin_bit_cast(unsigned, b); }
DI float bflo(unsigned u) { return __uint_as_float(u << 16); }
DI float bfhi(unsigned u) { return __uint_as_float(u & 0xffff0000u); }
DI u32x4 pack8(f32x4 a, f32x4 b) { u32x4 w; w.x = pk2(a[0], a[1]); w.y = pk2(a[2], a[3]); w.z = pk2(b[0], b[1]); w.w = pk2(b[2], b[3]); return w; }
DI float shx(float v, int m) { const int l = (otid() & 63) ^ m; return __builtin_bit_cast(float, __builtin_amdgcn_ds_bpermute(l << 2, __builtin_bit_cast(int, v))); }
DI float wave_sum(float v) {
#pragma unroll
    for (int o = 1; o < 64; o <<= 1) v += shx(v, o);
    return v;
}
DI float ozero() { float z = 0.f; asm volatile("" : "+v"(z)); return z; }
DI float cos_turn(float t) { return __builtin_amdgcn_cosf(t); }
DI float sin_turn(float t) { return __builtin_amdgcn_sinf(t); }
DI float fexp2(float x) { return __builtin_amdgcn_exp2f(x); }
DI float frcp(float x) { return __builtin_amdgcn_rcpf(x); }
#define LDS_WAIT() asm volatile("s_waitcnt lgkmcnt(0)" ::: "memory")

constexpr int DM = 1024, NB = 8, SEQ = 2048, DEPTH = 4, CTXL = 256;
constexpr int NLAT = NB * SEQ, NCTX = NB * CTXL, MTOK = NLAT + NCTX;
constexpr int NPROJ = 1536, DFF = 2816, MIXD = 1280, NKEY = SEQ + CTXL;
constexpr int PO_KR = 384, PO_SU = 416, PO_SV = 672, PO_POOL = 928, PO_F = 1184, IN_DIM = 1440;
constexpr float LN_EPS = 1e-6f;
constexpr float ALPHA = 1.6817928305074290f;
constexpr float QSCALE = 0.10206207261596575f * 1.4426950408889634f;

constexpr size_t WS_XRES = 0;
constexpr size_t WS_HA   = WS_XRES + (size_t)MTOK * DM * 4;
constexpr size_t WS_PROJ = WS_HA + (size_t)MTOK * DM * 2;
constexpr size_t WS_QLAT = WS_PROJ + (size_t)MTOK * NPROJ * 2;
constexpr size_t WS_QCTX = WS_QLAT + (size_t)64 * SEQ * 96 * 2;
constexpr size_t WS_K    = WS_QCTX + (size_t)64 * CTXL * 96 * 2;
constexpr size_t WS_VT   = WS_K + (size_t)64 * NKEY * 96 * 2;
constexpr size_t WS_U    = WS_PROJ;
static_assert((size_t)MTOK * DFF * 2 <= WS_VT - WS_PROJ, "U overlay");
constexpr size_t WS_GTL  = WS_VT + (size_t)64 * 64 * NKEY * 2;
constexpr size_t WS_GTC  = WS_GTL + (size_t)2048 * 4096 * 2;
constexpr size_t WS_MIX  = WS_GTC + (size_t)2048 * 512 * 2;
constexpr size_t WS_WIN  = WS_MIX + (size_t)MTOK * MIXD * 2;
constexpr size_t WS_WQK  = WS_WIN + (size_t)1536 * 1024 * 2;
constexpr size_t WS_WV   = WS_WQK + (size_t)1280 * 384 * 2;
constexpr size_t WS_WF   = WS_WV + (size_t)512 * 384 * 2;
constexpr size_t WS_WOUT = WS_WF + (size_t)512 * 256 * 2;
constexpr size_t WS_W13  = WS_WOUT + (size_t)1024 * 1280 * 2;
constexpr size_t WS_W2   = WS_W13 + (size_t)5632 * 1024 * 2;
constexpr size_t WS_WPOOL= WS_W2 + (size_t)1024 * 2816 * 2;
constexpr size_t WS_WS   = WS_WPOOL + (size_t)4 * 64 * 64 * 2;
constexpr size_t WS_CSL  = WS_WS + (size_t)4 * 128 * 128 * 2;
constexpr size_t WS_CSC  = WS_CSL + (size_t)2048 * 4096 * 2;
constexpr size_t WS_MOD  = WS_CSC + (size_t)256 * 512 * 2;
constexpr size_t WS_ROPE = WS_MOD + (size_t)4 * 9 * 6144 * 4;
constexpr size_t WS_STQ  = WS_ROPE + (size_t)2048 * 32 * 4;
constexpr size_t WS_STKV = WS_STQ + (size_t)MTOK * 4 * 4;
constexpr size_t WS_ST   = WS_STKV + (size_t)MTOK * 4 * 4;
constexpr size_t WS_CTL  = WS_ST + (size_t)MTOK * 2 * 4;
constexpr size_t CTL_BYTES = 16384;
constexpr size_t WS_END  = WS_CTL + CTL_BYTES;
constexpr int MISC_OFF = 139264;

constexpr int LDS_BYTES = 147456;

struct Params { const float* in[27]; float* out; unsigned char* ws; int ph_lo, ph_hi; };
DI const float* inp(const Params& p, int i) { asm volatile("" : "+s"(i)); return p.in[i]; }
DI unsigned char* wsp(const Params& p) { unsigned char* w = p.ws; asm volatile("" : "+s"(w)); return w; }

#define XB_TMO      128
#define XB_XCNT(j)  (256  + 64 * (j))
#define XB_XSUB(j)  (1280 + 64 * (j))
#define XB_XGEN(j)  (2304 + 64 * (j))
#define XB_TOP      3328
#define XB_TOPGEN   3392
#define XCD_BAR_WORDS 3456
#define XB_SPIN_CAP (1u << 18)

__device__ __forceinline__ unsigned xb_ld(unsigned* p)              { return __hip_atomic_load(p, __ATOMIC_RELAXED, __HIP_MEMORY_SCOPE_AGENT); }
__device__ __forceinline__ unsigned xb_add(unsigned* p, unsigned v) { return __hip_atomic_fetch_add(p, v, __ATOMIC_RELAXED, __HIP_MEMORY_SCOPE_AGENT); }
__device__ __forceinline__ unsigned xb_xcc_id() { return (unsigned)__builtin_amdgcn_s_getreg((3 << 11) | 20) & 0xFu; }
#define XB_SPIN(cond, bar) do { unsigned _sp = 0; while (cond) { __builtin_amdgcn_s_sleep(1); \
    if ((++_sp & 255u) == 0u) { if (xb_ld(&(bar)[XB_TMO])) break; if (_sp > XB_SPIN_CAP) { atomicAdd(&(bar)[XB_TMO], 1u); break; } } } } while (0)

struct XcdBarrier {
    unsigned* bar; unsigned x;
    volatile LAS unsigned* st;
};

__device__ __forceinline__ XcdBarrier xcd_barrier_post(unsigned* bar, volatile LAS unsigned* st) {
    XcdBarrier b; b.bar = bar; b.x = xb_xcc_id(); b.st = st;
    if (threadIdx.x == 0) (void)xb_add(&bar[XB_XCNT(b.x)], 1u);
    return b;
}
__device__ __forceinline__ void xcd_barrier_complete(unsigned* bar, unsigned x, unsigned& nloc, unsigned& nx) {
    const unsigned G = gridDim.x * gridDim.y * gridDim.z;
    unsigned sum, cnt, mine, sp = 0u;
    for (;;) {
        sum = 0u; cnt = 0u; mine = 0u;
#pragma unroll
        for (unsigned j = 0; j < 16; ++j) { const unsigned c = xb_ld(&bar[XB_XCNT(j)]); sum += c; cnt += (c > 0u) ? 1u : 0u; mine = (j == x) ? c : mine; }
        if (sum == G) break;
        __builtin_amdgcn_s_sleep(1);
        if ((++sp & 255u) == 0u) { if (xb_ld(&bar[XB_TMO])) break; if (sp > XB_SPIN_CAP) { atomicAdd(&bar[XB_TMO], 1u); break; } }
    }
    nloc = mine > 0u ? mine : 1u; nx = cnt > 0u ? cnt : 1u;
}

__device__ __forceinline__ void xcd_barrier(const XcdBarrier& b) {
    asm volatile("s_waitcnt vmcnt(0)" ::: "memory");
    __syncthreads();
    if (threadIdx.x == 0) {
        unsigned* bar = b.bar;
        __builtin_amdgcn_s_waitcnt(0);
        unsigned nloc = b.st[0], nx = b.st[1];
        if (nloc == 0u) { xcd_barrier_complete(bar, b.x, nloc, nx); b.st[0] = nloc; b.st[1] = nx; }
        const unsigned old = xb_add(&bar[XB_XSUB(b.x)], 1u);
        const unsigned gen = old / nloc;
        if (old + 1u == (gen + 1u) * nloc) {
            __builtin_amdgcn_fence(__ATOMIC_RELEASE, "agent");
            asm volatile("s_waitcnt vmcnt(0)" ::: "memory");
            const unsigned og = xb_add(&bar[XB_TOP], 1u);
            const unsigned tg = og / nx;
            if (og + 1u == (tg + 1u) * nx) xb_add(&bar[XB_TOPGEN], 1u);
            else XB_SPIN(xb_ld(&bar[XB_TOPGEN]) == tg, bar);
            __builtin_amdgcn_fence(__ATOMIC_ACQUIRE, "agent");
            xb_add(&bar[XB_XGEN(b.x)], 1u);
            asm volatile("s_waitcnt vmcnt(0)" ::: "memory");
        } else {
            XB_SPIN(xb_ld(&bar[XB_XGEN(b.x)]) == gen, bar);
            __builtin_amdgcn_fence(__ATOMIC_ACQUIRE, "agent");
            asm volatile("s_waitcnt vmcnt(0)" ::: "memory");
        }
    }
    __syncthreads();
}

typedef pg8::f32x4 A4;
DI void row_info(int row, int& b, int& pos, bool& lat) { lat = row < NLAT; if (lat) { b = row >> 11; pos = row & 2047; } else { b = (row - NLAT) >> 8; pos = (row - NLAT) & 255; } }

struct EpiProj {
    static constexpr bool PERM = true, AFTER_DRAIN = false;
    bf16* O; float* statq; float* statkv;
    DI void operator()(const A4 (&acc)[2][2][4][2], const pg8::Unit& u, int wr, int wc, int fr, int fq) const {
        const int row0 = u.pm * 256 + wr * 64 + fr, col0 = u.pn * 256 + wc * 32 + 8 * fq;
#pragma unroll
        for (int ai = 0; ai < 2; ++ai)
#pragma unroll
            for (int m = 0; m < 4; ++m) {
                const int row = row0 + ai * 128 + m * 16;
                bf16* rowp = O + (size_t)row * NPROJ + col0;
#pragma unroll
                for (int bj = 0; bj < 2; ++bj) *(u32x4*)(rowp + bj * 128) = pack8(acc[ai][bj][m][0], acc[ai][bj][m][1]);
                if (u.pn <= 1) {
                    float s = 0.f;
#pragma unroll
                    for (int bj = 0; bj < 2; ++bj) {
                        if (u.pn == 1 && bj == 1) continue;
#pragma unroll
                        for (int n = 0; n < 2; ++n) { const A4 x = acc[ai][bj][m][n]; s += (x[0] * x[0] + x[1] * x[1]) + (x[2] * x[2] + x[3] * x[3]); }
                    }
                    s += shx(s, 16); s += shx(s, 32);
                    if (fq == 0) { if (u.pn == 0) statq[row * 4 + wc] = s; else statkv[row * 4 + wc] = s; }
                }
            }
    }
};

struct EpiQK {
    static constexpr bool PERM = true, AFTER_DRAIN = false;
    bf16* Ql; bf16* Qc; bf16* Kb; const float* statq; const float* statkv; const float* rope;
    DI void operator()(const A4 (&acc)[2][2][4][2], const pg8::Unit& u, int wr, int wc, int fr, int fq) const {
        const int row0 = u.pm * 256 + wr * 64 + fr, col0 = u.pn * 256 + wc * 32 + 8 * fq;
        const bool isq = u.pn < 3;
#pragma unroll
        for (int ai = 0; ai < 2; ++ai)
#pragma unroll
            for (int m = 0; m < 4; ++m) {
                const int row = row0 + ai * 128 + m * 16;
                int b, pos; bool lat; row_info(row, b, pos, lat);
                const f32x4 st = *(const f32x4*)((isq ? statq : statkv) + row * 4);
                const float ss = (st[0] + st[1]) + (st[2] + st[3]);
                const float rs = isq ? rsqrtf(ss * (1.f / 256.f) + LN_EPS) * QSCALE : rsqrtf(ss * (1.f / 128.f) + LN_EPS);
#pragma unroll
                for (int bj = 0; bj < 2; ++bj) {
                    const int c = col0 + bj * 128;
                    A4 v0 = acc[ai][bj][m][0] * rs, v1 = acc[ai][bj][m][1] * rs;
                    if (isq) {
                        const int g32 = c >> 5, head = g32 / 3, part = g32 - head * 3, d0 = part * 32 + 8 * fq;
                        if (part == 2 && lat) {
                            A4 p0, p1;
#pragma unroll
                            for (int j = 0; j < 4; ++j) { p0[j] = shx(v0[j], 16); p1[j] = shx(v1[j], 16); }
                            const float* rp = rope + pos * 32 + (fq >> 1) * 8;
                            const f32x4 c0 = *(const f32x4*)rp, c1 = *(const f32x4*)(rp + 4), s0 = *(const f32x4*)(rp + 16), s1 = *(const f32x4*)(rp + 20);
                            if (fq & 1) { v0 = p0 * s0 + v0 * c0; v1 = p1 * s1 + v1 * c1; }
                            else        { v0 = v0 * c0 - p0 * s0; v1 = v1 * c1 - p1 * s1; }
                        }
                        bf16* dst = lat ? Ql + ((size_t)(b * 8 + head) * SEQ + pos) * 96 + d0 : Qc + ((size_t)(b * 8 + head) * CTXL + pos) * 96 + d0;
                        *(u32x4*)dst = pack8(v0, v1);
                    } else {
                        const int cc = c - 768, head = cc >> 6, d0 = cc & 63;
                        bf16* dst = Kb + ((size_t)(b * 8 + head) * NKEY + (lat ? CTXL + pos : pos)) * 96 + d0;
                        *(u32x4*)dst = pack8(v0, v1);
                    }
                }
            }
    }
};

DI float rstd_kv_tok(const float* statkv, int t) { const f32x4 st = *(const f32x4*)(statkv + t * 4); return rsqrtf(((st[0] + st[1]) + (st[2] + st[3])) * (1.f / 128.f) + LN_EPS); }

struct EpiVt {
    static constexpr bool PERM = true, AFTER_DRAIN = false;
    bf16* Vt; const float* statkv;
    DI void operator()(const A4 (&acc)[2][2][4][2], const pg8::Unit& u, int wr, int wc, int fr, int fq) const {
        const int row0 = u.pm * 256 + wr * 64 + fr, col0 = u.pn * 256 + wc * 32 + 8 * fq;
#pragma unroll
        for (int bj = 0; bj < 2; ++bj) {
            const int t0 = col0 + bj * 128;
            int b, pos; bool lat; row_info(t0, b, pos, lat);
            A4 r0, r1;
#pragma unroll
            for (int j = 0; j < 4; ++j) { r0[j] = rstd_kv_tok(statkv, t0 + j); r1[j] = rstd_kv_tok(statkv, t0 + 4 + j); }
#pragma unroll
            for (int ai = 0; ai < 2; ++ai)
#pragma unroll
                for (int m = 0; m < 4; ++m) {
                    const int row = row0 + ai * 128 + m * 16, head = row >> 6, dv = row & 63;
                    bf16* dst = Vt + ((size_t)(b * 8 + head) * 64 + dv) * NKEY + (lat ? CTXL + pos : pos);
                    *(u32x4*)dst = pack8(acc[ai][bj][m][0] * r0, acc[ai][bj][m][1] * r1);
                }
        }
    }
};

struct EpiGt {
    static constexpr bool PERM = true, AFTER_DRAIN = false;
    bf16* Gl; bf16* Gc;
    DI void operator()(const A4 (&acc)[2][2][4][2], const pg8::Unit& u, int wr, int wc, int fr, int fq) const {
        const int row0 = u.pm * 256 + wr * 64 + fr, col0 = u.pn * 256 + wc * 32 + 8 * fq;
#pragma unroll
        for (int bj = 0; bj < 2; ++bj) {
            const int t0 = col0 + bj * 128;
            int b, pos; bool lat; row_info(t0, b, pos, lat);
#pragma unroll
            for (int ai = 0; ai < 2; ++ai)
#pragma unroll
                for (int m = 0; m < 4; ++m) {
                    const int row = row0 + ai * 128 + m * 16, n = row & 255, half = row >> 8;
                    bf16* dst = lat ? Gl + (size_t)(b * 256 + n) * 4096 + half * 2048 + pos : Gc + (size_t)(b * 256 + n) * 512 + half * 256 + pos;
                    *(u32x4*)dst = pack8(acc[ai][bj][m][0], acc[ai][bj][m][1]);
                }
        }
    }
};

struct EpiDft {
    static constexpr bool PERM = true, AFTER_DRAIN = false;
    bf16* mix; int row_base, rows_per_b;
    DI void operator()(const A4 (&acc)[2][2][4][2], const pg8::Unit& u, int wr, int wc, int fr, int fq) const {
        const int row0 = u.pm * 256 + wr * 64 + fr, n0 = wc * 32 + 8 * fq;
#pragma unroll
        for (int ai = 0; ai < 2; ++ai)
#pragma unroll
            for (int m = 0; m < 4; ++m) {
                const int k = row0 + ai * 128 + m * 16;
                bf16* rowp = mix + (size_t)(row_base + u.pn * rows_per_b + k) * MIXD + 1024 + n0;
#pragma unroll
                for (int bj = 0; bj < 2; ++bj) *(u32x4*)(rowp + bj * 128) = pack8(acc[ai][bj][m][0], acc[ai][bj][m][1]);
            }
    }
};

struct EpiRes {
    static constexpr bool PERM = true, AFTER_DRAIN = false;
    const float* Xin; float* Xout; const float* ST; const float* lg; const float* lb; const float* modl; int goff; int pm_off;
    DI void operator()(const A4 (&acc)[2][2][4][2], const pg8::Unit& u, int wr, int wc, int fr, int fq) const {
        const int row0 = u.pm * 256 + wr * 64 + fr, col0 = u.pn * 256 + wc * 32 + 8 * fq;
        const int bidx = (u.pm + pm_off < 64) ? ((u.pm + pm_off) >> 3) : 8;
        const float* gp = modl + bidx * 6144 + goff + col0;
        f32x4 g[2][2], ga[2][2], be[2][2];
#pragma unroll
        for (int bj = 0; bj < 2; ++bj) { g[bj][0] = *(const f32x4*)(gp + bj * 128); g[bj][1] = *(const f32x4*)(gp + bj * 128 + 4); }
        const bool has_ln = lg != nullptr;
        if (has_ln) {
#pragma unroll
            for (int bj = 0; bj < 2; ++bj) { ga[bj][0] = *(const f32x4*)(lg + col0 + bj * 128) * ALPHA; ga[bj][1] = *(const f32x4*)(lg + col0 + bj * 128 + 4) * ALPHA;
                                             be[bj][0] = *(const f32x4*)(lb + col0 + bj * 128) * ALPHA; be[bj][1] = *(const f32x4*)(lb + col0 + bj * 128 + 4) * ALPHA; }
        } else {
#pragma unroll
            for (int bj = 0; bj < 2; ++bj) { ga[bj][0] = (f32x4){ALPHA, ALPHA, ALPHA, ALPHA}; ga[bj][1] = ga[bj][0]; be[bj][0] = (f32x4){0.f, 0.f, 0.f, 0.f}; be[bj][1] = be[bj][0]; }
        }
#pragma unroll
        for (int ai = 0; ai < 2; ++ai)
#pragma unroll
            for (int m = 0; m < 4; ++m) {
                const int row = row0 + ai * 128 + m * 16;
                float mean = 0.f, rstd = 1.f;
                if (has_ln) { const f32x2 st = *(const f32x2*)(ST + 2 * row); mean = st[0]; rstd = st[1]; }
                const float* rin = Xin + (size_t)row * DM + col0; float* rout = Xout + (size_t)row * DM + col0;
#pragma unroll
                for (int bj = 0; bj < 2; ++bj) {
                    f32x4 x0 = *(const f32x4*)(rin + bj * 128), x1 = *(const f32x4*)(rin + bj * 128 + 4);
                    x0 = (x0 - mean) * rstd * ga[bj][0] + be[bj][0] + g[bj][0] * acc[ai][bj][m][0];
                    x1 = (x1 - mean) * rstd * ga[bj][1] + be[bj][1] + g[bj][1] * acc[ai][bj][m][1];
                    *(f32x4*)(rout + bj * 128) = x0; *(f32x4*)(rout + bj * 128 + 4) = x1;
                }
            }
    }
};

DI f32x4 silu4(f32x4 a) { f32x4 r; for (int j = 0; j < 4; ++j) r[j] = a[j] * frcp(1.f + fexp2(-1.4426950408889634f * a[j])); return r; }
struct EpiSwiglu {
    static constexpr bool PERM = true, AFTER_DRAIN = false;
    bf16* U;
    DI void operator()(const A4 (&acc)[2][2][4][2], const pg8::Unit& u, int wr, int wc, int fr, int fq) const {
        const int row0 = u.pm * 256 + wr * 64 + fr, col0 = u.pn * 128 + wc * 32 + 8 * fq;
#pragma unroll
        for (int ai = 0; ai < 2; ++ai)
#pragma unroll
            for (int m = 0; m < 4; ++m) {
                const f32x4 h0 = silu4(acc[ai][0][m][0]) * acc[ai][1][m][0], h1 = silu4(acc[ai][0][m][1]) * acc[ai][1][m][1];
                *(u32x4*)(U + (size_t)(row0 + ai * 128 + m * 16) * DFF + col0) = pack8(h0, h1);
            }
    }
};

template <int M, int N> struct StaticOrderT {
    static constexpr int nM = M / 256, nN = N / 256, nwg = nM * nN;
    int G, c;
    static DI void map(int L, pg8::Unit& u) {
        int wgid = L; { constexpr int q = nwg / 8, r = nwg % 8; const int xcd = wgid % 8, off = wgid / 8; wgid = (xcd < r ? xcd * (q + 1) : r * (q + 1) + (xcd - r) * q) + off; }
        constexpr int nig = 8 * nN; const int gid = wgid / nig, fm = gid * 8, gsz = (nM - fm) < 8 ? (nM - fm) : 8;
        if constexpr (nM % 8 == 0) { u.pm = fm + ((wgid % nig) & 7); u.pn = (wgid % nig) >> 3; }
        else { u.pm = fm + ((wgid % nig) % gsz); u.pn = (wgid % nig) / gsz; }
    }
    DI bool next(int i, pg8::Unit& u) const { const int L = i * G + c; if (L >= nwg) return false; map(L, u); return true; }
    DI void a_ready(const pg8::Unit&) const {}
    DI void done(const pg8::Unit&) const {}
};
constexpr int CW_GCTX = 3584;
struct SchedG {
    int c; unsigned* cnt;
    DI bool next(int i, pg8::Unit& u) const {
        int L;
        if (c < 224) { L = c + 224 * i; if (L >= 1456) return false; }
        else { if (i >= 4) return false; L = 1456 + (c - 224) + 32 * i; }
        if (L < 176) { u.pm = 64 + (L & 7); u.pn = L >> 3; }
        else StaticOrderT<NLAT, 2 * DFF>::map(L - 176, u);
        return true;
    }
    DI void a_ready(const pg8::Unit&) const {}
    DI void done(const pg8::Unit& u) const {
        if (u.pm >= 64) {
            asm volatile("s_waitcnt vmcnt(0)" ::: "memory");
            __syncthreads();
            if (otid() == 0) { __builtin_amdgcn_fence(__ATOMIC_RELEASE, "agent"); asm volatile("s_waitcnt vmcnt(0)" ::: "memory"); (void)xb_add(cnt, 1u); }
        }
    }
};
constexpr int CW_ECTX = 3648;
DI void publish_block(unsigned* cnt) {
    asm volatile("s_waitcnt vmcnt(0)" ::: "memory");
    __syncthreads();
    if (otid() == 0) { __builtin_amdgcn_fence(__ATOMIC_RELEASE, "agent"); asm volatile("s_waitcnt vmcnt(0)" ::: "memory"); (void)xb_add(cnt, 1u); }
}
template <int M, int N> struct StaticOrderSig {
    int G, c; unsigned* cnt;
    DI bool next(int i, pg8::Unit& u) const { const int L = i * G + c; if (L >= StaticOrderT<M, N>::nwg) return false; StaticOrderT<M, N>::map(L, u); return true; }
    DI void a_ready(const pg8::Unit&) const {}
    DI void done(const pg8::Unit&) const { publish_block(cnt); }
};
struct SchedHC {
    int c; unsigned* cnt; unsigned target;
    DI bool next(int i, pg8::Unit& u) const { if (i > 0 || c < 224 || c >= 256) return false; const int k = c - 224; u.pm = k & 7; u.pn = k >> 3; return true; }
    DI void a_ready(const pg8::Unit&) const {
        if (otid() == 0) { unsigned sp = 0; while (xb_ld(cnt) < target) { __builtin_amdgcn_s_sleep(1); if (++sp > (1u << 22)) break; }
            __builtin_amdgcn_fence(__ATOMIC_ACQUIRE, "agent"); asm volatile("s_waitcnt vmcnt(0)" ::: "memory"); }
        __syncthreads();
    }
    DI void done(const pg8::Unit&) const {}
};
template <int LDA, int LDB, int KDIM, class Sched, class Epi> DI void run_gemm_s(LAS unsigned char* lds, const bf16* A, const bf16* Bt, int M, int N, const Sched& S, const Epi& E) {
    pg8::Gemm g{A, Bt, M, N};
    pg8::gemm_phase<Epi, Sched, true, true, LDA, LDB, KDIM>(lds, g, S, E);
    __syncthreads();
}
template <int LDA, int LDB, int KDIM, int M, int N, class Epi> DI void run_gemm(LAS unsigned char* lds, const bf16* A, const bf16* Bt, int G, int c, const Epi& E) {
    pg8::Gemm g{A, Bt, M, N};
    StaticOrderT<M, N> S; S.G = G; S.c = c;
    pg8::gemm_phase<Epi, StaticOrderT<M, N>, true, true, LDA, LDB, KDIM>(lds, g, S, E);
    __syncthreads();
}

template <int NR> DI void row_pass_n(const float* const (&src)[NR], const float* lg, const float* lb, float* const (&dstx)[NR], bf16* const (&dsth)[NR],
                                     const float* const (&sc)[NR], const float* const (&sh)[NR], float* const (&stat)[NR], bool has_stat, bool has_x, bool has_h, int lane) {
    f32x4 v[NR][4]; float s[NR];
#pragma unroll
    for (int r = 0; r < NR; ++r) { const f32x4* xr = (const f32x4*)src[r] + lane; s[r] = 0.f;
#pragma unroll
        for (int j = 0; j < 4; ++j) { v[r][j] = xr[64 * j]; } }
    if (lg) {
#pragma unroll
        for (int r = 0; r < NR; ++r)
#pragma unroll
            for (int j = 0; j < 4; ++j) s[r] += (v[r][j][0] + v[r][j][1]) + (v[r][j][2] + v[r][j][3]);
#pragma unroll
        for (int o = 1; o < 64; o <<= 1)
#pragma unroll
            for (int r = 0; r < NR; ++r) s[r] += shx(s[r], o);
        float s2[NR];
#pragma unroll
        for (int r = 0; r < NR; ++r) { const float mean = s[r] * (1.f / DM); s2[r] = 0.f;
#pragma unroll
            for (int j = 0; j < 4; ++j) { v[r][j] = v[r][j] - mean; s2[r] += (v[r][j][0] * v[r][j][0] + v[r][j][1] * v[r][j][1]) + (v[r][j][2] * v[r][j][2] + v[r][j][3] * v[r][j][3]); } }
#pragma unroll
        for (int o = 1; o < 64; o <<= 1)
#pragma unroll
            for (int r = 0; r < NR; ++r) s2[r] += shx(s2[r], o);
#pragma unroll
        for (int j = 0; j < 4; ++j) { const f32x4 gg = ((const f32x4*)lg)[lane + 64 * j], bb = ((const f32x4*)lb)[lane + 64 * j];
#pragma unroll
            for (int r = 0; r < NR; ++r) { const float rstd = rsqrtf(s2[r] * (1.f / DM) + LN_EPS); v[r][j] = v[r][j] * rstd * gg + bb; } }
        if (has_stat) {
#pragma unroll
            for (int r = 0; r < NR; ++r) if (lane == 0) { f32x2 st2; st2[0] = s[r] * (1.f / DM); st2[1] = rsqrtf(s2[r] * (1.f / DM) + LN_EPS); *(f32x2*)stat[r] = st2; }
        }
    }
    if (has_x) {
#pragma unroll
        for (int r = 0; r < NR; ++r)
#pragma unroll
            for (int j = 0; j < 4; ++j) ((f32x4*)dstx[r])[lane + 64 * j] = v[r][j];
    }
    if (has_h) {
#pragma unroll
        for (int r = 0; r < NR; ++r)
#pragma unroll
            for (int j = 0; j < 4; ++j) {
                const f32x4 a = ((const f32x4*)sc[r])[lane + 64 * j], d = ((const f32x4*)sh[r])[lane + 64 * j];
                const f32x4 h = v[r][j] * (a + 1.f) + d;
                u32x2 w; w.x = pk2(h[0], h[1]); w.y = pk2(h[2], h[3]);
                ((u32x2*)dsth[r])[lane + 64 * j] = w;
            }
    }
}
DI void rows_phase(const Params& p, int mode, int nrows, const float* lg, const float* lb, const float* modl, int sc_off, int sh_off, int gw, int ngw, int lane) {
    float* XRES = (float*)(wsp(p) + WS_XRES); bf16* HA = (bf16*)(wsp(p) + WS_HA); float* STA = (float*)(wsp(p) + WS_ST);
    constexpr int NR = 3;
    for (int row0 = gw; row0 < nrows; row0 += NR * ngw) {
        const float* src[NR]; float* dx[NR]; bf16* dh[NR]; const float* sc[NR]; const float* sh[NR]; float* stp[NR];
#pragma unroll
        for (int r = 0; r < NR; ++r) {
            int row = row0 + r * ngw; if (row >= nrows) row = row0;
            const int bidx = row < NLAT ? (row >> 11) : 8;
            src[r] = (mode == 0) ? (row < NLAT ? inp(p, 0) + (size_t)row * DM : inp(p, 2) + (size_t)(row - NLAT) * DM) : XRES + (size_t)row * DM;
            dx[r] = p.out + (size_t)(row < NLAT ? row : 0) * DM; dh[r] = HA + (size_t)row * DM; stp[r] = STA + 2 * row;
            sc[r] = modl + bidx * 6144 + sc_off; sh[r] = modl + bidx * 6144 + sh_off;
        }
        row_pass_n<NR>(src, lg, lb, dx, dh, sc, sh, stp, mode == 1, mode == 2, mode != 2, lane);
    }
}

template <class RM> DI void tr_item(const float* W, int ldsrc, int k0, int n0, bf16* dst, int lddst, int coloff, const float* kscale, RM rm, LAS float* scr, int lane) {
#pragma unroll 8
    for (int i = 0; i < 32; ++i) { const int kk = 2 * i + (lane >> 5); float w = W[(size_t)(k0 + kk) * ldsrc + n0 + (lane & 31)]; if (kscale) w *= kscale[k0 + kk]; scr[kk * 33 + (lane & 31)] = w; }
    LDS_WAIT(); asm volatile("" ::: "memory");
    const int c = lane & 7;
#pragma unroll
    for (int j = 0; j < 4; ++j) { const int n = (lane >> 3) + 8 * j; const LAS float* s = scr + (8 * c) * 33 + n;
        u32x4 o; o.x = pk2(s[0 * 33], s[1 * 33]); o.y = pk2(s[2 * 33], s[3 * 33]); o.z = pk2(s[4 * 33], s[5 * 33]); o.w = pk2(s[6 * 33], s[7 * 33]);
        *(u32x4*)(dst + (size_t)rm(n0 + n) * lddst + coloff + k0 + 8 * c) = o; }
    LDS_WAIT(); asm volatile("" ::: "memory");
}
struct RmId { int off; DI int operator()(int n) const { return n + off; } };
struct RmFfn { int off; DI int operator()(int n) const { return 256 * (n >> 7) + (n & 127) + off; } };

DI void zero_rect(bf16* dst, int ld, int row0, int nrows, int col0, int ncols, int gtid, int gthreads) {
    const int cpr = ncols >> 3, total = nrows * cpr; const unsigned zu = __float_as_uint(ozero());
    for (int e = gtid; e < total; e += gthreads) { const int r = e / cpr, cc = e - r * cpr; *(u32x4*)(dst + (size_t)(row0 + r) * ld + col0 + cc * 8) = (u32x4){zu, zu, zu, zu}; }
}

DI void phase_convert(const Params& p, int l, LAS unsigned char* lds, int gw, int ngw, int lane, int gtid, int gthreads) {
    unsigned char* ws = wsp(p);
    LAS float* scr = (LAS float*)(lds + (otid() >> 6) * 16384);
    bf16* Wtin = (bf16*)(ws + WS_WIN); bf16* Wtqk = (bf16*)(ws + WS_WQK); bf16* Wtv = (bf16*)(ws + WS_WV); bf16* Wtf = (bf16*)(ws + WS_WF);
    bf16* Wtout = (bf16*)(ws + WS_WOUT); bf16* Wt13 = (bf16*)(ws + WS_W13); bf16* Wt2 = (bf16*)(ws + WS_W2); bf16* Wtpool = (bf16*)(ws + WS_WPOOL); bf16* Wsb = (bf16*)(ws + WS_WS);
    const float* w_in = inp(p, 6) + (size_t)l * 1024 * 1440; const float* qn = inp(p, 7) + l * 256; const float* w_uq = inp(p, 8) + (size_t)l * 256 * 768;
    const float* kvn = inp(p, 9) + l * 128; const float* w_uk = inp(p, 10) + (size_t)l * 128 * 512; const float* w_uv = inp(p, 11) + (size_t)l * 128 * 512;
    const float* w_sp = inp(p, 14) + (size_t)l * 4 * 128 * 128; const float* w_pool = inp(p, 16) + (size_t)l * 4 * 64 * 64; const float* w_f = inp(p, 18) + (size_t)l * 256 * 256;
    const float* w_out = inp(p, 19) + (size_t)l * 1280 * 1024; const float* w1 = inp(p, 22) + (size_t)l * 1024 * DFF; const float* w3 = inp(p, 23) + (size_t)l * 1024 * DFF; const float* w2 = inp(p, 24) + (size_t)l * DFF * 1024;
    constexpr int I_IN = 16 * 45, I_UQ = 4 * 24, I_UK = 2 * 16, I_UV = 2 * 16, I_OUT = 20 * 32, I_F1 = 16 * 88, I_F3 = 16 * 88, I_F2 = 44 * 32, I_POOL = 8;
    constexpr int NITEMS = I_IN + I_UQ + I_UK + I_UV + I_OUT + I_F1 + I_F3 + I_F2 + I_POOL;
    for (int it = gw; it < NITEMS; it += ngw) {
        int r = it;
        if (r < I_IN) { tr_item(w_in, 1440, 64 * (r / 45), 32 * (r % 45), Wtin, 1024, 0, nullptr, RmId{0}, scr, lane); continue; } r -= I_IN;
        if (r < I_UQ) { tr_item(w_uq, 768, 64 * (r / 24), 32 * (r % 24), Wtqk, 384, 0, qn, RmId{0}, scr, lane); continue; } r -= I_UQ;
        if (r < I_UK) { tr_item(w_uk, 512, 64 * (r / 16), 32 * (r % 16), Wtqk, 384, 256, kvn, RmId{768}, scr, lane); continue; } r -= I_UK;
        if (r < I_UV) { tr_item(w_uv, 512, 64 * (r / 16), 32 * (r % 16), Wtv, 384, 256, kvn, RmId{0}, scr, lane); continue; } r -= I_UV;
        if (r < I_OUT) { tr_item(w_out, 1024, 64 * (r / 32), 32 * (r % 32), Wtout, 1280, 0, nullptr, RmId{0}, scr, lane); continue; } r -= I_OUT;
        if (r < I_F1) { tr_item(w1, DFF, 64 * (r / 88), 32 * (r % 88), Wt13, 1024, 0, nullptr, RmFfn{0}, scr, lane); continue; } r -= I_F1;
        if (r < I_F3) { tr_item(w3, DFF, 64 * (r / 88), 32 * (r % 88), Wt13, 1024, 0, nullptr, RmFfn{128}, scr, lane); continue; } r -= I_F3;
        if (r < I_F2) { tr_item(w2, 1024, 64 * (r / 32), 32 * (r % 32), Wt2, DFF, 0, nullptr, RmId{0}, scr, lane); continue; } r -= I_F2;
        { const int gi = r >> 1; tr_item(w_pool + gi * 4096, 64, 0, 32 * (r & 1), Wtpool + gi * 4096, 64, 0, nullptr, RmId{0}, scr, lane); }
    }
    zero_rect(Wtin, 1024, 1440, 96, 0, 1024, gtid, gthreads);
    zero_rect(Wtqk, 384, 0, 768, 256, 128, gtid, gthreads);
    zero_rect(Wtqk, 384, 768, 512, 0, 256, gtid, gthreads);
    zero_rect(Wtv, 384, 0, 512, 0, 256, gtid, gthreads);
    for (int e = gtid; e < 4 * 128 * 128 / 4; e += gthreads) { const f32x4 v = ((const f32x4*)w_sp)[e]; u32x2 w; w.x = pk2(v[0], v[1]); w.y = pk2(v[2], v[3]); ((u32x2*)Wsb)[e] = w; }
    for (int e = gtid; e < 256 * 256; e += gthreads) {
        const int n = e & 255, gc = e >> 8, g = gc >> 6, c = gc & 63;
        float sc_ = 0.f, ss_ = 0.f;
        for (int m = 0; m < 64; ++m) { const float w = w_f[(size_t)(g * 64 + m) * 256 + n]; const float a = (float)((m * c) & 63) * (1.f / 64.f); sc_ += cos_turn(a) * w; ss_ += sin_turn(a) * w; }
        Wtf[(size_t)n * 256 + gc] = (bf16)(pk2(sc_, 0.f) & 0xffffu); Wtf[(size_t)(256 + n) * 256 + gc] = (bf16)(pk2(-ss_, 0.f) & 0xffffu);
    }
}

DI void mod_items(const Params& p, LAS unsigned char* lds, int l_lo, int l_hi, int nblk, int blk) {
    const int tid = otid();
    LAS float* S = (LAS float*)lds;
    LAS float* red = (LAS float*)(lds + 40960);
    const float* cvec = inp(p, 1); const float* ccv = inp(p, 3); const float* w_mod = inp(p, 4); const float* b_mod = inp(p, 5);
    float* MOD = (float*)(wsp(p) + WS_MOD);
    if (blk >= (l_hi - l_lo) * 96) return;
    for (int i = tid; i < 9 * 1024; i += 512) { const float v = i < 8192 ? cvec[i] : ccv[i - 8192]; S[i] = v * frcp(1.f + fexp2(-1.4426950408889634f * v)); }
    __syncthreads();
    for (int item = blk; item < (l_hi - l_lo) * 96; item += nblk) {
        const int l = l_lo + item / 96, n0 = (item % 96) * 64, j = tid & 63, ks = tid >> 6;
        const float* W = w_mod + (size_t)l * 1024 * 6144 + n0 + j;
        float a0 = 0, a1 = 0, a2 = 0, a3 = 0, a4 = 0, a5 = 0, a6 = 0, a7 = 0, a8 = 0;
#pragma unroll 32
        for (int k = ks * 128; k < ks * 128 + 128; ++k) {
            const float w = W[(size_t)k * 6144];
            a0 += S[k] * w; a1 += S[1024 + k] * w; a2 += S[2048 + k] * w; a3 += S[3072 + k] * w; a4 += S[4096 + k] * w;
            a5 += S[5120 + k] * w; a6 += S[6144 + k] * w; a7 += S[7168 + k] * w; a8 += S[8192 + k] * w;
        }
        LAS float* rr = red + ks * 576 + j;
        rr[0] = a0; rr[64] = a1; rr[128] = a2; rr[192] = a3; rr[256] = a4; rr[320] = a5; rr[384] = a6; rr[448] = a7; rr[512] = a8;
        __syncthreads();
        for (int o = tid; o < 576; o += 512) {
            const int r = o >> 6, jj = o & 63; float s = b_mod[l * 6144 + n0 + jj];
#pragma unroll
            for (int k2 = 0; k2 < 8; ++k2) s += red[k2 * 576 + o];
            MOD[(size_t)(l * 9 + r) * 6144 + n0 + jj] = s;
        }
        __syncthreads();
    }
}
DI void cs_tables(const Params& p, int gtid, int gthreads) {
    bf16* CSL = (bf16*)(wsp(p) + WS_CSL); bf16* CSC = (bf16*)(wsp(p) + WS_CSC);
    for (int ch = gtid; ch < 1048576 + 16384; ch += gthreads) {
        float v[8];
        if (ch < 1048576) {
            const int k = ch >> 9, l0 = (ch & 511) * 8, half = l0 >> 11, lb = l0 & 2047; const float scale = 0.00276213586400995f;
#pragma unroll
            for (int j = 0; j < 8; ++j) { const float a = (float)((k * (lb + j)) & 2047) * (1.f / 2048.f); v[j] = (half ? sin_turn(a) : cos_turn(a)) * scale; }
            u32x4 w; w.x = pk2(v[0], v[1]); w.y = pk2(v[2], v[3]); w.z = pk2(v[4], v[5]); w.w = pk2(v[6], v[7]);
            *(u32x4*)(CSL + (size_t)k * 4096 + l0) = w;
        } else {
            const int c2 = ch - 1048576, k = c2 >> 6, l0 = (c2 & 63) * 8, half = l0 >> 8, lb = l0 & 255; const float scale = 1.f / 128.f;
#pragma unroll
            for (int j = 0; j < 8; ++j) { const float a = (float)((k * (lb + j)) & 255) * (1.f / 256.f); v[j] = (half ? sin_turn(a) : cos_turn(a)) * scale; }
            u32x4 w; w.x = pk2(v[0], v[1]); w.y = pk2(v[2], v[3]); w.z = pk2(v[4], v[5]); w.w = pk2(v[6], v[7]);
            *(u32x4*)(CSC + (size_t)k * 512 + l0) = w;
        }
    }
}
DI void phase_prologue(const Params& p, LAS unsigned char* lds, int G, int bid) {
    const int tid = otid();
    if (G == 256) mod_items(p, lds, 0, 1, G, bid); else mod_items(p, lds, 0, DEPTH, G, bid);
    const int gtid = bid * 512 + tid, gthreads = G * 512;
    if (G != 256) cs_tables(p, gtid, gthreads);
    float* ROPE = (float*)(wsp(p) + WS_ROPE);
    for (int e = gtid; e < 2048 * 16; e += gthreads) {
        const int pos = e >> 4, f = e & 15, axis = f >> 3, fi = f & 7;
        const float coord = (float)(axis ? (pos & 63) : (pos >> 6));
        const float inv = fexp2(-(float)fi * (13.287712379549449f / 8.f));
        const float ang = coord * inv * 0.15915494309189535f;
        ROPE[pos * 32 + f] = cos_turn(ang); ROPE[pos * 32 + 16 + f] = sin_turn(ang);
    }
}

DI f32x4 mfma16(bf16x8 a, bf16x8 b, f32x4 c) { return __builtin_amdgcn_mfma_f32_16x16x32_bf16(a, b, c, 0, 0, 0); }
DI f32x16 mfma32(bf16x8 a, bf16x8 b, f32x16 c) { return __builtin_amdgcn_mfma_f32_32x32x16_bf16(a, b, c, 0, 0, 0); }

DI void sgu_item(const Params& p, int l, int ci, int g, LAS unsigned char* lds) {
    const int tid = otid(), lane = tid & 63, w = tid >> 6;
    const bf16* proj = (const bf16*)(wsp(p) + WS_PROJ); bf16* mix = (bf16*)(wsp(p) + WS_MIX); const bf16* Wsb = (const bf16*)(wsp(p) + WS_WS);
    const float* gam = inp(p, 12) + l * 256; const float* bet = inp(p, 13) + l * 256; const float* bsp = inp(p, 15) + l * 512;
    constexpr int PITCH = 136;
    LAS bf16* vnT = (LAS bf16*)lds;
    const int r0 = ci * 128;
    const int fr = lane & 15, fq = lane >> 4, pp = 16 * w + fr, tok = r0 + pp;
    bf16x8 wfr[4]; u32x2 uu[4];
#pragma unroll
    for (int ks = 0; ks < 4; ++ks) wfr[ks] = *(const bf16x8*)(Wsb + (size_t)(g * 128 + pp) * 128 + ks * 32 + fq * 8);
#pragma unroll
    for (int ct = 0; ct < 4; ++ct) uu[ct] = *(const u32x2*)(proj + (size_t)tok * NPROJ + PO_SU + g * 64 + ct * 16 + fq * 4);
    const float bs = bsp[g * 128 + pp];
    {
        const int q = tid >> 2, j = tid & 3;
        const u32x4* src = (const u32x4*)(proj + (size_t)(r0 + q) * NPROJ + PO_SV + j * 64);
        float v[64]; float s = 0.f;
#pragma unroll
        for (int i = 0; i < 8; ++i) { const u32x4 x = src[i];
            v[8 * i + 0] = bflo(x.x); v[8 * i + 1] = bfhi(x.x); v[8 * i + 2] = bflo(x.y); v[8 * i + 3] = bfhi(x.y);
            v[8 * i + 4] = bflo(x.z); v[8 * i + 5] = bfhi(x.z); v[8 * i + 6] = bflo(x.w); v[8 * i + 7] = bfhi(x.w); }
#pragma unroll
        for (int i = 0; i < 64; ++i) s += v[i];
        s += shx(s, 1); s += shx(s, 2);
        const float mean = s * (1.f / 256.f); float s2 = 0.f;
#pragma unroll
        for (int i = 0; i < 64; ++i) { v[i] -= mean; s2 += v[i] * v[i]; }
        s2 += shx(s2, 1); s2 += shx(s2, 2);
        const float rstd = rsqrtf(s2 * (1.f / 256.f) + LN_EPS);
        if (j == g) {
#pragma unroll
            for (int c = 0; c < 64; ++c) { const float vn = v[c] * rstd * gam[g * 64 + c] + bet[g * 64 + c]; vnT[c * PITCH + q] = (bf16)(pk2(vn, 0.f) & 0xffffu); }
        }
    }
    __syncthreads();
    {
        f32x4 acc[4]; const float zf = ozero();
#pragma unroll
        for (int ct = 0; ct < 4; ++ct) acc[ct] = (f32x4){zf, zf, zf, zf};
#pragma unroll
        for (int ks = 0; ks < 4; ++ks) {
            const bf16x8 bfr = wfr[ks];
#pragma unroll
            for (int ct = 0; ct < 4; ++ct) { const bf16x8 afr = *(const LAS bf16x8*)(vnT + (ct * 16 + fr) * PITCH + ks * 32 + fq * 8); acc[ct] = mfma16(afr, bfr, acc[ct]); }
        }
#pragma unroll
        for (int ct = 0; ct < 4; ++ct) {
            const int c0 = g * 64 + ct * 16 + fq * 4;
            u32x2 o; o.x = pk2(bflo(uu[ct].x) * (acc[ct][0] + bs), bfhi(uu[ct].x) * (acc[ct][1] + bs)); o.y = pk2(bflo(uu[ct].y) * (acc[ct][2] + bs), bfhi(uu[ct].y) * (acc[ct][3] + bs));
            *(u32x2*)(mix + (size_t)tok * MIXD + 512 + c0) = o;
        }
    }
    __syncthreads();
}

DI void pool_item(const Params& p, int l, int ti, int gi, LAS unsigned char* lds) {
    const int tid = otid(), lane = tid & 63, w = tid >> 6;
    const bf16* proj = (const bf16*)(wsp(p) + WS_PROJ); bf16* mix = (bf16*)(wsp(p) + WS_MIX); const bf16* Wtp = (const bf16*)(wsp(p) + WS_WPOOL) + gi * 4096;
    const float* pscale = inp(p, 17) + l * 256 + gi * 64;
    LAS float* Pl = (LAS float*)lds;
    LAS bf16* Dl = (LAS bf16*)(lds + 40960);
    const int r0 = ti * 128, half = 1 << gi;
    int sb, se; if (r0 < NLAT) { sb = r0 & ~2047; se = sb + 2048; } else { sb = NLAT + ((r0 - NLAT) & ~255); se = sb + 256; }
    const unsigned zu = __float_as_uint(ozero());
    const int fr = lane & 15, fq = lane >> 4;
    bf16x8 wfr[2][4]; f32x4 psc[4];
#pragma unroll
    for (int ks = 0; ks < 2; ++ks)
#pragma unroll
        for (int nt = 0; nt < 4; ++nt) wfr[ks][nt] = *(const bf16x8*)(Wtp + (nt * 16 + fr) * 64 + ks * 32 + fq * 8);
#pragma unroll
    for (int nt = 0; nt < 4; ++nt) psc[nt] = *(const f32x4*)(pscale + nt * 16 + fq * 4);
    for (int e = tid; e < 144 * 8; e += 512) {
        const int rr = e >> 3, c8 = (e & 7) * 8, r = r0 - 8 + rr;
        u32x4 x = (u32x4){zu, zu, zu, zu};
        if (r >= sb && r < se) x = *(const u32x4*)(proj + (size_t)r * NPROJ + PO_POOL + gi * 64 + c8);
        LAS float* d = Pl + rr * 65 + c8;
        d[0] = bflo(x.x); d[1] = bfhi(x.x); d[2] = bflo(x.y); d[3] = bfhi(x.y); d[4] = bflo(x.z); d[5] = bfhi(x.z); d[6] = bflo(x.w); d[7] = bfhi(x.w);
    }
    __syncthreads();
    {
        const int c = tid & 63, t0 = (tid >> 6) * 16;
        float s = 0.f;
        for (int rr = t0 + 8 - half; rr < t0 + 8 + half; ++rr) s += Pl[rr * 65 + c];
        float add[15], sub[15], ctr[16];
#pragma unroll
        for (int i = 0; i < 15; ++i) { add[i] = Pl[(t0 + i + 8 + half) * 65 + c]; sub[i] = Pl[(t0 + i + 8 - half) * 65 + c]; }
#pragma unroll
        for (int i = 0; i < 16; ++i) ctr[i] = Pl[(t0 + i + 8) * 65 + c];
#pragma unroll
        for (int i = 0; i < 16; ++i) {
            const int r = r0 + t0 + i;
            const int lo = max(r - half, sb), hi = min(r + half, se);
            const float d = s * frcp((float)(hi - lo)) - ctr[i];
            Dl[(t0 + i) * 72 + c] = (bf16)(pk2(d, 0.f) & 0xffffu);
            if (i < 15) s += add[i] - sub[i];
        }
    }
    __syncthreads();
    {
        const int t = 16 * w + fr;
        f32x4 acc[4]; const float zf = ozero();
#pragma unroll
        for (int nt = 0; nt < 4; ++nt) acc[nt] = (f32x4){zf, zf, zf, zf};
#pragma unroll
        for (int ks = 0; ks < 2; ++ks) {
            const bf16x8 bfr = *(const LAS bf16x8*)(Dl + t * 72 + ks * 32 + fq * 8);
#pragma unroll
            for (int nt = 0; nt < 4; ++nt) acc[nt] = mfma16(wfr[ks][nt], bfr, acc[nt]);
        }
#pragma unroll
        for (int nt = 0; nt < 4; ++nt) {
            const int n0 = nt * 16 + fq * 4; const f32x4 sc = psc[nt];
            u32x2 o; o.x = pk2(acc[nt][0] * sc[0], acc[nt][1] * sc[1]); o.y = pk2(acc[nt][2] * sc[2], acc[nt][3] * sc[3]);
            *(u32x2*)(mix + (size_t)(r0 + t) * MIXD + 768 + gi * 64 + n0) = o;
        }
    }
    __syncthreads();
}

DI void krope_items(const Params& p, int gtid, int gthreads) {
    const bf16* proj = (const bf16*)(wsp(p) + WS_PROJ); bf16* Kb = (bf16*)(wsp(p) + WS_K); const float* rope = (const float*)(wsp(p) + WS_ROPE);
    for (int e = gtid; e < MTOK * 2; e += gthreads) {
        const int row = e >> 1, axis = e & 1;
        int b, pos; bool lat; row_info(row, b, pos, lat);
        const u32x4 x1 = *(const u32x4*)(proj + (size_t)row * NPROJ + PO_KR + axis * 16), x2 = *(const u32x4*)(proj + (size_t)row * NPROJ + PO_KR + axis * 16 + 8);
        u32x4 o1 = x1, o2 = x2;
        if (lat) {
            const float* rp = rope + pos * 32 + axis * 8;
            float a[8], c[8], cs[8], sn[8];
            a[0] = bflo(x1.x); a[1] = bfhi(x1.x); a[2] = bflo(x1.y); a[3] = bfhi(x1.y); a[4] = bflo(x1.z); a[5] = bfhi(x1.z); a[6] = bflo(x1.w); a[7] = bfhi(x1.w);
            c[0] = bflo(x2.x); c[1] = bfhi(x2.x); c[2] = bflo(x2.y); c[3] = bfhi(x2.y); c[4] = bflo(x2.z); c[5] = bfhi(x2.z); c[6] = bflo(x2.w); c[7] = bfhi(x2.w);
#pragma unroll
            for (int j = 0; j < 8; ++j) { cs[j] = rp[j]; sn[j] = rp[16 + j]; }
            float y1[8], y2[8];
#pragma unroll
            for (int j = 0; j < 8; ++j) { y1[j] = a[j] * cs[j] - c[j] * sn[j]; y2[j] = a[j] * sn[j] + c[j] * cs[j]; }
            o1.x = pk2(y1[0], y1[1]); o1.y = pk2(y1[2], y1[3]); o1.z = pk2(y1[4], y1[5]); o1.w = pk2(y1[6], y1[7]);
            o2.x = pk2(y2[0], y2[1]); o2.y = pk2(y2[2], y2[3]); o2.z = pk2(y2[4], y2[5]); o2.w = pk2(y2[6], y2[7]);
        }
        const int key = lat ? CTXL + pos : pos;
#pragma unroll
        for (int h = 0; h < 8; ++h) { bf16* dst = Kb + ((size_t)(b * 8 + h) * NKEY + key) * 96 + 64 + axis * 16; *(u32x4*)dst = o1; *(u32x4*)(dst + 8) = o2; }
    }
}

DI int swap23(int r) { return (r & ~12) | ((r & 4) << 1) | ((r & 8) >> 1); }
DI void attn_item(const bf16* Qp, const bf16* Kp, const bf16* Vtp, int nkeys, bf16* outp  , LAS unsigned char* lds) {
    const int tid = otid(), lane = tid & 63, w = tid >> 6, r = lane & 31, hh = lane >> 5, gk = w >> 2, wq = w & 3;
    constexpr int KP = 208, VP = 144, KT = 64 * KP, VT = 64 * VP;
    LAS unsigned char* Kl = lds; LAS unsigned char* Vl = lds + 4 * KT;
    bf16x8 qf[6];
#pragma unroll
    for (int kk = 0; kk < 6; ++kk) qf[kk] = *(const bf16x8*)(Qp + (size_t)(32 * wq + r) * 96 + kk * 16 + hh * 8);
    const float zf = ozero();
    f32x16 o0, o1;
#pragma unroll
    for (int i = 0; i < 16; ++i) { o0[i] = zf; o1[i] = zf; }
    float mrun = -60.f, lrun = zf;
    unsigned kg[3], kl[3], vg[2], vl[2];
#pragma unroll
    for (int i = 0; i < 3; ++i) { const int c = tid + 512 * i, tile = c / 768, cc = c - tile * 768, row = cc / 12, col = cc - row * 12;
        kg[i] = (unsigned)((tile * 64 + row) * 96 + col * 8); kl[i] = (unsigned)(tile * KT + swap23(row) * KP + col * 16); }
#pragma unroll
    for (int i = 0; i < 2; ++i) { const int c = tid + 512 * i, tile = c >> 9, cc = c & 511, dv = cc >> 3, col = cc & 7;
        vg[i] = (unsigned)(dv * NKEY + tile * 64 + col * 8); vl[i] = (unsigned)(tile * VT + dv * VP + col * 16); }
    const int npairs = nkeys >> 7;
    u32x4 sk[3], sv[2];
#pragma unroll
    for (int i = 0; i < 3; ++i) sk[i] = *(const u32x4*)(Kp + kg[i]);
#pragma unroll
    for (int i = 0; i < 2; ++i) sv[i] = *(const u32x4*)(Vtp + vg[i]);
#pragma unroll
    for (int i = 0; i < 3; ++i) *(LAS u32x4*)(Kl + kl[i]) = sk[i];
#pragma unroll
    for (int i = 0; i < 2; ++i) *(LAS u32x4*)(Vl + vl[i]) = sv[i];
    __syncthreads();
    for (int kp = 0; kp < npairs; ++kp) {
        const int cur = kp & 1;
        if (kp + 1 < npairs) {
            const bf16* kgp = Kp + (size_t)(kp + 1) * 128 * 96; const bf16* vgp = Vtp + (kp + 1) * 128;
#pragma unroll
            for (int i = 0; i < 3; ++i) sk[i] = *(const u32x4*)(kgp + kg[i]);
#pragma unroll
            for (int i = 0; i < 2; ++i) sv[i] = *(const u32x4*)(vgp + vg[i]);
        }
        const LAS unsigned char* kb = Kl + (cur * 2 + gk) * KT; const LAS unsigned char* vb = Vl + (cur * 2 + gk) * VT;
        f32x16 s0, s1; const float negm = -mrun;
#pragma unroll
        for (int i = 0; i < 16; ++i) { s0[i] = negm; s1[i] = negm; }
#pragma unroll
        for (int kk = 0; kk < 6; ++kk) {
            const bf16x8 ka0 = *(const LAS bf16x8*)(kb + r * KP + kk * 32 + hh * 16);
            const bf16x8 ka1 = *(const LAS bf16x8*)(kb + (32 + r) * KP + kk * 32 + hh * 16);
            s0 = mfma32(ka0, qf[kk], s0); s1 = mfma32(ka1, qf[kk], s1);
        }
        float mx = s0[0];
#pragma unroll
        for (int i = 1; i < 16; ++i) mx = fmaxf(mx, s0[i]);
#pragma unroll
        for (int i = 0; i < 16; ++i) mx = fmaxf(mx, s1[i]);
        if (__builtin_amdgcn_ballot_w64(mx > 6.f) != 0ull) {
            mx = fmaxf(mx, shx(mx, 32));
            const float dm = fmaxf(mx, 0.f), alpha = fexp2(-dm);
            mrun += dm; lrun *= alpha;
#pragma unroll
            for (int i = 0; i < 16; ++i) { s0[i] -= dm; s1[i] -= dm; o0[i] *= alpha; o1[i] *= alpha; }
        }
        float ls = 0.f;
#pragma unroll
        for (int i = 0; i < 16; ++i) { s0[i] = fexp2(s0[i]); s1[i] = fexp2(s1[i]); ls += s0[i] + s1[i]; }
        lrun += ls;
        bf16x8 pf[2][2];
#pragma unroll
        for (int s2 = 0; s2 < 2; ++s2) {
            u32x4 a, b2;
            a.x = pk2(s0[8 * s2 + 0], s0[8 * s2 + 1]); a.y = pk2(s0[8 * s2 + 2], s0[8 * s2 + 3]); a.z = pk2(s0[8 * s2 + 4], s0[8 * s2 + 5]); a.w = pk2(s0[8 * s2 + 6], s0[8 * s2 + 7]);
            b2.x = pk2(s1[8 * s2 + 0], s1[8 * s2 + 1]); b2.y = pk2(s1[8 * s2 + 2], s1[8 * s2 + 3]); b2.z = pk2(s1[8 * s2 + 4], s1[8 * s2 + 5]); b2.w = pk2(s1[8 * s2 + 6], s1[8 * s2 + 7]);
            pf[0][s2] = __builtin_bit_cast(bf16x8, a); pf[1][s2] = __builtin_bit_cast(bf16x8, b2);
        }
#pragma unroll
        for (int d = 0; d < 2; ++d)
#pragma unroll
            for (int s2 = 0; s2 < 2; ++s2) {
                const bf16x8 v0 = *(const LAS bf16x8*)(vb + r * VP + (d * 32 + s2 * 16 + hh * 8) * 2);
                const bf16x8 v1 = *(const LAS bf16x8*)(vb + (32 + r) * VP + (d * 32 + s2 * 16 + hh * 8) * 2);
                o0 = mfma32(v0, pf[d][s2], o0); o1 = mfma32(v1, pf[d][s2], o1);
            }
        if (kp + 1 < npairs) {
            LAS unsigned char* kn = Kl + (cur ^ 1) * 2 * KT; LAS unsigned char* vn = Vl + (cur ^ 1) * 2 * VT;
#pragma unroll
            for (int i = 0; i < 3; ++i) *(LAS u32x4*)(kn + kl[i]) = sk[i];
#pragma unroll
            for (int i = 0; i < 2; ++i) *(LAS u32x4*)(vn + vl[i]) = sv[i];
        }
        __syncthreads();
    }
    lrun += shx(lrun, 32);
    LAS float* mg = (LAS float*)lds + wq * (34 * 64) + lane;
    if (gk == 1) {
#pragma unroll
        for (int i = 0; i < 16; ++i) { mg[i * 64] = o0[i]; mg[(16 + i) * 64] = o1[i]; }
        mg[32 * 64] = mrun; mg[33 * 64] = lrun;
    }
    __syncthreads();
    if (gk == 0) {
        const float m1 = mg[32 * 64], l1 = mg[33 * 64];
        const float m = fmaxf(mrun, m1), a0 = fexp2(mrun - m), a1 = fexp2(m1 - m);
        const float inv = frcp(lrun * a0 + l1 * a1), c0 = a0 * inv, c1 = a1 * inv;
        bf16* orow = outp + (size_t)(32 * wq + r) * MIXD;
#pragma unroll
        for (int i4 = 0; i4 < 4; ++i4) {
            u32x2 a, b2;
            a.x = pk2(o0[4 * i4] * c0 + mg[(4 * i4) * 64] * c1, o0[4 * i4 + 1] * c0 + mg[(4 * i4 + 1) * 64] * c1);
            a.y = pk2(o0[4 * i4 + 2] * c0 + mg[(4 * i4 + 2) * 64] * c1, o0[4 * i4 + 3] * c0 + mg[(4 * i4 + 3) * 64] * c1);
            b2.x = pk2(o1[4 * i4] * c0 + mg[(16 + 4 * i4) * 64] * c1, o1[4 * i4 + 1] * c0 + mg[(16 + 4 * i4 + 1) * 64] * c1);
            b2.y = pk2(o1[4 * i4 + 2] * c0 + mg[(16 + 4 * i4 + 2) * 64] * c1, o1[4 * i4 + 3] * c0 + mg[(16 + 4 * i4 + 3) * 64] * c1);
            *(u32x2*)(orow + 8 * i4 + 4 * hh) = a; *(u32x2*)(orow + 32 + 8 * i4 + 4 * hh) = b2;
        }
    }
    __syncthreads();
}

DI void attn_any(const Params& p, int item, LAS unsigned char* lds) {
    unsigned char* ws = wsp(p);
    const bool isl = item < 1024;
    const int bh = isl ? (item >> 4) : ((item - 1024) >> 1), qb = isl ? (item & 15) : ((item - 1024) & 1), b = bh >> 3, h = bh & 7;
    const bf16* Qp = isl ? (const bf16*)(ws + WS_QLAT) + ((size_t)bh * SEQ + qb * 128) * 96 : (const bf16*)(ws + WS_QCTX) + ((size_t)bh * CTXL + qb * 128) * 96;
    const bf16* Kp = (const bf16*)(ws + WS_K) + (size_t)bh * NKEY * 96;
    const bf16* Vtp = (const bf16*)(ws + WS_VT) + (size_t)bh * 64 * NKEY;
    bf16* outp = (bf16*)(ws + WS_MIX) + (size_t)(isl ? (b * SEQ + qb * 128) : (NLAT + b * CTXL + qb * 128)) * MIXD + h * 64;
    attn_item(Qp, Kp, Vtp, isl ? NKEY : CTXL, outp, lds);
    if (!isl) publish_block((unsigned*)(ws + WS_CTL) + CW_ECTX);
}

#ifndef PROBE_REP_SUB
#define PROBE_REP_SUB -1
#endif
#ifndef PROBE_SYNCS
#define PROBE_SYNCS 0
#endif
constexpr int NSUB = 13 + (PROBE_REP_SUB >= 0 ? 1 : 0), NSTEP = 2 + NSUB * DEPTH;
__global__ void __launch_bounds__(512, 2) mk_fwd(Params p) {
    extern __shared__ __attribute__((aligned(16))) unsigned char lds_raw[];
    LAS unsigned char* lds = (LAS unsigned char*)lds_raw;
    cg::grid_group grid = cg::this_grid();
    volatile LAS unsigned* MISC = (volatile LAS unsigned*)(lds + MISC_OFF);
    if (threadIdx.x < 4) MISC[threadIdx.x] = 0u;
    __syncthreads();
    const XcdBarrier xbar = xcd_barrier_post((unsigned*)(p.ws + WS_CTL), MISC);
    if (p.ph_lo < 0) grid.sync();
    for (int st = p.ph_lo; st < p.ph_hi; ++st) {
        int G = gridDim.x, bid = blockIdx.x; asm volatile("" : "+s"(G), "+s"(bid));
        const int vcu = (G % 8 == 0) ? (bid % 8) * (G / 8) + bid / 8 : bid;
        const int ngw = G * 8, gthreads = G * 512;
        const int tid = otid(), lane = tid & 63, wave = tid >> 6, gw = bid * 8 + wave, gtid = bid * 512 + tid;
        const int l = (st - 1) / NSUB, subx = (st - 1) - l * NSUB, sub = (st == 0) ? 100 : (st == NSTEP - 1) ? 101 : ((PROBE_REP_SUB >= 0 && subx > PROBE_REP_SUB) ? subx - 1 : subx);
        const bool need_sync = !(sub == 3 || sub == 4 || sub == 5 || sub == 7 || sub == 8 || sub == 100);
        if (st > p.ph_lo && need_sync) xcd_barrier(xbar);
        unsigned char* ws = wsp(p);
        float* XRES = (float*)(ws + WS_XRES); bf16* HA = (bf16*)(ws + WS_HA); bf16* PROJ = (bf16*)(ws + WS_PROJ);
        bf16* MIX = (bf16*)(ws + WS_MIX); bf16* U = (bf16*)(ws + WS_U);
        const float* MOD = (const float*)(ws + WS_MOD);
        float* STQ = (float*)(ws + WS_STQ); float* STKV = (float*)(ws + WS_STKV);
        const bool last = (l == DEPTH - 1);
        const int Mtail = last ? NLAT : MTOK;
        const float* modl = MOD + (size_t)l * 9 * 6144;
        if (PROBE_SYNCS > 0 && sub == 101) { for (int i = 0; i < PROBE_SYNCS; ++i) xcd_barrier(xbar); }
        switch (sub) {
        case 100: phase_prologue(p, lds, G, bid); break;
        case 101: {
            rows_phase(p, 2, NLAT, inp(p, 25) + (DEPTH - 1) * DM, inp(p, 26) + (DEPTH - 1) * DM, modl, 0, 0, gw, ngw, lane);
        } break;
        case 0: {
            const float* lg = (l == 0) ? nullptr : inp(p, 25) + (l - 1) * DM; const float* lb = (l == 0) ? nullptr : inp(p, 26) + (l - 1) * DM;
            rows_phase(p, l == 0 ? 0 : 1, MTOK, lg, lb, modl, 1024, 0, gw, ngw, lane);
            phase_convert(p, l, lds, gw, ngw, lane, gtid, gthreads);
        } break;
        case 1: {
            EpiProj E{PROJ, STQ, STKV};
            run_gemm<DM, DM, DM, MTOK, NPROJ>(lds, HA, (const bf16*)(ws + WS_WIN), G, bid, E);
            if (l == 0 && G == 256 && bid >= 176) cs_tables(p, (bid - 176) * 512 + otid(), 80 * 512);
        } break;
        case 2: {
            EpiQK E{(bf16*)(ws + WS_QLAT), (bf16*)(ws + WS_QCTX), (bf16*)(ws + WS_K), STQ, STKV, (const float*)(ws + WS_ROPE)};
            run_gemm<NPROJ, 384, 384, MTOK, 1280>(lds, PROJ, (const bf16*)(ws + WS_WQK), G, bid, E);
        } break;
        case 3: {
            EpiVt E{(bf16*)(ws + WS_VT), STKV};
            run_gemm<384, NPROJ, 384, 512, MTOK>(lds, (const bf16*)(ws + WS_WV), PROJ, G, (bid + G - 104) % G, E);
        } break;
        case 4: {
            EpiGt E{(bf16*)(ws + WS_GTL), (bf16*)(ws + WS_GTC)};
            run_gemm<256, NPROJ, 256, 512, MTOK>(lds, (const bf16*)(ws + WS_WF), PROJ + PO_F, G, (bid + G - 104) % G, E);
        } break;
        case 5: {
            int first, cnt;
            if (G == 256) { if (bid < 104) { first = bid * 5; cnt = 5; } else if (bid < 248) { first = 520 + (bid - 104) * 4; cnt = 4; } else { first = 1096 + (bid - 248) * 7; cnt = 7; } }
            else { first = bid; cnt = (1152 - bid + G - 1) / G; }
            for (int k = 0; k < cnt; ++k) { const int it = (G == 256) ? first + k : first + k * G;
                if (it < 576) sgu_item(p, l, it >> 2, it & 3, lds); else pool_item(p, l, (it - 576) >> 2, (it - 576) & 3, lds); }
            krope_items(p, gtid, gthreads);
        } break;
        case 6: {
            EpiDft E{MIX, 0, SEQ};
            run_gemm<4096, 4096, 4096, 2048, 2048>(lds, (const bf16*)(ws + WS_CSL), (const bf16*)(ws + WS_GTL), G, vcu, E);
        } break;
        case 7: {
            if (!last) { EpiDft E{MIX, NLAT, CTXL};
              StaticOrderSig<256, 2048> S{G, (vcu + G - 64) % G, (unsigned*)(ws + WS_CTL) + CW_ECTX};
              run_gemm_s<512, 512, 512>(lds, (const bf16*)(ws + WS_CSC), (const bf16*)(ws + WS_GTC), 256, 2048, S, E); }
        } break;
        case 8: {
            if (G == 256) {
                int first, cnt, citem = -1;
                if (vcu < 64) { first = 2 * vcu; cnt = 2; } else if (vcu < 72) { first = 128 + 5 * (vcu - 64); cnt = 5; }
                else if (vcu < 104) { first = 168 + 3 * (vcu - 72); cnt = 3; } else { first = 264 + 5 * (vcu - 104); cnt = 5; if (!last && vcu < 232) citem = 1024 + (vcu - 104); }
                if (citem >= 0) attn_any(p, citem, lds);
                for (int k = 0; k < cnt; ++k) attn_any(p, first + k, lds);
                if (!last) {
                    SchedHC S{vcu + 152, (unsigned*)(ws + WS_CTL) + CW_ECTX, 136u * (unsigned)(l + 1)};
                    EpiRes E2{(l == 0) ? inp(p, 2) : XRES + (size_t)NLAT * DM, XRES + (size_t)NLAT * DM, (const float*)(ws + WS_ST) + 2 * NLAT, (l == 0) ? nullptr : inp(p, 25) + (l - 1) * DM, (l == 0) ? nullptr : inp(p, 26) + (l - 1) * DM, modl, 2048, 64};
                    run_gemm_s<MIXD, MIXD, MIXD>(lds, MIX + (size_t)NLAT * MIXD, (const bf16*)(ws + WS_WOUT), NCTX, DM, S, E2);
                }
            } else {
                for (int it = vcu; it < (last ? 1024 : 1152); it += G) attn_any(p, it, lds);
            }
        } break;
        case 9: {
            EpiRes E{(l == 0) ? inp(p, 0) : XRES, XRES, (const float*)(ws + WS_ST), (l == 0) ? nullptr : inp(p, 25) + (l - 1) * DM, (l == 0) ? nullptr : inp(p, 26) + (l - 1) * DM, modl, 2048, 0};
            if (last || G == 256) run_gemm<MIXD, MIXD, MIXD, NLAT, DM>(lds, MIX, (const bf16*)(ws + WS_WOUT), G, bid, E);
            else run_gemm<MIXD, MIXD, MIXD, MTOK, DM>(lds, MIX, (const bf16*)(ws + WS_WOUT), G, bid, E);
        } break;
        case 10: {
            rows_phase(p, 1, Mtail, inp(p, 20) + l * DM, inp(p, 21) + l * DM, modl, 4096, 3072, gw, ngw, lane);
        } break;
        case 11: {
            EpiSwiglu E{U};
            if (last || G != 256) {
                if (last) run_gemm<DM, DM, DM, NLAT, 2 * DFF>(lds, HA, (const bf16*)(ws + WS_W13), G, bid, E);
                else run_gemm<DM, DM, DM, MTOK, 2 * DFF>(lds, HA, (const bf16*)(ws + WS_W13), G, bid, E);
            } else {
                unsigned* cnt = (unsigned*)(ws + WS_CTL) + CW_GCTX;
                { SchedG S{bid, cnt}; run_gemm_s<DM, DM, DM>(lds, HA, (const bf16*)(ws + WS_W13), MTOK, 2 * DFF, S, E); }
                { SchedHC S{bid, cnt, 176u * (unsigned)(l + 1)}; EpiRes E2{XRES + (size_t)NLAT * DM, XRES + (size_t)NLAT * DM, (const float*)(ws + WS_ST) + 2 * NLAT, inp(p, 20) + l * DM, inp(p, 21) + l * DM, modl, 5120, 64};
                  run_gemm_s<DFF, DFF, DFF>(lds, U + (size_t)NLAT * DFF, (const bf16*)(ws + WS_W2), NCTX, DM, S, E2); }
                mod_items(p, lds, l + 1, l + 2, G, bid - 112 < 0 ? (1 << 20) : bid - 112);
            }
        } break;
        case 12: {
            EpiRes E{XRES, XRES, (const float*)(ws + WS_ST), inp(p, 20) + l * DM, inp(p, 21) + l * DM, modl, 5120, 0};
            if (last || G == 256) run_gemm<DFF, DFF, DFF, NLAT, DM>(lds, U, (const bf16*)(ws + WS_W2), G, bid, E);
            else run_gemm<DFF, DFF, DFF, MTOK, DM>(lds, U, (const bf16*)(ws + WS_W2), G, bid, E);
        } break;
        }
        __syncthreads();
    }
}

#ifndef MK_SPLIT
#define MK_SPLIT 0
#endif
extern "C" void kernel_launch(void* const* d_in, const int* in_sizes, int n_in, void* d_out, int out_size, void* d_ws, size_t ws_size, hipStream_t stream) {
    static int grid = 0;
    if (grid == 0) {
        if (n_in != 27 || out_size != NLAT * DM || ws_size < WS_END) { fprintf(stderr, "kernel_launch: unexpected shapes / workspace (%d inputs, out %d, ws %zu < %zu)\n", n_in, out_size, ws_size, (size_t)WS_END); grid = -1; return; }
        int dev = 0, cus = 0, per_cu = 0;
        hipGetDevice(&dev);
        hipDeviceGetAttribute(&cus, hipDeviceAttributeMultiprocessorCount, dev);
        hipFuncSetAttribute((const void*)mk_fwd, hipFuncAttributeMaxDynamicSharedMemorySize, LDS_BYTES);
        hipOccupancyMaxActiveBlocksPerMultiprocessor(&per_cu, (const void*)mk_fwd, 512, LDS_BYTES);
        if (per_cu < 1) { fprintf(stderr, "kernel_launch: occupancy query reports %d blocks per CU\n", per_cu); per_cu = 1; }
        grid = cus * 1;
        (void)hipGetLastError();
    }
    if (grid < 0) return;
    if (hipMemsetAsync((char*)d_ws + WS_CTL, 0, CTL_BYTES, stream) != hipSuccess) { fprintf(stderr, "kernel_launch: memset failed\n"); return; }
    Params p{};
    for (int i = 0; i < 27; ++i) p.in[i] = (const float*)d_in[i];
    p.out = (float*)d_out; p.ws = (unsigned char*)d_ws;
#if MK_SPLIT
    for (int ph = 0; ph < NSTEP; ++ph) {
        p.ph_lo = ph; p.ph_hi = ph + 1;
        void* args[] = {&p};
        hipError_t e = hipLaunchCooperativeKernel((const void*)mk_fwd, dim3(grid), dim3(512), args, LDS_BYTES, stream);
        if (e != hipSuccess) { fprintf(stderr, "cooperative launch failed: %s\n", hipGetErrorString(e)); return; }
    }
#else
    p.ph_lo = 0; p.ph_hi = NSTEP;
    void* args[] = {&p};
    hipError_t e = hipLaunchCooperativeKernel((const void*)mk_fwd, dim3(grid), dim3(512), args, LDS_BYTES, stream);
    if (e != hipSuccess) fprintf(stderr, "cooperative launch failed: %s (grid %d)\n", hipGetErrorString(e), grid);
#endif
}
```

```cpp
#include <hip/hip_runtime.h>
#include <hip/hip_cooperative_groups.h>
#include <cstdio>
#include <cstdint>
namespace cg = cooperative_groups;
__device__ __forceinline__ int otid() { int t = threadIdx.x; asm volatile("" : "+v"(t)); return t; }
namespace pg8 {
#define PG8_LAS __attribute__((address_space(3)))
typedef unsigned short bf16_t;
typedef short bf16x8 __attribute__((ext_vector_type(8)));
typedef float f32x4 __attribute__((ext_vector_type(4)));
typedef unsigned u32x4 __attribute__((ext_vector_type(4)));
constexpr int BM = 256, BK = 64, HALF = 128, HTB = HALF * BK * 2  , STAGE_BYTES = 8 * HTB, NXCD = 8, WGM = 8;

__host__ __device__ __forceinline__ int lds_byte(int r, int c) { const int st = (r >> 4) * 2 + (c >> 5), rr = r & 15, cc = c & 31, ob = rr * 64 + cc * 2; return st * 1024 + (ob ^ (((ob >> 9) & 1) << 5)); }
__host__ __device__ __forceinline__ void stage_rc(int b, int& R, int& C) { const int st = b / 1024, sb = b % 1024, swz = sb ^ (((sb >> 9) & 1) << 5); R = (st >> 1) * 16 + swz / 64; C = (st & 1) * 32 + (swz % 64) / 2; }
__host__ __device__ __forceinline__ int perm32(int rho) { const int n = rho >> 4, i = rho & 15; return 8 * (i >> 2) + 4 * n + (i & 3); }

struct Unit { int pm, pn; };
struct Gemm { const bf16_t* A; const bf16_t* Bt; int M, N; };

struct StaticOrder {
    int nM, nN, nwg, G, c;
    __host__ __device__ void init(int M, int N, int G_, int c_) { nM = M / BM; nN = N / BM; nwg = nM * nN; G = G_; c = c_; }
    __host__ __device__ bool next(int i, Unit& u) const {
        const long L = (long)i * G + c; if (L >= nwg) return false;
        int wgid = (int)L; { const int q = nwg / NXCD, r = nwg % NXCD, xcd = wgid % NXCD, off = wgid / NXCD; wgid = (xcd < r ? xcd * (q + 1) : r * (q + 1) + (xcd - r) * q) + off; }
        const int nig = WGM * nN, gid = wgid / nig, fm = gid * WGM, gsz = (nM - fm) < WGM ? (nM - fm) : WGM;
        u.pm = fm + ((wgid % nig) % gsz); u.pn = (wgid % nig) / gsz; return true;
    }
    __device__ __forceinline__ void a_ready(const Unit&) const {}
    __device__ __forceinline__ void done(const Unit&) const {}
};


template <class Epi, class Sched, bool ALIGN_EPI, bool SP2, int LDA, int LDB, int KDIM>
__device__ __forceinline__ void gemm_phase(PG8_LAS unsigned char* lds, const Gemm g, const Sched& S, const Epi& E) {
    const int tid = otid(), wid = __builtin_amdgcn_readfirstlane(tid >> 6), lane = tid & 63, wr = wid >> 2, wc = wid & 3, fr = lane & 15, fq = lane >> 4;
    constexpr int K = KDIM, nt = K / BK;
    unsigned voffA[2], voffB[2];
#pragma unroll
    for (int i = 0; i < 2; ++i) { int R, C; stage_rc(tid * 16 + i * 8192, R, C); const int Rb = Epi::PERM ? ((R & ~31) + perm32(R & 31)) : R;
        voffA[i] = (unsigned)(R * LDA + C) * 2u; voffB[i] = (unsigned)(Rb * LDB + C) * 2u; }
    constexpr size_t kstep = (size_t)(BK * 2);
    constexpr size_t hstepA = (size_t)HALF * LDA * 2, hstepB = (size_t)HALF * LDB * 2;
    constexpr size_t tstepA = 2 * hstepA, tstepB = 2 * hstepB;
    const unsigned ldsw = (unsigned)wid * 1024u;
    const int aoff = lds_byte(wr * 64 + fr, fq * 8), boff = lds_byte(wc * 32 + fr, fq * 8);
#define PG8_SA(b, h) (((b) * 2 + (h)) * HTB)
#define PG8_SB(b, h) ((4 + (b) * 2 + (h)) * HTB)
#define PG8_STAGE(bufoff, gbase, voff) do { _Pragma("unroll") for (int _i = 0; _i < 2; ++_i) \
        __builtin_amdgcn_global_load_lds((const unsigned*)((const char*)(gbase) + (voff)[_i]), (PG8_LAS unsigned*)(lds + (bufoff) + ldsw + _i * 8192), 16, 0, 0); } while (0)
#define PG8_LDA(dst, b, h) do { _Pragma("unroll") for (int m = 0; m < 4; ++m) _Pragma("unroll") for (int k = 0; k < 2; ++k) dst[m][k] = *(const PG8_LAS bf16x8*)(lds + PG8_SA(b, h) + aoff + m * 2048 + k * 1024); } while (0)
#define PG8_LDB(dst, b, h) do { _Pragma("unroll") for (int n = 0; n < 2; ++n) _Pragma("unroll") for (int k = 0; k < 2; ++k) dst[n][k] = *(const PG8_LAS bf16x8*)(lds + PG8_SB(b, h) + boff + n * 2048 + k * 1024); } while (0)
#define PG8_MMA(ai, bj, At, Bt) do { __builtin_amdgcn_s_setprio(1); _Pragma("unroll") for (int m = 0; m < 4; ++m) _Pragma("unroll") for (int n = 0; n < 2; ++n) _Pragma("unroll") for (int k = 0; k < 2; ++k) \
        acc[ai][bj][m][n] = __builtin_amdgcn_mfma_f32_16x16x32_bf16(Bt[n][k], At[m][k], acc[ai][bj][m][n], 0, 0, 0); __builtin_amdgcn_s_setprio(0); } while (0)
#define PG8_WAIT_V(n) asm volatile("s_waitcnt vmcnt(" #n ")" ::: "memory")
#define PG8_WAIT_L(n) asm volatile("s_waitcnt lgkmcnt(" #n ")" ::: "memory")
#define PG8_BAR __builtin_amdgcn_s_barrier()
#define PG8_SCHED __builtin_amdgcn_sched_barrier(0)
    Unit cur, nxt; int ui = 0;
    if (!S.next(0, cur)) return;
    float zf = 0.f; asm volatile("" : "+v"(zf));
    f32x4 acc[2][2][4][2];
#pragma unroll
    for (int a = 0; a < 2; ++a)
#pragma unroll
        for (int b = 0; b < 2; ++b)
#pragma unroll
            for (int m = 0; m < 4; ++m)
#pragma unroll
                for (int n = 0; n < 2; ++n) acc[a][b][m][n] = (f32x4){zf, zf, zf, zf};
    bf16x8 At[4][2], B0[2][2], B1[2][2];
    const char* cA = (const char*)g.A + (size_t)cur.pm * tstepA; const char* cB = (const char*)g.Bt + (size_t)cur.pn * tstepB;
    S.a_ready(cur);
    if constexpr (SP2) {
        PG8_STAGE(PG8_SB(0, 0), cB, voffB); PG8_STAGE(PG8_SB(0, 1), cB + hstepB, voffB); PG8_STAGE(PG8_SA(0, 0), cA, voffA); PG8_STAGE(PG8_SA(0, 1), cA + hstepA, voffA);
        if (wr == 1) PG8_BAR;
        PG8_WAIT_V(2); PG8_BAR;
        PG8_STAGE(PG8_SB(1, 0), cB + kstep, voffB); PG8_STAGE(PG8_SA(1, 0), cA + kstep, voffA); PG8_STAGE(PG8_SB(1, 1), cB + hstepB + kstep, voffB);
        PG8_WAIT_V(6); PG8_BAR;
    } else {
        PG8_STAGE(PG8_SB(0, 0), cB, voffB); PG8_STAGE(PG8_SA(0, 0), cA, voffA); PG8_STAGE(PG8_SB(0, 1), cB + hstepB, voffB); PG8_STAGE(PG8_SA(0, 1), cA + hstepA, voffA);
        if (wr == 1) PG8_BAR;
        PG8_WAIT_V(4); PG8_BAR;
        PG8_STAGE(PG8_SB(1, 0), cB + kstep, voffB); PG8_STAGE(PG8_SA(1, 0), cA + kstep, voffA); PG8_STAGE(PG8_SB(1, 1), cB + hstepB + kstep, voffB);
        PG8_WAIT_V(6); PG8_BAR;
    }
    for (;;) {
        const bool has_next = S.next(ui + 1, nxt);
        const char* nA = has_next ? (const char*)g.A + (size_t)nxt.pm * tstepA : cA; const char* nB = has_next ? (const char*)g.Bt + (size_t)nxt.pn * tstepB : cB;
#pragma nounroll
        for (int t = 0; t < nt; t += 2) {
            const bool last = (t == nt - 2);
            const char* a1 = cA + (size_t)(t + 1) * kstep;
            const char* a2 = last ? nA : cA + (size_t)(t + 2) * kstep; const char* b2 = last ? nB : cB + (size_t)(t + 2) * kstep;
            const char* a3 = a2 + kstep; const char* b3 = b2 + kstep;
            if (last && has_next) S.a_ready(nxt);
            if constexpr (SP2) {
            PG8_LDB(B0, 0, 0); PG8_LDB(B1, 0, 1); PG8_SCHED; PG8_LDA(At, 0, 0); PG8_STAGE(PG8_SA(1, 1), a1 + hstepA, voffA);
            PG8_WAIT_V(8); PG8_WAIT_L(0); PG8_BAR; PG8_MMA(0, 0, At, B0); PG8_MMA(0, 1, At, B1); PG8_BAR; PG8_SCHED;
            PG8_LDA(At, 0, 1); PG8_STAGE(PG8_SB(0, 0), b2, voffB); PG8_STAGE(PG8_SB(0, 1), b2 + hstepB, voffB); PG8_STAGE(PG8_SA(0, 0), a2, voffA);
            PG8_WAIT_V(8); PG8_WAIT_L(0); PG8_BAR; PG8_MMA(1, 0, At, B0); PG8_MMA(1, 1, At, B1); PG8_BAR; PG8_SCHED;
            PG8_LDB(B0, 1, 0); PG8_LDB(B1, 1, 1); PG8_SCHED; PG8_LDA(At, 1, 0); PG8_STAGE(PG8_SA(0, 1), a2 + hstepA, voffA);
            PG8_WAIT_V(8); PG8_WAIT_L(0); PG8_BAR; PG8_MMA(0, 0, At, B0); PG8_MMA(0, 1, At, B1); PG8_BAR; PG8_SCHED;
            PG8_LDA(At, 1, 1); PG8_STAGE(PG8_SB(1, 0), b3, voffB); PG8_STAGE(PG8_SB(1, 1), b3 + hstepB, voffB); PG8_STAGE(PG8_SA(1, 0), a3, voffA);
            PG8_WAIT_V(8); PG8_WAIT_L(0); PG8_BAR; PG8_MMA(1, 0, At, B0); PG8_MMA(1, 1, At, B1); PG8_BAR; PG8_SCHED;
            } else {
            PG8_LDB(B0, 0, 0); PG8_SCHED; PG8_LDA(At, 0, 0); PG8_STAGE(PG8_SA(1, 1), a1 + hstepA, voffA);
            PG8_WAIT_L(8); PG8_BAR; PG8_WAIT_L(0); PG8_MMA(0, 0, At, B0); PG8_BAR; PG8_SCHED;
            PG8_LDB(B1, 0, 1); PG8_STAGE(PG8_SB(0, 0), b2, voffB);
            PG8_BAR; PG8_WAIT_L(0); PG8_MMA(0, 1, At, B1); PG8_BAR;
            PG8_LDA(At, 0, 1); PG8_STAGE(PG8_SA(0, 0), a2, voffA);
            PG8_BAR; PG8_WAIT_L(0); PG8_MMA(1, 0, At, B0); PG8_BAR; PG8_SCHED;
            PG8_STAGE(PG8_SB(0, 1), b2 + hstepB, voffB);
            PG8_WAIT_V(6); PG8_BAR; PG8_MMA(1, 1, At, B1); PG8_BAR;
            PG8_LDB(B0, 1, 0); PG8_SCHED; PG8_LDA(At, 1, 0); PG8_STAGE(PG8_SA(0, 1), a2 + hstepA, voffA);
            PG8_WAIT_L(8); PG8_BAR; PG8_WAIT_L(0); PG8_MMA(0, 0, At, B0); PG8_BAR; PG8_SCHED;
            PG8_LDB(B1, 1, 1); PG8_STAGE(PG8_SB(1, 0), b3, voffB);
            PG8_BAR; PG8_WAIT_L(0); PG8_MMA(0, 1, At, B1); PG8_BAR;
            PG8_LDA(At, 1, 1); PG8_STAGE(PG8_SA(1, 0), a3, voffA);
            PG8_BAR; PG8_WAIT_L(0); PG8_MMA(1, 0, At, B0); PG8_BAR; PG8_SCHED;
            PG8_STAGE(PG8_SB(1, 1), b3 + hstepB, voffB);
            PG8_WAIT_V(6); PG8_BAR; PG8_MMA(1, 1, At, B1); PG8_BAR;
            }
        }
        if constexpr (ALIGN_EPI) { if (wr == 0) PG8_BAR; }
        if constexpr (!Epi::AFTER_DRAIN) { int fr2 = fr, fq2 = fq; asm volatile("" : "+v"(fr2), "+v"(fq2));
            E(acc, cur, wr, wc, fr2, fq2); S.done(cur); }
        if (!has_next) break;
#pragma unroll
        for (int a = 0; a < 2; ++a)
#pragma unroll
            for (int b = 0; b < 2; ++b)
#pragma unroll
                for (int m = 0; m < 4; ++m)
#pragma unroll
                    for (int n = 0; n < 2; ++n) acc[a][b][m][n] = (f32x4){zf, zf, zf, zf};
        cur = nxt; cA = nA; cB = nB; ++ui;
        if constexpr (ALIGN_EPI) { if (wr == 1) PG8_BAR; }
    }
    PG8_WAIT_V(0);
    if constexpr (!ALIGN_EPI) { if (wr == 0) PG8_BAR; }
    PG8_BAR;
    if constexpr (Epi::AFTER_DRAIN) { E.fused(acc, cur, wr, wc, fr, fq, lds, wid, lane); S.done(cur); }
#undef PG8_SA
#undef PG8_SB
#undef PG8_STAGE
#undef PG8_LDA
#undef PG8_LDB
#undef PG8_MMA
#undef PG8_WAIT_V
#undef PG8_WAIT_L
#undef PG8_BAR
#undef PG8_SCHED
}
}

#define LAS __attribute__((address_space(3)))
typedef unsigned short bf16;
typedef float f32x2 __attribute__((ext_vector_type(2)));
typedef float f32x4 __attribute__((ext_vector_type(4)));
typedef float f32x16 __attribute__((ext_vector_type(16)));
typedef short bf16x8 __attribute__((ext_vector_type(8)));
typedef unsigned u32x4 __attribute__((ext_vector_type(4)));
typedef unsigned u32x2 __attribute__((ext_vector_type(2)));
typedef __bf16 bf16x2_t __attribute__((ext_vector_type(2)));
#define DI __device__ __forceinline__

DI unsigned pk2(float lo, float hi) { f32x2 v = {lo, hi}; bf16x2_t b = __builtin_convertvector(v, bf16x2_t); return __builtin_bit_cast(unsigned, b); }
DI float bflo(unsigned u) { return __uint_as_float(u << 16); }
DI float bfhi(unsigned u) { return __uint_as_float(u & 0xffff0000u); }
DI u32x4 pack8(f32x4 a, f32x4 b) { u32x4 w; w.x = pk2(a[0], a[1]); w.y = pk2(a[2], a[3]); w.z = pk2(b[0], b[1]); w.w = pk2(b[2], b[3]); return w; }
DI float shx(float v, int m) { const int l = (otid() & 63) ^ m; return __builtin_bit_cast(float, __builtin_amdgcn_ds_bpermute(l << 2, __builtin_bit_cast(int, v))); }
DI float wave_sum(float v) {
#pragma unroll
    for (int o = 1; o < 64; o <<= 1) v += shx(v, o);
    return v;
}
DI float ozero() { float z = 0.f; asm volatile("" : "+v"(z)); return z; }
DI float cos_turn(float t) { return __builtin_amdgcn_cosf(t); }
DI float sin_turn(float t) { return __builtin_amdgcn_sinf(t); }
DI float fexp2(float x) { return __builtin_amdgcn_exp2f(x); }
DI float frcp(float x) { return __builtin_amdgcn_rcpf(x); }
#define LDS_WAIT() asm volatile("s_waitcnt lgkmcnt(0)" ::: "memory")

constexpr int DM = 1024, NB = 8, SEQ = 2048, DEPTH = 4, CTXL = 256;
constexpr int NLAT = NB * SEQ, NCTX = NB * CTXL, MTOK = NLAT + NCTX;
constexpr int NPROJ = 1536, DFF = 2816, MIXD = 1280, NKEY = SEQ + CTXL;
constexpr int PO_KR = 384, PO_SU = 416, PO_SV = 672, PO_POOL = 928, PO_F = 1184, IN_DIM = 1440;
constexpr float LN_EPS = 1e-6f;
constexpr float ALPHA = 1.6817928305074290f;
constexpr float QSCALE = 0.10206207261596575f * 1.4426950408889634f;

constexpr size_t WS_XRES = 0;
constexpr size_t WS_HA   = WS_XRES + (size_t)MTOK * DM * 4;
constexpr size_t WS_PROJ = WS_HA + (size_t)MTOK * DM * 2;
constexpr size_t WS_QLAT = WS_PROJ + (size_t)MTOK * NPROJ * 2;
constexpr size_t WS_QCTX = WS_QLAT + (size_t)64 * SEQ * 96 * 2;
constexpr size_t WS_K    = WS_QCTX + (size_t)64 * CTXL * 96 * 2;
constexpr size_t WS_VT   = WS_K + (size_t)64 * NKEY * 96 * 2;
constexpr size_t WS_U    = WS_PROJ;
static_assert((size_t)MTOK * DFF * 2 <= WS_VT - WS_PROJ, "U overlay");
constexpr size_t WS_GTL  = WS_VT + (size_t)64 * 64 * NKEY * 2;
constexpr size_t WS_GTC  = WS_GTL + (size_t)2048 * 4096 * 2;
constexpr size_t WS_MIX  = WS_GTC + (size_t)2048 * 512 * 2;
constexpr size_t WS_WIN  = WS_MIX + (size_t)MTOK * MIXD * 2;
constexpr size_t WS_WQK  = WS_WIN + (size_t)1536 * 1024 * 2;
constexpr size_t WS_WV   = WS_WQK + (size_t)1280 * 384 * 2;
constexpr size_t WS_WF   = WS_WV + (size_t)512 * 384 * 2;
constexpr size_t WS_WOUT = WS_WF + (size_t)512 * 256 * 2;
constexpr size_t WS_W13  = WS_WOUT + (size_t)1024 * 1280 * 2;
constexpr size_t WS_W2   = WS_W13 + (size_t)5632 * 1024 * 2;
constexpr size_t WS_WPOOL= WS_W2 + (size_t)1024 * 2816 * 2;
constexpr size_t WS_WS   = WS_WPOOL + (size_t)4 * 64 * 64 * 2;
constexpr size_t WS_CSL  = WS_WS + (size_t)4 * 128 * 128 * 2;
constexpr size_t WS_CSC  = WS_CSL + (size_t)2048 * 4096 * 2;
constexpr size_t WS_MOD  = WS_CSC + (size_t)256 * 512 * 2;
constexpr size_t WS_ROPE = WS_MOD + (size_t)4 * 9 * 6144 * 4;
constexpr size_t WS_STQ  = WS_ROPE + (size_t)2048 * 32 * 4;
constexpr size_t WS_STKV = WS_STQ + (size_t)MTOK * 4 * 4;
constexpr size_t WS_ST   = WS_STKV + (size_t)MTOK * 4 * 4;
constexpr size_t WS_CTL  = WS_ST + (size_t)MTOK * 2 * 4;
constexpr size_t CTL_BYTES = 16384;
constexpr size_t WS_END  = WS_CTL + CTL_BYTES;
constexpr int MISC_OFF = 139264;

constexpr int LDS_BYTES = 147456;

struct Params { const float* in[27]; float* out; unsigned char* ws; int ph_lo, ph_hi; };
DI const float* inp(const Params& p, int i) { asm volatile("" : "+s"(i)); return p.in[i]; }
DI unsigned char* wsp(const Params& p) { unsigned char* w = p.ws; asm volatile("" : "+s"(w)); return w; }

#define XB_TMO      128
#define XB_XCNT(j)  (256  + 64 * (j))
#define XB_XSUB(j)  (1280 + 64 * (j))
#define XB_XGEN(j)  (2304 + 64 * (j))
#define XB_TOP      3328
#define XB_TOPGEN   3392
#define XCD_BAR_WORDS 3456
#define XB_SPIN_CAP (1u << 18)

__device__ __forceinline__ unsigned xb_ld(unsigned* p)              { return __hip_atomic_load(p, __ATOMIC_RELAXED, __HIP_MEMORY_SCOPE_AGENT); }
__device__ __forceinline__ unsigned xb_add(unsigned* p, unsigned v) { return __hip_atomic_fetch_add(p, v, __ATOMIC_RELAXED, __HIP_MEMORY_SCOPE_AGENT); }
__device__ __forceinline__ unsigned xb_xcc_id() { return (unsigned)__builtin_amdgcn_s_getreg((3 << 11) | 20) & 0xFu; }
#define XB_SPIN(cond, bar) do { unsigned _sp = 0; while (cond) { __builtin_amdgcn_s_sleep(1); \
    if ((++_sp & 255u) == 0u) { if (xb_ld(&(bar)[XB_TMO])) break; if (_sp > XB_SPIN_CAP) { atomicAdd(&(bar)[XB_TMO], 1u); break; } } } } while (0)

struct XcdBarrier {
    unsigned* bar; unsigned x;
    volatile LAS unsigned* st;
};

__device__ __forceinline__ XcdBarrier xcd_barrier_post(unsigned* bar, volatile LAS unsigned* st) {
    XcdBarrier b; b.bar = bar; b.x = xb_xcc_id(); b.st = st;
    if (threadIdx.x == 0) (void)xb_add(&bar[XB_XCNT(b.x)], 1u);
    return b;
}
__device__ __forceinline__ void xcd_barrier_complete(unsigned* bar, unsigned x, unsigned& nloc, unsigned& nx) {
    const unsigned G = gridDim.x * gridDim.y * gridDim.z;
    unsigned sum, cnt, mine, sp = 0u;
    for (;;) {
        sum = 0u; cnt = 0u; mine = 0u;
#pragma unroll
        for (unsigned j = 0; j < 16; ++j) { const unsigned c = xb_ld(&bar[XB_XCNT(j)]); sum += c; cnt += (c > 0u) ? 1u : 0u; mine = (j == x) ? c : mine; }
        if (sum == G) break;
        __builtin_amdgcn_s_sleep(1);
        if ((++sp & 255u) == 0u) { if (xb_ld(&bar[XB_TMO])) break; if (sp > XB_SPIN_CAP) { atomicAdd(&bar[XB_TMO], 1u); break; } }
    }
    nloc = mine > 0u ? mine : 1u; nx = cnt > 0u ? cnt : 1u;
}

__device__ __forceinline__ void xcd_barrier(const XcdBarrier& b) {
    asm volatile("s_waitcnt vmcnt(0)" ::: "memory");
    __syncthreads();
    if (threadIdx.x == 0) {
        unsigned* bar = b.bar;
        __builtin_amdgcn_s_waitcnt(0);
        unsigned nloc = b.st[0], nx = b.st[1];
        if (nloc == 0u) { xcd_barrier_complete(bar, b.x, nloc, nx); b.st[0] = nloc; b.st[1] = nx; }
        const unsigned old = xb_add(&bar[XB_XSUB(b.x)], 1u);
        const unsigned gen = old / nloc;
        if (old + 1u == (gen + 1u) * nloc) {
            __builtin_amdgcn_fence(__ATOMIC_RELEASE, "agent");
            asm volatile("s_waitcnt vmcnt(0)" ::: "memory");
            const unsigned og = xb_add(&bar[XB_TOP], 1u);
            const unsigned tg = og / nx;
            if (og + 1u == (tg + 1u) * nx) xb_add(&bar[XB_TOPGEN], 1u);
            else XB_SPIN(xb_ld(&bar[XB_TOPGEN]) == tg, bar);
            __builtin_amdgcn_fence(__ATOMIC_ACQUIRE, "agent");
            xb_add(&bar[XB_XGEN(b.x)], 1u);
            asm volatile("s_waitcnt vmcnt(0)" ::: "memory");
        } else {
            XB_SPIN(xb_ld(&bar[XB_XGEN(b.x)]) == gen, bar);
            __builtin_amdgcn_fence(__ATOMIC_ACQUIRE, "agent");
            asm volatile("s_waitcnt vmcnt(0)" ::: "memory");
        }
    }
    __syncthreads();
}

typedef pg8::f32x4 A4;
DI void row_info(int row, int& b, int& pos, bool& lat) { lat = row < NLAT; if (lat) { b = row >> 11; pos = row & 2047; } else { b = (row - NLAT) >> 8; pos = (row - NLAT) & 255; } }

struct EpiProj {
    static constexpr bool PERM = true, AFTER_DRAIN = false;
    bf16* O; float* statq; float* statkv;
    DI void operator()(const A4 (&acc)[2][2][4][2], const pg8::Unit& u, int wr, int wc, int fr, int fq) const {
        const int row0 = u.pm * 256 + wr * 64 + fr, col0 = u.pn * 256 + wc * 32 + 8 * fq;
#pragma unroll
        for (int ai = 0; ai < 2; ++ai)
#pragma unroll
            for (int m = 0; m < 4; ++m) {
                const int row = row0 + ai * 128 + m * 16;
                bf16* rowp = O + (size_t)row * NPROJ + col0;
#pragma unroll
                for (int bj = 0; bj < 2; ++bj) *(u32x4*)(rowp + bj * 128) = pack8(acc[ai][bj][m][0], acc[ai][bj][m][1]);
                if (u.pn <= 1) {
                    float s = 0.f;
#pragma unroll
                    for (int bj = 0; bj < 2; ++bj) {
                        if (u.pn == 1 && bj == 1) continue;
#pragma unroll
                        for (int n = 0; n < 2; ++n) { const A4 x = acc[ai][bj][m][n]; s += (x[0] * x[0] + x[1] * x[1]) + (x[2] * x[2] + x[3] * x[3]); }
                    }
                    s += shx(s, 16); s += shx(s, 32);
                    if (fq == 0) { if (u.pn == 0) statq[row * 4 + wc] = s; else statkv[row * 4 + wc] = s; }
                }
            }
    }
};

struct EpiQK {
    static constexpr bool PERM = true, AFTER_DRAIN = false;
    bf16* Ql; bf16* Qc; bf16* Kb; const float* statq; const float* statkv; const float* rope;
    DI void operator()(const A4 (&acc)[2][2][4][2], const pg8::Unit& u, int wr, int wc, int fr, int fq) const {
        const int row0 = u.pm * 256 + wr * 64 + fr, col0 = u.pn * 256 + wc * 32 + 8 * fq;
        const bool isq = u.pn < 3;
#pragma unroll
        for (int ai = 0; ai < 2; ++ai)
#pragma unroll
            for (int m = 0; m < 4; ++m) {
                const int row = row0 + ai * 128 + m * 16;
                int b, pos; bool lat; row_info(row, b, pos, lat);
                const f32x4 st = *(const f32x4*)((isq ? statq : statkv) + row * 4);
                const float ss = (st[0] + st[1]) + (st[2] + st[3]);
                const float rs = isq ? rsqrtf(ss * (1.f / 256.f) + LN_EPS) * QSCALE : rsqrtf(ss * (1.f / 128.f) + LN_EPS);
#pragma unroll
                for (int bj = 0; bj < 2; ++bj) {
                    const int c = col0 + bj * 128;
                    A4 v0 = acc[ai][bj][m][0] * rs, v1 = acc[ai][bj][m][1] * rs;
                    if (isq) {
                        const int g32 = c >> 5, head = g32 / 3, part = g32 - head * 3, d0 = part * 32 + 8 * fq;
                        if (part == 2 && lat) {
                            A4 p0, p1;
#pragma unroll
                            for (int j = 0; j < 4; ++j) { p0[j] = shx(v0[j], 16); p1[j] = shx(v1[j], 16); }
                            const float* rp = rope + pos * 32 + (fq >> 1) * 8;
                            const f32x4 c0 = *(const f32x4*)rp, c1 = *(const f32x4*)(rp + 4), s0 = *(const f32x4*)(rp + 16), s1 = *(const f32x4*)(rp + 20);
                            if (fq & 1) { v0 = p0 * s0 + v0 * c0; v1 = p1 * s1 + v1 * c1; }
                            else        { v0 = v0 * c0 - p0 * s0; v1 = v1 * c1 - p1 * s1; }
                        }
                        bf16* dst = lat ? Ql + ((size_t)(b * 8 + head) * SEQ + pos) * 96 + d0 : Qc + ((size_t)(b * 8 + head) * CTXL + pos) * 96 + d0;
                        *(u32x4*)dst = pack8(v0, v1);
                    } else {
                        const int cc = c - 768, head = cc >> 6, d0 = cc & 63;
                        bf16* dst = Kb + ((size_t)(b * 8 + head) * NKEY + (lat ? CTXL + pos : pos)) * 96 + d0;
                        *(u32x4*)dst = pack8(v0, v1);
                    }
                }
            }
    }
};

DI float rstd_kv_tok(const float* statkv, int t) { const f32x4 st = *(const f32x4*)(statkv + t * 4); return rsqrtf(((st[0] + st[1]) + (st[2] + st[3])) * (1.f / 128.f) + LN_EPS); }

struct EpiVt {
    static constexpr bool PERM = true, AFTER_DRAIN = false;
    bf16* Vt; const float* statkv;
    DI void operator()(const A4 (&acc)[2][2][4][2], const pg8::Unit& u, int wr, int wc, int fr, int fq) const {
        const int row0 = u.pm * 256 + wr * 64 + fr, col0 = u.pn * 256 + wc * 32 + 8 * fq;
#pragma unroll
        for (int bj = 0; bj < 2; ++bj) {
            const int t0 = col0 + bj * 128;
            int b, pos; bool lat; row_info(t0, b, pos, lat);
            A4 r0, r1;
#pragma unroll
            for (int j = 0; j < 4; ++j) { r0[j] = rstd_kv_tok(statkv, t0 + j); r1[j] = rstd_kv_tok(statkv, t0 + 4 + j); }
#pragma unroll
            for (int ai = 0; ai < 2; ++ai)
#pragma unroll
                for (int m = 0; m < 4; ++m) {
                    const int row = row0 + ai * 128 + m * 16, head = row >> 6, dv = row & 63;
                    bf16* dst = Vt + ((size_t)(b * 8 + head) * 64 + dv) * NKEY + (lat ? CTXL + pos : pos);
                    *(u32x4*)dst = pack8(acc[ai][bj][m][0] * r0, acc[ai][bj][m][1] * r1);
                }
        }
    }
};

struct EpiGt {
    static constexpr bool PERM = true, AFTER_DRAIN = false;
    bf16* Gl; bf16* Gc;
    DI void operator()(const A4 (&acc)[2][2][4][2], const pg8::Unit& u, int wr, int wc, int fr, int fq) const {
        const int row0 = u.pm * 256 + wr * 64 + fr, col0 = u.pn * 256 + wc * 32 + 8 * fq;
#pragma unroll
        for (int bj = 0; bj < 2; ++bj) {
            const int t0 = col0 + bj * 128;
            int b, pos; bool lat; row_info(t0, b, pos, lat);
#pragma unroll
            for (int ai = 0; ai < 2; ++ai)
#pragma unroll
                for (int m = 0; m < 4; ++m) {
                    const int row = row0 + ai * 128 + m * 16, n = row & 255, half = row >> 8;
                    bf16* dst = lat ? Gl + (size_t)(b * 256 + n) * 4096 + half * 2048 + pos : Gc + (size_t)(b * 256 + n) * 512 + half * 256 + pos;
                    *(u32x4*)dst = pack8(acc[ai][bj][m][0], acc[ai][bj][m][1]);
                }
        }
    }
};

struct EpiDft {
    static constexpr bool PERM = true, AFTER_DRAIN = false;
    bf16* mix; int row_base, rows_per_b;
    DI void operator()(const A4 (&acc)[2][2][4][2], const pg8::Unit& u, int wr, int wc, int fr, int fq) const {
        const int row0 = u.pm * 256 + wr * 64 + fr, n0 = wc * 32 + 8 * fq;
#pragma unroll
        for (int ai = 0; ai < 2; ++ai)
#pragma unroll
            for (int m = 0; m < 4; ++m) {
                const int k = row0 + ai * 128 + m * 16;
                bf16* rowp = mix + (size_t)(row_base + u.pn * rows_per_b + k) * MIXD + 1024 + n0;
#pragma unroll
                for (int bj = 0; bj < 2; ++bj) *(u32x4*)(rowp + bj * 128) = pack8(acc[ai][bj][m][0], acc[ai][bj][m][1]);
            }
    }
};

struct EpiRes {
    static constexpr bool PERM = true, AFTER_DRAIN = false;
    const float* Xin; float* Xout; const float* ST; const float* lg; const float* lb; const float* modl; int goff; int pm_off;
    DI void operator()(const A4 (&acc)[2][2][4][2], const pg8::Unit& u, int wr, int wc, int fr, int fq) const {
        const int row0 = u.pm * 256 + wr * 64 + fr, col0 = u.pn * 256 + wc * 32 + 8 * fq;
        const int bidx = (u.pm + pm_off < 64) ? ((u.pm + pm_off) >> 3) : 8;
        const float* gp = modl + bidx * 6144 + goff + col0;
        f32x4 g[2][2], ga[2][2], be[2][2];
#pragma unroll
        for (int bj = 0; bj < 2; ++bj) { g[bj][0] = *(const f32x4*)(gp + bj * 128); g[bj][1] = *(const f32x4*)(gp + bj * 128 + 4); }
        const bool has_ln = lg != nullptr;
        if (has_ln) {
#pragma unroll
            for (int bj = 0; bj < 2; ++bj) { ga[bj][0] = *(const f32x4*)(lg + col0 + bj * 128) * ALPHA; ga[bj][1] = *(const f32x4*)(lg + col0 + bj * 128 + 4) * ALPHA;
                                             be[bj][0] = *(const f32x4*)(lb + col0 + bj * 128) * ALPHA; be[bj][1] = *(const f32x4*)(lb + col0 + bj * 128 + 4) * ALPHA; }
        } else {
#pragma unroll
            for (int bj = 0; bj < 2; ++bj) { ga[bj][0] = (f32x4){ALPHA, ALPHA, ALPHA, ALPHA}; ga[bj][1] = ga[bj][0]; be[bj][0] = (f32x4){0.f, 0.f, 0.f, 0.f}; be[bj][1] = be[bj][0]; }
        }
#pragma unroll
        for (int ai = 0; ai < 2; ++ai)
#pragma unroll
            for (int m = 0; m < 4; ++m) {
                const int row = row0 + ai * 128 + m * 16;
                float mean = 0.f, rstd = 1.f;
                if (has_ln) { const f32x2 st = *(const f32x2*)(ST + 2 * row); mean = st[0]; rstd = st[1]; }
                const float* rin = Xin + (size_t)row * DM + col0; float* rout = Xout + (size_t)row * DM + col0;
#pragma unroll
                for (int bj = 0; bj < 2; ++bj) {
                    f32x4 x0 = *(const f32x4*)(rin + bj * 128), x1 = *(const f32x4*)(rin + bj * 128 + 4);
                    x0 = (x0 - mean) * rstd * ga[bj][0] + be[bj][0] + g[bj][0] * acc[ai][bj][m][0];
                    x1 = (x1 - mean) * rstd * ga[bj][1] + be[bj][1] + g[bj][1] * acc[ai][bj][m][1];
                    *(f32x4*)(rout + bj * 128) = x0; *(f32x4*)(rout + bj * 128 + 4) = x1;
                }
            }
    }
};

DI f32x4 silu4(f32x4 a) { f32x4 r; for (int j = 0; j < 4; ++j) r[j] = a[j] * frcp(1.f + fexp2(-1.4426950408889634f * a[j])); return r; }
struct EpiSwiglu {
    static constexpr bool PERM = true, AFTER_DRAIN = false;
    bf16* U;
    DI void operator()(const A4 (&acc)[2][2][4][2], const pg8::Unit& u, int wr, int wc, int fr, int fq) const {
        const int row0 = u.pm * 256 + wr * 64 + fr, col0 = u.pn * 128 + wc * 32 + 8 * fq;
#pragma unroll
        for (int ai = 0; ai < 2; ++ai)
#pragma unroll
            for (int m = 0; m < 4; ++m) {
                const f32x4 h0 = silu4(acc[ai][0][m][0]) * acc[ai][1][m][0], h1 = silu4(acc[ai][0][m][1]) * acc[ai][1][m][1];
                *(u32x4*)(U + (size_t)(row0 + ai * 128 + m * 16) * DFF + col0) = pack8(h0, h1);
            }
    }
};

template <int M, int N> struct StaticOrderT {
    static constexpr int nM = M / 256, nN = N / 256, nwg = nM * nN;
    int G, c;
    static DI void map(int L, pg8::Unit& u) {
        int wgid = L; { constexpr int q = nwg / 8, r = nwg % 8; const int xcd = wgid % 8, off = wgid / 8; wgid = (xcd < r ? xcd * (q + 1) : r * (q + 1) + (xcd - r) * q) + off; }
        constexpr int nig = 8 * nN; const int gid = wgid / nig, fm = gid * 8, gsz = (nM - fm) < 8 ? (nM - fm) : 8;
        if constexpr (nM % 8 == 0) { u.pm = fm + ((wgid % nig) & 7); u.pn = (wgid % nig) >> 3; }
        else { u.pm = fm + ((wgid % nig) % gsz); u.pn = (wgid % nig) / gsz; }
    }
    DI bool next(int i, pg8::Unit& u) const { const int L = i * G + c; if (L >= nwg) return false; map(L, u); return true; }
    DI void a_ready(const pg8::Unit&) const {}
    DI void done(const pg8::Unit&) const {}
};
constexpr int CW_GCTX = 3584;
struct SchedG {
    int c; unsigned* cnt;
    DI bool next(int i, pg8::Unit& u) const {
        int L;
        if (c < 224) { L = c + 224 * i; if (L >= 1456) return false; }
        else { if (i >= 4) return false; L = 1456 + (c - 224) + 32 * i; }
        if (L < 176) { u.pm = 64 + (L & 7); u.pn = L >> 3; }
        else StaticOrderT<NLAT, 2 * DFF>::map(L - 176, u);
        return true;
    }
    DI void a_ready(const pg8::Unit&) const {}
    DI void done(const pg8::Unit& u) const {
        if (u.pm >= 64) {
            asm volatile("s_waitcnt vmcnt(0)" ::: "memory");
            __syncthreads();
            if (otid() == 0) { __builtin_amdgcn_fence(__ATOMIC_RELEASE, "agent"); asm volatile("s_waitcnt vmcnt(0)" ::: "memory"); (void)xb_add(cnt, 1u); }
        }
    }
};
constexpr int CW_ECTX = 3648;
DI void publish_block(unsigned* cnt) {
    asm volatile("s_waitcnt vmcnt(0)" ::: "memory");
    __syncthreads();
    if (otid() == 0) { __builtin_amdgcn_fence(__ATOMIC_RELEASE, "agent"); asm volatile("s_waitcnt vmcnt(0)" ::: "memory"); (void)xb_add(cnt, 1u); }
}
template <int M, int N> struct StaticOrderSig {
    int G, c; unsigned* cnt;
    DI bool next(int i, pg8::Unit& u) const { const int L = i * G + c; if (L >= StaticOrderT<M, N>::nwg) return false; StaticOrderT<M, N>::map(L, u); return true; }
    DI void a_ready(const pg8::Unit&) const {}
    DI void done(const pg8::Unit&) const { publish_block(cnt); }
};
struct SchedHC {
    int c; unsigned* cnt; unsigned target;
    DI bool next(int i, pg8::Unit& u) const { if (i > 0 || c < 224 || c >= 256) return false; const int k = c - 224; u.pm = k & 7; u.pn = k >> 3; return true; }
    DI void a_ready(const pg8::Unit&) const {
        if (otid() == 0) { unsigned sp = 0; while (xb_ld(cnt) < target) { __builtin_amdgcn_s_sleep(1); if (++sp > (1u << 22)) break; }
            __builtin_amdgcn_fence(__ATOMIC_ACQUIRE, "agent"); asm volatile("s_waitcnt vmcnt(0)" ::: "memory"); }
        __syncthreads();
    }
    DI void done(const pg8::Unit&) const {}
};
template <int LDA, int LDB, int KDIM, class Sched, class Epi> DI void run_gemm_s(LAS unsigned char* lds, const bf16* A, const bf16* Bt, int M, int N, const Sched& S, const Epi& E) {
    pg8::Gemm g{A, Bt, M, N};
    pg8::gemm_phase<Epi, Sched, true, true, LDA, LDB, KDIM>(lds, g, S, E);
    __syncthreads();
}
template <int LDA, int LDB, int KDIM, int M, int N, class Epi> DI void run_gemm(LAS unsigned char* lds, const bf16* A, const bf16* Bt, int G, int c, const Epi& E) {
    pg8::Gemm g{A, Bt, M, N};
    StaticOrderT<M, N> S; S.G = G; S.c = c;
    pg8::gemm_phase<Epi, StaticOrderT<M, N>, true, true, LDA, LDB, KDIM>(lds, g, S, E);
    __syncthreads();
}

template <int NR> DI void row_pass_n(const float* const (&src)[NR], const float* lg, const float* lb, float* const (&dstx)[NR], bf16* const (&dsth)[NR],
                                     const float* const (&sc)[NR], const float* const (&sh)[NR], float* const (&stat)[NR], bool has_stat, bool has_x, bool has_h, int lane) {
    f32x4 v[NR][4]; float s[NR];
#pragma unroll
    for (int r = 0; r < NR; ++r) { const f32x4* xr = (const f32x4*)src[r] + lane; s[r] = 0.f;
#pragma unroll
        for (int j = 0; j < 4; ++j) { v[r][j] = xr[64 * j]; } }
    if (lg) {
#pragma unroll
        for (int r = 0; r < NR; ++r)
#pragma unroll
            for (int j = 0; j < 4; ++j) s[r] += (v[r][j][0] + v[r][j][1]) + (v[r][j][2] + v[r][j][3]);
#pragma unroll
        for (int o = 1; o < 64; o <<= 1)
#pragma unroll
            for (int r = 0; r < NR; ++r) s[r] += shx(s[r], o);
        float s2[NR];
#pragma unroll
        for (int r = 0; r < NR; ++r) { const float mean = s[r] * (1.f / DM); s2[r] = 0.f;
#pragma unroll
            for (int j = 0; j < 4; ++j) { v[r][j] = v[r][j] - mean; s2[r] += (v[r][j][0] * v[r][j][0] + v[r][j][1] * v[r][j][1]) + (v[r][j][2] * v[r][j][2] + v[r][j][3] * v[r][j][3]); } }
#pragma unroll
        for (int o = 1; o < 64; o <<= 1)
#pragma unroll
            for (int r = 0; r < NR; ++r) s2[r] += shx(s2[r], o);
#pragma unroll
        for (int j = 0; j < 4; ++j) { const f32x4 gg = ((const f32x4*)lg)[lane + 64 * j], bb = ((const f32x4*)lb)[lane + 64 * j];
#pragma unroll
            for (int r = 0; r < NR; ++r) { const float rstd = rsqrtf(s2[r] * (1.f / DM) + LN_EPS); v[r][j] = v[r][j] * rstd * gg + bb; } }
        if (has_stat) {
#pragma unroll
            for (int r = 0; r < NR; ++r) if (lane == 0) { f32x2 st2; st2[0] = s[r] * (1.f / DM); st2[1] = rsqrtf(s2[r] * (1.f / DM) + LN_EPS); *(f32x2*)stat[r] = st2; }
        }
    }
    if (has_x) {
#pragma unroll
        for (int r = 0; r < NR; ++r)
#pragma unroll
            for (int j = 0; j < 4; ++j) ((f32x4*)dstx[r])[lane + 64 * j] = v[r][j];
    }
    if (has_h) {
#pragma unroll
        for (int r = 0; r < NR; ++r)
#pragma unroll
            for (int j = 0; j < 4; ++j) {
                const f32x4 a = ((const f32x4*)sc[r])[lane + 64 * j], d = ((const f32x4*)sh[r])[lane + 64 * j];
                const f32x4 h = v[r][j] * (a + 1.f) + d;
                u32x2 w; w.x = pk2(h[0], h[1]); w.y = pk2(h[2], h[3]);
                ((u32x2*)dsth[r])[lane + 64 * j] = w;
            }
    }
}
DI void rows_phase(const Params& p, int mode, int nrows, const float* lg, const float* lb, const float* modl, int sc_off, int sh_off, int gw, int ngw, int lane) {
    float* XRES = (float*)(wsp(p) + WS_XRES); bf16* HA = (bf16*)(wsp(p) + WS_HA); float* STA = (float*)(wsp(p) + WS_ST);
    constexpr int NR = 3;
    for (int row0 = gw; row0 < nrows; row0 += NR * ngw) {
        const float* src[NR]; float* dx[NR]; bf16* dh[NR]; const float* sc[NR]; const float* sh[NR]; float* stp[NR];
#pragma unroll
        for (int r = 0; r < NR; ++r) {
            int row = row0 + r * ngw; if (row >= nrows) row = row0;
            const int bidx = row < NLAT ? (row >> 11) : 8;
            src[r] = (mode == 0) ? (row < NLAT ? inp(p, 0) + (size_t)row * DM : inp(p, 2) + (size_t)(row - NLAT) * DM) : XRES + (size_t)row * DM;
            dx[r] = p.out + (size_t)(row < NLAT ? row : 0) * DM; dh[r] = HA + (size_t)row * DM; stp[r] = STA + 2 * row;
            sc[r] = modl + bidx * 6144 + sc_off; sh[r] = modl + bidx * 6144 + sh_off;
        }
        row_pass_n<NR>(src, lg, lb, dx, dh, sc, sh, stp, mode == 1, mode == 2, mode != 2, lane);
    }
}

template <class RM> DI void tr_item(const float* W, int ldsrc, int k0, int n0, bf16* dst, int lddst, int coloff, const float* kscale, RM rm, LAS float* scr, int lane) {
#pragma unroll 8
    for (int i = 0; i < 32; ++i) { const int kk = 2 * i + (lane >> 5); float w = W[(size_t)(k0 + kk) * ldsrc + n0 + (lane & 31)]; if (kscale) w *= kscale[k0 + kk]; scr[kk * 33 + (lane & 31)] = w; }
    LDS_WAIT(); asm volatile("" ::: "memory");
    const int c = lane & 7;
#pragma unroll
    for (int j = 0; j < 4; ++j) { const int n = (lane >> 3) + 8 * j; const LAS float* s = scr + (8 * c) * 33 + n;
        u32x4 o; o.x = pk2(s[0 * 33], s[1 * 33]); o.y = pk2(s[2 * 33], s[3 * 33]); o.z = pk2(s[4 * 33], s[5 * 33]); o.w = pk2(s[6 * 33], s[7 * 33]);
        *(u32x4*)(dst + (size_t)rm(n0 + n) * lddst + coloff + k0 + 8 * c) = o; }
    LDS_WAIT(); asm volatile("" ::: "memory");
}
struct RmId { int off; DI int operator()(int n) const { return n + off; } };
struct RmFfn { int off; DI int operator()(int n) const { return 256 * (n >> 7) + (n & 127) + off; } };

DI void zero_rect(bf16* dst, int ld, int row0, int nrows, int col0, int ncols, int gtid, int gthreads) {
    const int cpr = ncols >> 3, total = nrows * cpr; const unsigned zu = __float_as_uint(ozero());
    for (int e = gtid; e < total; e += gthreads) { const int r = e / cpr, cc = e - r * cpr; *(u32x4*)(dst + (size_t)(row0 + r) * ld + col0 + cc * 8) = (u32x4){zu, zu, zu, zu}; }
}

DI void phase_convert(const Params& p, int l, LAS unsigned char* lds, int gw, int ngw, int lane, int gtid, int gthreads) {
    unsigned char* ws = wsp(p);
    LAS float* scr = (LAS float*)(lds + (otid() >> 6) * 16384);
    bf16* Wtin = (bf16*)(ws + WS_WIN); bf16* Wtqk = (bf16*)(ws + WS_WQK); bf16* Wtv = (bf16*)(ws + WS_WV); bf16* Wtf = (bf16*)(ws + WS_WF);
    bf16* Wtout = (bf16*)(ws + WS_WOUT); bf16* Wt13 = (bf16*)(ws + WS_W13); bf16* Wt2 = (bf16*)(ws + WS_W2); bf16* Wtpool = (bf16*)(ws + WS_WPOOL); bf16* Wsb = (bf16*)(ws + WS_WS);
    const float* w_in = inp(p, 6) + (size_t)l * 1024 * 1440; const float* qn = inp(p, 7) + l * 256; const float* w_uq = inp(p, 8) + (size_t)l * 256 * 768;
    const float* kvn = inp(p, 9) + l * 128; const float* w_uk = inp(p, 10) + (size_t)l * 128 * 512; const float* w_uv = inp(p, 11) + (size_t)l * 128 * 512;
    const float* w_sp = inp(p, 14) + (size_t)l * 4 * 128 * 128; const float* w_pool = inp(p, 16) + (size_t)l * 4 * 64 * 64; const float* w_f = inp(p, 18) + (size_t)l * 256 * 256;
    const float* w_out = inp(p, 19) + (size_t)l * 1280 * 1024; const float* w1 = inp(p, 22) + (size_t)l * 1024 * DFF; const float* w3 = inp(p, 23) + (size_t)l * 1024 * DFF; const float* w2 = inp(p, 24) + (size_t)l * DFF * 1024;
    constexpr int I_IN = 16 * 45, I_UQ = 4 * 24, I_UK = 2 * 16, I_UV = 2 * 16, I_OUT = 20 * 32, I_F1 = 16 * 88, I_F3 = 16 * 88, I_F2 = 44 * 32, I_POOL = 8;
    constexpr int NITEMS = I_IN + I_UQ + I_UK + I_UV + I_OUT + I_F1 + I_F3 + I_F2 + I_POOL;
    for (int it = gw; it < NITEMS; it += ngw) {
        int r = it;
        if (r < I_IN) { tr_item(w_in, 1440, 64 * (r / 45), 32 * (r % 45), Wtin, 1024, 0, nullptr, RmId{0}, scr, lane); continue; } r -= I_IN;
        if (r < I_UQ) { tr_item(w_uq, 768, 64 * (r / 24), 32 * (r % 24), Wtqk, 384, 0, qn, RmId{0}, scr, lane); continue; } r -= I_UQ;
        if (r < I_UK) { tr_item(w_uk, 512, 64 * (r / 16), 32 * (r % 16), Wtqk, 384, 256, kvn, RmId{768}, scr, lane); continue; } r -= I_UK;
        if (r < I_UV) { tr_item(w_uv, 512, 64 * (r / 16), 32 * (r % 16), Wtv, 384, 256, kvn, RmId{0}, scr, lane); continue; } r -= I_UV;
        if (r < I_OUT) { tr_item(w_out, 1024, 64 * (r / 32), 32 * (r % 32), Wtout, 1280, 0, nullptr, RmId{0}, scr, lane); continue; } r -= I_OUT;
        if (r < I_F1) { tr_item(w1, DFF, 64 * (r / 88), 32 * (r % 88), Wt13, 1024, 0, nullptr, RmFfn{0}, scr, lane); continue; } r -= I_F1;
        if (r < I_F3) { tr_item(w3, DFF, 64 * (r / 88), 32 * (r % 88), Wt13, 1024, 0, nullptr, RmFfn{128}, scr, lane); continue; } r -= I_F3;
        if (r < I_F2) { tr_item(w2, 1024, 64 * (r / 32), 32 * (r % 32), Wt2, DFF, 0, nullptr, RmId{0}, scr, lane); continue; } r -= I_F2;
        { const int gi = r >> 1; tr_item(w_pool + gi * 4096, 64, 0, 32 * (r & 1), Wtpool + gi * 4096, 64, 0, nullptr, RmId{0}, scr, lane); }
    }
    zero_rect(Wtin, 1024, 1440, 96, 0, 1024, gtid, gthreads);
    zero_rect(Wtqk, 384, 0, 768, 256, 128, gtid, gthreads);
    zero_rect(Wtqk, 384, 768, 512, 0, 256, gtid, gthreads);
    zero_rect(Wtv, 384, 0, 512, 0, 256, gtid, gthreads);
    for (int e = gtid; e < 4 * 128 * 128 / 4; e += gthreads) { const f32x4 v = ((const f32x4*)w_sp)[e]; u32x2 w; w.x = pk2(v[0], v[1]); w.y = pk2(v[2], v[3]); ((u32x2*)Wsb)[e] = w; }
    for (int e = gtid; e < 256 * 256; e += gthreads) {
        const int n = e & 255, gc = e >> 8, g = gc >> 6, c = gc & 63;
        float sc_ = 0.f, ss_ = 0.f;
        for (int m = 0; m < 64; ++m) { const float w = w_f[(size_t)(g * 64 + m) * 256 + n]; const float a = (float)((m * c) & 63) * (1.f / 64.f); sc_ += cos_turn(a) * w; ss_ += sin_turn(a) * w; }
        Wtf[(size_t)n * 256 + gc] = (bf16)(pk2(sc_, 0.f) & 0xffffu); Wtf[(size_t)(256 + n) * 256 + gc] = (bf16)(pk2(-ss_, 0.f) & 0xffffu);
    }
}

DI void phase_prologue(const Params& p, LAS unsigned char* lds, int G, int bid) {
    const int tid = otid();
    LAS float* S = (LAS float*)lds;
    LAS float* red = (LAS float*)(lds + 40960);
    const float* cvec = inp(p, 1); const float* ccv = inp(p, 3); const float* w_mod = inp(p, 4); const float* b_mod = inp(p, 5);
    float* MOD = (float*)(wsp(p) + WS_MOD);
    for (int i = tid; i < 9 * 1024; i += 512) { const float v = i < 8192 ? cvec[i] : ccv[i - 8192]; S[i] = v * frcp(1.f + fexp2(-1.4426950408889634f * v)); }
    __syncthreads();
    for (int item = bid; item < 4 * 96; item += G) {
        const int l = item / 96, n0 = (item - l * 96) * 64, j = tid & 63, ks = tid >> 6;
        const float* W = w_mod + (size_t)l * 1024 * 6144 + n0 + j;
        float a0 = 0, a1 = 0, a2 = 0, a3 = 0, a4 = 0, a5 = 0, a6 = 0, a7 = 0, a8 = 0;
#pragma unroll 32
        for (int k = ks * 128; k < ks * 128 + 128; ++k) {
            const float w = W[(size_t)k * 6144];
            a0 += S[k] * w; a1 += S[1024 + k] * w; a2 += S[2048 + k] * w; a3 += S[3072 + k] * w; a4 += S[4096 + k] * w;
            a5 += S[5120 + k] * w; a6 += S[6144 + k] * w; a7 += S[7168 + k] * w; a8 += S[8192 + k] * w;
        }
        LAS float* rr = red + ks * 576 + j;
        rr[0] = a0; rr[64] = a1; rr[128] = a2; rr[192] = a3; rr[256] = a4; rr[320] = a5; rr[384] = a6; rr[448] = a7; rr[512] = a8;
        __syncthreads();
        for (int o = tid; o < 576; o += 512) {
            const int r = o >> 6, jj = o & 63; float s = b_mod[l * 6144 + n0 + jj];
#pragma unroll
            for (int k2 = 0; k2 < 8; ++k2) s += red[k2 * 576 + o];
            MOD[(size_t)(l * 9 + r) * 6144 + n0 + jj] = s;
        }
        __syncthreads();
    }
    const int gtid = bid * 512 + tid, gthreads = G * 512;
    bf16* CSL = (bf16*)(wsp(p) + WS_CSL); bf16* CSC = (bf16*)(wsp(p) + WS_CSC);
    for (int ch = gtid; ch < 1048576 + 16384; ch += gthreads) {
        float v[8];
        if (ch < 1048576) {
            const int k = ch >> 9, l0 = (ch & 511) * 8, half = l0 >> 11, lb = l0 & 2047; const float scale = 0.00276213586400995f;
#pragma unroll
            for (int j = 0; j < 8; ++j) { const float a = (float)((k * (lb + j)) & 2047) * (1.f / 2048.f); v[j] = (half ? sin_turn(a) : cos_turn(a)) * scale; }
            u32x4 w; w.x = pk2(v[0], v[1]); w.y = pk2(v[2], v[3]); w.z = pk2(v[4], v[5]); w.w = pk2(v[6], v[7]);
            *(u32x4*)(CSL + (size_t)k * 4096 + l0) = w;
        } else {
            const int c2 = ch - 1048576, k = c2 >> 6, l0 = (c2 & 63) * 8, half = l0 >> 8, lb = l0 & 255; const float scale = 1.f / 128.f;
#pragma unroll
            for (int j = 0; j < 8; ++j) { const float a = (float)((k * (lb + j)) & 255) * (1.f / 256.f); v[j] = (half ? sin_turn(a) : cos_turn(a)) * scale; }
            u32x4 w; w.x = pk2(v[0], v[1]); w.y = pk2(v[2], v[3]); w.z = pk2(v[4], v[5]); w.w = pk2(v[6], v[7]);
            *(u32x4*)(CSC + (size_t)k * 512 + l0) = w;
        }
    }
    float* ROPE = (float*)(wsp(p) + WS_ROPE);
    for (int e = gtid; e < 2048 * 16; e += gthreads) {
        const int pos = e >> 4, f = e & 15, axis = f >> 3, fi = f & 7;
        const float coord = (float)(axis ? (pos & 63) : (pos >> 6));
        const float inv = fexp2(-(float)fi * (13.287712379549449f / 8.f));
        const float ang = coord * inv * 0.15915494309189535f;
        ROPE[pos * 32 + f] = cos_turn(ang); ROPE[pos * 32 + 16 + f] = sin_turn(ang);
    }
}

DI f32x4 mfma16(bf16x8 a, bf16x8 b, f32x4 c) { return __builtin_amdgcn_mfma_f32_16x16x32_bf16(a, b, c, 0, 0, 0); }
DI f32x16 mfma32(bf16x8 a, bf16x8 b, f32x16 c) { return __builtin_amdgcn_mfma_f32_32x32x16_bf16(a, b, c, 0, 0, 0); }

DI void sgu_item(const Params& p, int l, int ci, int g, LAS unsigned char* lds) {
    const int tid = otid(), lane = tid & 63, w = tid >> 6;
    const bf16* proj = (const bf16*)(wsp(p) + WS_PROJ); bf16* mix = (bf16*)(wsp(p) + WS_MIX); const bf16* Wsb = (const bf16*)(wsp(p) + WS_WS);
    const float* gam = inp(p, 12) + l * 256; const float* bet = inp(p, 13) + l * 256; const float* bsp = inp(p, 15) + l * 512;
    constexpr int PITCH = 136;
    LAS bf16* vnT = (LAS bf16*)lds;
    const int r0 = ci * 128;
    const int fr = lane & 15, fq = lane >> 4, pp = 16 * w + fr, tok = r0 + pp;
    bf16x8 wfr[4]; u32x2 uu[4];
#pragma unroll
    for (int ks = 0; ks < 4; ++ks) wfr[ks] = *(const bf16x8*)(Wsb + (size_t)(g * 128 + pp) * 128 + ks * 32 + fq * 8);
#pragma unroll
    for (int ct = 0; ct < 4; ++ct) uu[ct] = *(const u32x2*)(proj + (size_t)tok * NPROJ + PO_SU + g * 64 + ct * 16 + fq * 4);
    const float bs = bsp[g * 128 + pp];
    {
        const int q = tid >> 2, j = tid & 3;
        const u32x4* src = (const u32x4*)(proj + (size_t)(r0 + q) * NPROJ + PO_SV + j * 64);
        float v[64]; float s = 0.f;
#pragma unroll
        for (int i = 0; i < 8; ++i) { const u32x4 x = src[i];
            v[8 * i + 0] = bflo(x.x); v[8 * i + 1] = bfhi(x.x); v[8 * i + 2] = bflo(x.y); v[8 * i + 3] = bfhi(x.y);
            v[8 * i + 4] = bflo(x.z); v[8 * i + 5] = bfhi(x.z); v[8 * i + 6] = bflo(x.w); v[8 * i + 7] = bfhi(x.w); }
#pragma unroll
        for (int i = 0; i < 64; ++i) s += v[i];
        s += shx(s, 1); s += shx(s, 2);
        const float mean = s * (1.f / 256.f); float s2 = 0.f;
#pragma unroll
        for (int i = 0; i < 64; ++i) { v[i] -= mean; s2 += v[i] * v[i]; }
        s2 += shx(s2, 1); s2 += shx(s2, 2);
        const float rstd = rsqrtf(s2 * (1.f / 256.f) + LN_EPS);
        if (j == g) {
#pragma unroll
            for (int c = 0; c < 64; ++c) { const float vn = v[c] * rstd * gam[g * 64 + c] + bet[g * 64 + c]; vnT[c * PITCH + q] = (bf16)(pk2(vn, 0.f) & 0xffffu); }
        }
    }
    __syncthreads();
    {
        f32x4 acc[4]; const float zf = ozero();
#pragma unroll
        for (int ct = 0; ct < 4; ++ct) acc[ct] = (f32x4){zf, zf, zf, zf};
#pragma unroll
        for (int ks = 0; ks < 4; ++ks) {
            const bf16x8 bfr = wfr[ks];
#pragma unroll
            for (int ct = 0; ct < 4; ++ct) { const bf16x8 afr = *(const LAS bf16x8*)(vnT + (ct * 16 + fr) * PITCH + ks * 32 + fq * 8); acc[ct] = mfma16(afr, bfr, acc[ct]); }
        }
#pragma unroll
        for (int ct = 0; ct < 4; ++ct) {
            const int c0 = g * 64 + ct * 16 + fq * 4;
            u32x2 o; o.x = pk2(bflo(uu[ct].x) * (acc[ct][0] + bs), bfhi(uu[ct].x) * (acc[ct][1] + bs)); o.y = pk2(bflo(uu[ct].y) * (acc[ct][2] + bs), bfhi(uu[ct].y) * (acc[ct][3] + bs));
            *(u32x2*)(mix + (size_t)tok * MIXD + 512 + c0) = o;
        }
    }
    __syncthreads();
}

DI void pool_item(const Params& p, int l, int ti, int gi, LAS unsigned char* lds) {
    const int tid = otid(), lane = tid & 63, w = tid >> 6;
    const bf16* proj = (const bf16*)(wsp(p) + WS_PROJ); bf16* mix = (bf16*)(wsp(p) + WS_MIX); const bf16* Wtp = (const bf16*)(wsp(p) + WS_WPOOL) + gi * 4096;
    const float* pscale = inp(p, 17) + l * 256 + gi * 64;
    LAS float* Pl = (LAS float*)lds;
    LAS bf16* Dl = (LAS bf16*)(lds + 40960);
    const int r0 = ti * 128, half = 1 << gi;
    int sb, se; if (r0 < NLAT) { sb = r0 & ~2047; se = sb + 2048; } else { sb = NLAT + ((r0 - NLAT) & ~255); se = sb + 256; }
    const unsigned zu = __float_as_uint(ozero());
    const int fr = lane & 15, fq = lane >> 4;
    bf16x8 wfr[2][4]; f32x4 psc[4];
#pragma unroll
    for (int ks = 0; ks < 2; ++ks)
#pragma unroll
        for (int nt = 0; nt < 4; ++nt) wfr[ks][nt] = *(const bf16x8*)(Wtp + (nt * 16 + fr) * 64 + ks * 32 + fq * 8);
#pragma unroll
    for (int nt = 0; nt < 4; ++nt) psc[nt] = *(const f32x4*)(pscale + nt * 16 + fq * 4);
    for (int e = tid; e < 144 * 8; e += 512) {
        const int rr = e >> 3, c8 = (e & 7) * 8, r = r0 - 8 + rr;
        u32x4 x = (u32x4){zu, zu, zu, zu};
        if (r >= sb && r < se) x = *(const u32x4*)(proj + (size_t)r * NPROJ + PO_POOL + gi * 64 + c8);
        LAS float* d = Pl + rr * 65 + c8;
        d[0] = bflo(x.x); d[1] = bfhi(x.x); d[2] = bflo(x.y); d[3] = bfhi(x.y); d[4] = bflo(x.z); d[5] = bfhi(x.z); d[6] = bflo(x.w); d[7] = bfhi(x.w);
    }
    __syncthreads();
    {
        const int c = tid & 63, t0 = (tid >> 6) * 16;
        float s = 0.f;
        for (int rr = t0 + 8 - half; rr < t0 + 8 + half; ++rr) s += Pl[rr * 65 + c];
        float add[15], sub[15], ctr[16];
#pragma unroll
        for (int i = 0; i < 15; ++i) { add[i] = Pl[(t0 + i + 8 + half) * 65 + c]; sub[i] = Pl[(t0 + i + 8 - half) * 65 + c]; }
#pragma unroll
        for (int i = 0; i < 16; ++i) ctr[i] = Pl[(t0 + i + 8) * 65 + c];
#pragma unroll
        for (int i = 0; i < 16; ++i) {
            const int r = r0 + t0 + i;
            const int lo = max(r - half, sb), hi = min(r + half, se);
            const float d = s * frcp((float)(hi - lo)) - ctr[i];
            Dl[(t0 + i) * 72 + c] = (bf16)(pk2(d, 0.f) & 0xffffu);
            if (i < 15) s += add[i] - sub[i];
        }
    }
    __syncthreads();
    {
        const int t = 16 * w + fr;
        f32x4 acc[4]; const float zf = ozero();
#pragma unroll
        for (int nt = 0; nt < 4; ++nt) acc[nt] = (f32x4){zf, zf, zf, zf};
#pragma unroll
        for (int ks = 0; ks < 2; ++ks) {
            const bf16x8 bfr = *(const LAS bf16x8*)(Dl + t * 72 + ks * 32 + fq * 8);
#pragma unroll
            for (int nt = 0; nt < 4; ++nt) acc[nt] = mfma16(wfr[ks][nt], bfr, acc[nt]);
        }
#pragma unroll
        for (int nt = 0; nt < 4; ++nt) {
            const int n0 = nt * 16 + fq * 4; const f32x4 sc = psc[nt];
            u32x2 o; o.x = pk2(acc[nt][0] * sc[0], acc[nt][1] * sc[1]); o.y = pk2(acc[nt][2] * sc[2], acc[nt][3] * sc[3]);
            *(u32x2*)(mix + (size_t)(r0 + t) * MIXD + 768 + gi * 64 + n0) = o;
        }
    }
    __syncthreads();
}

DI void krope_items(const Params& p, int gtid, int gthreads) {
    const bf16* proj = (const bf16*)(wsp(p) + WS_PROJ); bf16* Kb = (bf16*)(wsp(p) + WS_K); const float* rope = (const float*)(wsp(p) + WS_ROPE);
    for (int e = gtid; e < MTOK * 2; e += gthreads) {
        const int row = e >> 1, axis = e & 1;
        int b, pos; bool lat; row_info(row, b, pos, lat);
        const u32x4 x1 = *(const u32x4*)(proj + (size_t)row * NPROJ + PO_KR + axis * 16), x2 = *(const u32x4*)(proj + (size_t)row * NPROJ + PO_KR + axis * 16 + 8);
        u32x4 o1 = x1, o2 = x2;
        if (lat) {
            const float* rp = rope + pos * 32 + axis * 8;
            float a[8], c[8], cs[8], sn[8];
            a[0] = bflo(x1.x); a[1] = bfhi(x1.x); a[2] = bflo(x1.y); a[3] = bfhi(x1.y); a[4] = bflo(x1.z); a[5] = bfhi(x1.z); a[6] = bflo(x1.w); a[7] = bfhi(x1.w);
            c[0] = bflo(x2.x); c[1] = bfhi(x2.x); c[2] = bflo(x2.y); c[3] = bfhi(x2.y); c[4] = bflo(x2.z); c[5] = bfhi(x2.z); c[6] = bflo(x2.w); c[7] = bfhi(x2.w);
#pragma unroll
            for (int j = 0; j < 8; ++j) { cs[j] = rp[j]; sn[j] = rp[16 + j]; }
            float y1[8], y2[8];
#pragma unroll
            for (int j = 0; j < 8; ++j) { y1[j] = a[j] * cs[j] - c[j] * sn[j]; y2[j] = a[j] * sn[j] + c[j] * cs[j]; }
            o1.x = pk2(y1[0], y1[1]); o1.y = pk2(y1[2], y1[3]); o1.z = pk2(y1[4], y1[5]); o1.w = pk2(y1[6], y1[7]);
            o2.x = pk2(y2[0], y2[1]); o2.y = pk2(y2[2], y2[3]); o2.z = pk2(y2[4], y2[5]); o2.w = pk2(y2[6], y2[7]);
        }
        const int key = lat ? CTXL + pos : pos;
#pragma unroll
        for (int h = 0; h < 8; ++h) { bf16* dst = Kb + ((size_t)(b * 8 + h) * NKEY + key) * 96 + 64 + axis * 16; *(u32x4*)dst = o1; *(u32x4*)(dst + 8) = o2; }
    }
}

DI int swap23(int r) { return (r & ~12) | ((r & 4) << 1) | ((r & 8) >> 1); }
DI void attn_item(const bf16* Qp, const bf16* Kp, const bf16* Vtp, int nkeys, bf16* outp  , LAS unsigned char* lds) {
    const int tid = otid(), lane = tid & 63, w = tid >> 6, r = lane & 31, hh = lane >> 5, gk = w >> 2, wq = w & 3;
    constexpr int KP = 208, VP = 144, KT = 64 * KP, VT = 64 * VP;
    LAS unsigned char* Kl = lds; LAS unsigned char* Vl = lds + 4 * KT;
    bf16x8 qf[6];
#pragma unroll
    for (int kk = 0; kk < 6; ++kk) qf[kk] = *(const bf16x8*)(Qp + (size_t)(32 * wq + r) * 96 + kk * 16 + hh * 8);
    const float zf = ozero();
    f32x16 o0, o1;
#pragma unroll
    for (int i = 0; i < 16; ++i) { o0[i] = zf; o1[i] = zf; }
    float mrun = -60.f, lrun = zf;
    unsigned kg[3], kl[3], vg[2], vl[2];
#pragma unroll
    for (int i = 0; i < 3; ++i) { const int c = tid + 512 * i, tile = c / 768, cc = c - tile * 768, row = cc / 12, col = cc - row * 12;
        kg[i] = (unsigned)((tile * 64 + row) * 96 + col * 8); kl[i] = (unsigned)(tile * KT + swap23(row) * KP + col * 16); }
#pragma unroll
    for (int i = 0; i < 2; ++i) { const int c = tid + 512 * i, tile = c >> 9, cc = c & 511, dv = cc >> 3, col = cc & 7;
        vg[i] = (unsigned)(dv * NKEY + tile * 64 + col * 8); vl[i] = (unsigned)(tile * VT + dv * VP + col * 16); }
    const int npairs = nkeys >> 7;
    u32x4 sk[3], sv[2];
#pragma unroll
    for (int i = 0; i < 3; ++i) sk[i] = *(const u32x4*)(Kp + kg[i]);
#pragma unroll
    for (int i = 0; i < 2; ++i) sv[i] = *(const u32x4*)(Vtp + vg[i]);
#pragma unroll
    for (int i = 0; i < 3; ++i) *(LAS u32x4*)(Kl + kl[i]) = sk[i];
#pragma unroll
    for (int i = 0; i < 2; ++i) *(LAS u32x4*)(Vl + vl[i]) = sv[i];
    __syncthreads();
    for (int kp = 0; kp < npairs; ++kp) {
        const int cur = kp & 1;
        if (kp + 1 < npairs) {
            const bf16* kgp = Kp + (size_t)(kp + 1) * 128 * 96; const bf16* vgp = Vtp + (kp + 1) * 128;
#pragma unroll
            for (int i = 0; i < 3; ++i) sk[i] = *(const u32x4*)(kgp + kg[i]);
#pragma unroll
            for (int i = 0; i < 2; ++i) sv[i] = *(const u32x4*)(vgp + vg[i]);
        }
        const LAS unsigned char* kb = Kl + (cur * 2 + gk) * KT; const LAS unsigned char* vb = Vl + (cur * 2 + gk) * VT;
        f32x16 s0, s1; const float negm = -mrun;
#pragma unroll
        for (int i = 0; i < 16; ++i) { s0[i] = negm; s1[i] = negm; }
#pragma unroll
        for (int kk = 0; kk < 6; ++kk) {
            const bf16x8 ka0 = *(const LAS bf16x8*)(kb + r * KP + kk * 32 + hh * 16);
            const bf16x8 ka1 = *(const LAS bf16x8*)(kb + (32 + r) * KP + kk * 32 + hh * 16);
            s0 = mfma32(ka0, qf[kk], s0); s1 = mfma32(ka1, qf[kk], s1);
        }
        float mx = s0[0];
#pragma unroll
        for (int i = 1; i < 16; ++i) mx = fmaxf(mx, s0[i]);
#pragma unroll
        for (int i = 0; i < 16; ++i) mx = fmaxf(mx, s1[i]);
        if (__builtin_amdgcn_ballot_w64(mx > 6.f) != 0ull) {
            mx = fmaxf(mx, shx(mx, 32));
            const float dm = fmaxf(mx, 0.f), alpha = fexp2(-dm);
            mrun += dm; lrun *= alpha;
#pragma unroll
            for (int i = 0; i < 16; ++i) { s0[i] -= dm; s1[i] -= dm; o0[i] *= alpha; o1[i] *= alpha; }
        }
        float ls = 0.f;
#pragma unroll
        for (int i = 0; i < 16; ++i) { s0[i] = fexp2(s0[i]); s1[i] = fexp2(s1[i]); ls += s0[i] + s1[i]; }
        lrun += ls;
        bf16x8 pf[2][2];
#pragma unroll
        for (int s2 = 0; s2 < 2; ++s2) {
            u32x4 a, b2;
            a.x = pk2(s0[8 * s2 + 0], s0[8 * s2 + 1]); a.y = pk2(s0[8 * s2 + 2], s0[8 * s2 + 3]); a.z = pk2(s0[8 * s2 + 4], s0[8 * s2 + 5]); a.w = pk2(s0[8 * s2 + 6], s0[8 * s2 + 7]);
            b2.x = pk2(s1[8 * s2 + 0], s1[8 * s2 + 1]); b2.y = pk2(s1[8 * s2 + 2], s1[8 * s2 + 3]); b2.z = pk2(s1[8 * s2 + 4], s1[8 * s2 + 5]); b2.w = pk2(s1[8 * s2 + 6], s1[8 * s2 + 7]);
            pf[0][s2] = __builtin_bit_cast(bf16x8, a); pf[1][s2] = __builtin_bit_cast(bf16x8, b2);
        }
#pragma unroll
        for (int d = 0; d < 2; ++d)
#pragma unroll
            for (int s2 = 0; s2 < 2; ++s2) {
                const bf16x8 v0 = *(const LAS bf16x8*)(vb + r * VP + (d * 32 + s2 * 16 + hh * 8) * 2);
                const bf16x8 v1 = *(const LAS bf16x8*)(vb + (32 + r) * VP + (d * 32 + s2 * 16 + hh * 8) * 2);
                o0 = mfma32(v0, pf[d][s2], o0); o1 = mfma32(v1, pf[d][s2], o1);
            }
        if (kp + 1 < npairs) {
            LAS unsigned char* kn = Kl + (cur ^ 1) * 2 * KT; LAS unsigned char* vn = Vl + (cur ^ 1) * 2 * VT;
#pragma unroll
            for (int i = 0; i < 3; ++i) *(LAS u32x4*)(kn + kl[i]) = sk[i];
#pragma unroll
            for (int i = 0; i < 2; ++i) *(LAS u32x4*)(vn + vl[i]) = sv[i];
        }
        __syncthreads();
    }
    lrun += shx(lrun, 32);
    LAS float* mg = (LAS float*)lds + wq * (34 * 64) + lane;
    if (gk == 1) {
#pragma unroll
        for (int i = 0; i < 16; ++i) { mg[i * 64] = o0[i]; mg[(16 + i) * 64] = o1[i]; }
        mg[32 * 64] = mrun; mg[33 * 64] = lrun;
    }
    __syncthreads();
    if (gk == 0) {
        const float m1 = mg[32 * 64], l1 = mg[33 * 64];
        const float m = fmaxf(mrun, m1), a0 = fexp2(mrun - m), a1 = fexp2(m1 - m);
        const float inv = frcp(lrun * a0 + l1 * a1), c0 = a0 * inv, c1 = a1 * inv;
        bf16* orow = outp + (size_t)(32 * wq + r) * MIXD;
#pragma unroll
        for (int i4 = 0; i4 < 4; ++i4) {
            u32x2 a, b2;
            a.x = pk2(o0[4 * i4] * c0 + mg[(4 * i4) * 64] * c1, o0[4 * i4 + 1] * c0 + mg[(4 * i4 + 1) * 64] * c1);
            a.y = pk2(o0[4 * i4 + 2] * c0 + mg[(4 * i4 + 2) * 64] * c1, o0[4 * i4 + 3] * c0 + mg[(4 * i4 + 3) * 64] * c1);
            b2.x = pk2(o1[4 * i4] * c0 + mg[(16 + 4 * i4) * 64] * c1, o1[4 * i4 + 1] * c0 + mg[(16 + 4 * i4 + 1) * 64] * c1);
            b2.y = pk2(o1[4 * i4 + 2] * c0 + mg[(16 + 4 * i4 + 2) * 64] * c1, o1[4 * i4 + 3] * c0 + mg[(16 + 4 * i4 + 3) * 64] * c1);
            *(u32x2*)(orow + 8 * i4 + 4 * hh) = a; *(u32x2*)(orow + 32 + 8 * i4 + 4 * hh) = b2;
        }
    }
    __syncthreads();
}

DI void attn_any(const Params& p, int item, LAS unsigned char* lds) {
    unsigned char* ws = wsp(p);
    const bool isl = item < 1024;
    const int bh = isl ? (item >> 4) : ((item - 1024) >> 1), qb = isl ? (item & 15) : ((item - 1024) & 1), b = bh >> 3, h = bh & 7;
    const bf16* Qp = isl ? (const bf16*)(ws + WS_QLAT) + ((size_t)bh * SEQ + qb * 128) * 96 : (const bf16*)(ws + WS_QCTX) + ((size_t)bh * CTXL + qb * 128) * 96;
    const bf16* Kp = (const bf16*)(ws + WS_K) + (size_t)bh * NKEY * 96;
    const bf16* Vtp = (const bf16*)(ws + WS_VT) + (size_t)bh * 64 * NKEY;
    bf16* outp = (bf16*)(ws + WS_MIX) + (size_t)(isl ? (b * SEQ + qb * 128) : (NLAT + b * CTXL + qb * 128)) * MIXD + h * 64;
    attn_item(Qp, Kp, Vtp, isl ? NKEY : CTXL, outp, lds);
    if (!isl) publish_block((unsigned*)(ws + WS_CTL) + CW_ECTX);
}

#ifndef PROBE_REP_SUB
#define PROBE_REP_SUB -1
#endif
#ifndef PROBE_SYNCS
#define PROBE_SYNCS 0
#endif
constexpr int NSUB = 13 + (PROBE_REP_SUB >= 0 ? 1 : 0), NSTEP = 2 + NSUB * DEPTH;
__global__ void __launch_bounds__(512, 2) mk_fwd(Params p) {
    extern __shared__ __attribute__((aligned(16))) unsigned char lds_raw[];
    LAS unsigned char* lds = (LAS unsigned char*)lds_raw;
    cg::grid_group grid = cg::this_grid();
    volatile LAS unsigned* MISC = (volatile LAS unsigned*)(lds + MISC_OFF);
    if (threadIdx.x < 4) MISC[threadIdx.x] = 0u;
    __syncthreads();
    const XcdBarrier xbar = xcd_barrier_post((unsigned*)(p.ws + WS_CTL), MISC);
    if (p.ph_lo < 0) grid.sync();
    for (int st = p.ph_lo; st < p.ph_hi; ++st) {
        int G = gridDim.x, bid = blockIdx.x; asm volatile("" : "+s"(G), "+s"(bid));
        const int vcu = (G % 8 == 0) ? (bid % 8) * (G / 8) + bid / 8 : bid;
        const int ngw = G * 8, gthreads = G * 512;
        const int tid = otid(), lane = tid & 63, wave = tid >> 6, gw = bid * 8 + wave, gtid = bid * 512 + tid;
        const int l = (st - 1) / NSUB, subx = (st - 1) - l * NSUB, sub = (st == 0) ? 100 : (st == NSTEP - 1) ? 101 : ((PROBE_REP_SUB >= 0 && subx > PROBE_REP_SUB) ? subx - 1 : subx);
        const bool need_sync = !(sub == 3 || sub == 4 || sub == 5 || sub == 7 || sub == 8 || sub == 100);
        if (st > p.ph_lo && need_sync) xcd_barrier(xbar);
        unsigned char* ws = wsp(p);
        float* XRES = (float*)(ws + WS_XRES); bf16* HA = (bf16*)(ws + WS_HA); bf16* PROJ = (bf16*)(ws + WS_PROJ);
        bf16* MIX = (bf16*)(ws + WS_MIX); bf16* U = (bf16*)(ws + WS_U);
        const float* MOD = (const float*)(ws + WS_MOD);
        float* STQ = (float*)(ws + WS_STQ); float* STKV = (float*)(ws + WS_STKV);
        const bool last = (l == DEPTH - 1);
        const int Mtail = last ? NLAT : MTOK;
        const float* modl = MOD + (size_t)l * 9 * 6144;
        if (PROBE_SYNCS > 0 && sub == 101) { for (int i = 0; i < PROBE_SYNCS; ++i) xcd_barrier(xbar); }
        switch (sub) {
        case 100: phase_prologue(p, lds, G, bid); break;
        case 101: {
            rows_phase(p, 2, NLAT, inp(p, 25) + (DEPTH - 1) * DM, inp(p, 26) + (DEPTH - 1) * DM, modl, 0, 0, gw, ngw, lane);
        } break;
        case 0: {
            const float* lg = (l == 0) ? nullptr : inp(p, 25) + (l - 1) * DM; const float* lb = (l == 0) ? nullptr : inp(p, 26) + (l - 1) * DM;
            rows_phase(p, l == 0 ? 0 : 1, MTOK, lg, lb, modl, 1024, 0, gw, ngw, lane);
            phase_convert(p, l, lds, gw, ngw, lane, gtid, gthreads);
        } break;
        case 1: {
            EpiProj E{PROJ, STQ, STKV};
            run_gemm<DM, DM, DM, MTOK, NPROJ>(lds, HA, (const bf16*)(ws + WS_WIN), G, bid, E);
        } break;
        case 2: {
            EpiQK E{(bf16*)(ws + WS_QLAT), (bf16*)(ws + WS_QCTX), (bf16*)(ws + WS_K), STQ, STKV, (const float*)(ws + WS_ROPE)};
            run_gemm<NPROJ, 384, 384, MTOK, 1280>(lds, PROJ, (const bf16*)(ws + WS_WQK), G, bid, E);
        } break;
        case 3: {
            EpiVt E{(bf16*)(ws + WS_VT), STKV};
            run_gemm<384, NPROJ, 384, 512, MTOK>(lds, (const bf16*)(ws + WS_WV), PROJ, G, (bid + G - 104) % G, E);
        } break;
        case 4: {
            EpiGt E{(bf16*)(ws + WS_GTL), (bf16*)(ws + WS_GTC)};
            run_gemm<256, NPROJ, 256, 512, MTOK>(lds, (const bf16*)(ws + WS_WF), PROJ + PO_F, G, (bid + G - 104) % G, E);
        } break;
        case 5: {
            int first, cnt;
            if (G == 256) { if (bid < 104) { first = bid * 5; cnt = 5; } else if (bid < 248) { first = 520 + (bid - 104) * 4; cnt = 4; } else { first = 1096 + (bid - 248) * 7; cnt = 7; } }
            else { first = bid; cnt = (1152 - bid + G - 1) / G; }
            for (int k = 0; k < cnt; ++k) { const int it = (G == 256) ? first + k : first + k * G;
                if (it < 576) sgu_item(p, l, it >> 2, it & 3, lds); else pool_item(p, l, (it - 576) >> 2, (it - 576) & 3, lds); }
            krope_items(p, gtid, gthreads);
        } break;
        case 6: {
            EpiDft E{MIX, 0, SEQ};
            run_gemm<4096, 4096, 4096, 2048, 2048>(lds, (const bf16*)(ws + WS_CSL), (const bf16*)(ws + WS_GTL), G, vcu, E);
        } break;
        case 7: {
            if (!last) { EpiDft E{MIX, NLAT, CTXL};
              StaticOrderSig<256, 2048> S{G, (vcu + G - 64) % G, (unsigned*)(ws + WS_CTL) + CW_ECTX};
              run_gemm_s<512, 512, 512>(lds, (const bf16*)(ws + WS_CSC), (const bf16*)(ws + WS_GTC), 256, 2048, S, E); }
        } break;
        case 8: {
            if (G == 256) {
                int first, cnt, citem = -1;
                if (vcu < 64) { first = 2 * vcu; cnt = 2; } else if (vcu < 72) { first = 128 + 5 * (vcu - 64); cnt = 5; }
                else if (vcu < 104) { first = 168 + 3 * (vcu - 72); cnt = 3; } else { first = 264 + 5 * (vcu - 104); cnt = 5; if (!last && vcu < 232) citem = 1024 + (vcu - 104); }
                if (citem >= 0) attn_any(p, citem, lds);
                for (int k = 0; k < cnt; ++k) attn_any(p, first + k, lds);
                if (!last) {
                    SchedHC S{vcu + 152, (unsigned*)(ws + WS_CTL) + CW_ECTX, 136u * (unsigned)(l + 1)};
                    EpiRes E2{(l == 0) ? inp(p, 2) : XRES + (size_t)NLAT * DM, XRES + (size_t)NLAT * DM, (const float*)(ws + WS_ST) + 2 * NLAT, (l == 0) ? nullptr : inp(p, 25) + (l - 1) * DM, (l == 0) ? nullptr : inp(p, 26) + (l - 1) * DM, modl, 2048, 64};
                    run_gemm_s<MIXD, MIXD, MIXD>(lds, MIX + (size_t)NLAT * MIXD, (const bf16*)(ws + WS_WOUT), NCTX, DM, S, E2);
                }
            } else {
                for (int it = vcu; it < (last ? 1024 : 1152); it += G) attn_any(p, it, lds);
            }
        } break;
        case 9: {
            EpiRes E{(l == 0) ? inp(p, 0) : XRES, XRES, (const float*)(ws + WS_ST), (l == 0) ? nullptr : inp(p, 25) + (l - 1) * DM, (l == 0) ? nullptr : inp(p, 26) + (l - 1) * DM, modl, 2048, 0};
            if (last || G == 256) run_gemm<MIXD, MIXD, MIXD, NLAT, DM>(lds, MIX, (const bf16*)(ws + WS_WOUT), G, bid, E);
            else run_gemm<MIXD, MIXD, MIXD, MTOK, DM>(lds, MIX, (const bf16*)(ws + WS_WOUT), G, bid, E);
        } break;
        case 10: {
            rows_phase(p, 1, Mtail, inp(p, 20) + l * DM, inp(p, 21) + l * DM, modl, 4096, 3072, gw, ngw, lane);
        } break;
        case 11: {
            EpiSwiglu E{U};
            if (last || G != 256) {
                if (last) run_gemm<DM, DM, DM, NLAT, 2 * DFF>(lds, HA, (const bf16*)(ws + WS_W13), G, bid, E);
                else run_gemm<DM, DM, DM, MTOK, 2 * DFF>(lds, HA, (const bf16*)(ws + WS_W13), G, bid, E);
            } else {
                unsigned* cnt = (unsigned*)(ws + WS_CTL) + CW_GCTX;
                { SchedG S{bid, cnt}; run_gemm_s<DM, DM, DM>(lds, HA, (const bf16*)(ws + WS_W13), MTOK, 2 * DFF, S, E); }
                { SchedHC S{bid, cnt, 176u * (unsigned)(l + 1)}; EpiRes E2{XRES + (size_t)NLAT * DM, XRES + (size_t)NLAT * DM, (const float*)(ws + WS_ST) + 2 * NLAT, inp(p, 20) + l * DM, inp(p, 21) + l * DM, modl, 5120, 64};
                  run_gemm_s<DFF, DFF, DFF>(lds, U + (size_t)NLAT * DFF, (const bf16*)(ws + WS_W2), NCTX, DM, S, E2); }
            }
        } break;
        case 12: {
            EpiRes E{XRES, XRES, (const float*)(ws + WS_ST), inp(p, 20) + l * DM, inp(p, 21) + l * DM, modl, 5120, 0};
            if (last || G == 256) run_gemm<DFF, DFF, DFF, NLAT, DM>(lds, U, (const bf16*)(ws + WS_W2), G, bid, E);
            else run_gemm<DFF, DFF, DFF, MTOK, DM>(lds, U, (const bf16*)(ws + WS_W2), G, bid, E);
        } break;
        }
        __syncthreads();
    }
}

#ifndef MK_SPLIT
#define MK_SPLIT 0
#endif
extern "C" void kernel_launch(void* const* d_in, const int* in_sizes, int n_in, void* d_out, int out_size, void* d_ws, size_t ws_size, hipStream_t stream) {
    static int grid = 0;
    if (grid == 0) {
        if (n_in != 27 || out_size != NLAT * DM || ws_size < WS_END) { fprintf(stderr, "kernel_launch: unexpected shapes / workspace (%d inputs, out %d, ws %zu < %zu)\n", n_in, out_size, ws_size, (size_t)WS_END); grid = -1; return; }
        int dev = 0, cus = 0, per_cu = 0;
        hipGetDevice(&dev);
        hipDeviceGetAttribute(&cus, hipDeviceAttributeMultiprocessorCount, dev);
        hipFuncSetAttribute((const void*)mk_fwd, hipFuncAttributeMaxDynamicSharedMemorySize, LDS_BYTES);
        hipOccupancyMaxActiveBlocksPerMultiprocessor(&per_cu, (const void*)mk_fwd, 512, LDS_BYTES);
        if (per_cu < 1) { fprintf(stderr, "kernel_launch: occupancy query reports %d blocks per CU\n", per_cu); per_cu = 1; }
        grid = cus >= 256 ? 256 : cus;
        (void)hipGetLastError();
    }
    if (grid < 0) return;
    if (hipMemsetAsync((char*)d_ws + WS_CTL, 0, CTL_BYTES, stream) != hipSuccess) { fprintf(stderr, "kernel_launch: memset failed\n"); return; }
    Params p{};
    for (int i = 0; i < 27; ++i) p.in[i] = (const float*)d_in[i];
    p.out = (float*)d_out; p.ws = (unsigned char*)d_ws;
#if MK_SPLIT
    for (int ph = 0; ph < NSTEP; ++ph) {
        p.ph_lo = ph; p.ph_hi = ph + 1;
        void* args[] = {&p};
        hipError_t e = hipLaunchCooperativeKernel((const void*)mk_fwd, dim3(grid), dim3(512), args, LDS_BYTES, stream);
        if (e != hipSuccess) { fprintf(stderr, "cooperative launch failed: %s\n", hipGetErrorString(e)); return; }
    }
#else
    p.ph_lo = 0; p.ph_hi = NSTEP;
    void* args[] = {&p};
    hipError_t e = hipLaunchCooperativeKernel((const void*)mk_fwd, dim3(grid), dim3(512), args, LDS_BYTES, stream);
    if (e != hipSuccess) fprintf(stderr, "cooperative launch failed: %s (grid %d)\n", hipGetErrorString(e), grid);
#endif
}
```

```cpp
#include <hip/hip_runtime.h>
#include <hip/hip_cooperative_groups.h>
#include <cstdio>
#include <cstdint>
namespace cg = cooperative_groups;
__device__ __forceinline__ int otid() { int t = threadIdx.x; asm volatile("" : "+v"(t)); return t; }
namespace pg8 {
#define PG8_LAS __attribute__((address_space(3)))
typedef unsigned short bf16_t;
typedef short bf16x8 __attribute__((ext_vector_type(8)));
typedef float f32x4 __attribute__((ext_vector_type(4)));
typedef unsigned u32x4 __attribute__((ext_vector_type(4)));
constexpr int BM = 256, BK = 64, HALF = 128, HTB = HALF * BK * 2  , STAGE_BYTES = 8 * HTB, NXCD = 8, WGM = 8;

__host__ __device__ __forceinline__ int lds_byte(int r, int c) { const int st = (r >> 4) * 2 + (c >> 5), rr = r & 15, cc = c & 31, ob = rr * 64 + cc * 2; return st * 1024 + (ob ^ (((ob >> 9) & 1) << 5)); }
__host__ __device__ __forceinline__ void stage_rc(int b, int& R, int& C) { const int st = b / 1024, sb = b % 1024, swz = sb ^ (((sb >> 9) & 1) << 5); R = (st >> 1) * 16 + swz / 64; C = (st & 1) * 32 + (swz % 64) / 2; }
__host__ __device__ __forceinline__ int perm32(int rho) { const int n = rho >> 4, i = rho & 15; return 8 * (i >> 2) + 4 * n + (i & 3); }

struct Unit { int pm, pn; };
struct Gemm { const bf16_t* A; const bf16_t* Bt; int M, N; };

struct StaticOrder {
    int nM, nN, nwg, G, c;
    __host__ __device__ void init(int M, int N, int G_, int c_) { nM = M / BM; nN = N / BM; nwg = nM * nN; G = G_; c = c_; }
    __host__ __device__ bool next(int i, Unit& u) const {
        const long L = (long)i * G + c; if (L >= nwg) return false;
        int wgid = (int)L; { const int q = nwg / NXCD, r = nwg % NXCD, xcd = wgid % NXCD, off = wgid / NXCD; wgid = (xcd < r ? xcd * (q + 1) : r * (q + 1) + (xcd - r) * q) + off; }
        const int nig = WGM * nN, gid = wgid / nig, fm = gid * WGM, gsz = (nM - fm) < WGM ? (nM - fm) : WGM;
        u.pm = fm + ((wgid % nig) % gsz); u.pn = (wgid % nig) / gsz; return true;
    }
    __device__ __forceinline__ void a_ready(const Unit&) const {}
    __device__ __forceinline__ void done(const Unit&) const {}
};


template <class Epi, class Sched, bool ALIGN_EPI, bool SP2, int LDA, int LDB, int KDIM>
__device__ __forceinline__ void gemm_phase(PG8_LAS unsigned char* lds, const Gemm g, const Sched& S, const Epi& E) {
    const int tid = otid(), wid = __builtin_amdgcn_readfirstlane(tid >> 6), lane = tid & 63, wr = wid >> 2, wc = wid & 3, fr = lane & 15, fq = lane >> 4;
    constexpr int K = KDIM, nt = K / BK;
    unsigned voffA[2], voffB[2];
#pragma unroll
    for (int i = 0; i < 2; ++i) { int R, C; stage_rc(tid * 16 + i * 8192, R, C); const int Rb = Epi::PERM ? ((R & ~31) + perm32(R & 31)) : R;
        voffA[i] = (unsigned)(R * LDA + C) * 2u; voffB[i] = (unsigned)(Rb * LDB + C) * 2u; }
    constexpr size_t kstep = (size_t)(BK * 2);
    constexpr size_t hstepA = (size_t)HALF * LDA * 2, hstepB = (size_t)HALF * LDB * 2;
    constexpr size_t tstepA = 2 * hstepA, tstepB = 2 * hstepB;
    const unsigned ldsw = (unsigned)wid * 1024u;
    const int aoff = lds_byte(wr * 64 + fr, fq * 8), boff = lds_byte(wc * 32 + fr, fq * 8);
#define PG8_SA(b, h) (((b) * 2 + (h)) * HTB)
#define PG8_SB(b, h) ((4 + (b) * 2 + (h)) * HTB)
#define PG8_STAGE(bufoff, gbase, voff) do { _Pragma("unroll") for (int _i = 0; _i < 2; ++_i) \
        __builtin_amdgcn_global_load_lds((const unsigned*)((const char*)(gbase) + (voff)[_i]), (PG8_LAS unsigned*)(lds + (bufoff) + ldsw + _i * 8192), 16, 0, 0); } while (0)
#define PG8_LDA(dst, b, h) do { _Pragma("unroll") for (int m = 0; m < 4; ++m) _Pragma("unroll") for (int k = 0; k < 2; ++k) dst[m][k] = *(const PG8_LAS bf16x8*)(lds + PG8_SA(b, h) + aoff + m * 2048 + k * 1024); } while (0)
#define PG8_LDB(dst, b, h) do { _Pragma("unroll") for (int n = 0; n < 2; ++n) _Pragma("unroll") for (int k = 0; k < 2; ++k) dst[n][k] = *(const PG8_LAS bf16x8*)(lds + PG8_SB(b, h) + boff + n * 2048 + k * 1024); } while (0)
#define PG8_MMA(ai, bj, At, Bt) do { __builtin_amdgcn_s_setprio(1); _Pragma("unroll") for (int m = 0; m < 4; ++m) _Pragma("unroll") for (int n = 0; n < 2; ++n) _Pragma("unroll") for (int k = 0; k < 2; ++k) \
        acc[ai][bj][m][n] = __builtin_amdgcn_mfma_f32_16x16x32_bf16(Bt[n][k], At[m][k], acc[ai][bj][m][n], 0, 0, 0); __builtin_amdgcn_s_setprio(0); } while (0)
#define PG8_WAIT_V(n) asm volatile("s_waitcnt vmcnt(" #n ")" ::: "memory")
#define PG8_WAIT_L(n) asm volatile("s_waitcnt lgkmcnt(" #n ")" ::: "memory")
#define PG8_BAR __builtin_amdgcn_s_barrier()
#define PG8_SCHED __builtin_amdgcn_sched_barrier(0)
    Unit cur, nxt; int ui = 0;
    if (!S.next(0, cur)) return;
    float zf = 0.f; asm volatile("" : "+v"(zf));
    f32x4 acc[2][2][4][2];
#pragma unroll
    for (int a = 0; a < 2; ++a)
#pragma unroll
        for (int b = 0; b < 2; ++b)
#pragma unroll
            for (int m = 0; m < 4; ++m)
#pragma unroll
                for (int n = 0; n < 2; ++n) acc[a][b][m][n] = (f32x4){zf, zf, zf, zf};
    bf16x8 At[4][2], B0[2][2], B1[2][2];
    const char* cA = (const char*)g.A + (size_t)cur.pm * tstepA; const char* cB = (const char*)g.Bt + (size_t)cur.pn * tstepB;
    S.a_ready(cur);
    if constexpr (SP2) {
        PG8_STAGE(PG8_SB(0, 0), cB, voffB); PG8_STAGE(PG8_SB(0, 1), cB + hstepB, voffB); PG8_STAGE(PG8_SA(0, 0), cA, voffA); PG8_STAGE(PG8_SA(0, 1), cA + hstepA, voffA);
        if (wr == 1) PG8_BAR;
        PG8_WAIT_V(2); PG8_BAR;
        PG8_STAGE(PG8_SB(1, 0), cB + kstep, voffB); PG8_STAGE(PG8_SA(1, 0), cA + kstep, voffA); PG8_STAGE(PG8_SB(1, 1), cB + hstepB + kstep, voffB);
        PG8_WAIT_V(6); PG8_BAR;
    } else {
        PG8_STAGE(PG8_SB(0, 0), cB, voffB); PG8_STAGE(PG8_SA(0, 0), cA, voffA); PG8_STAGE(PG8_SB(0, 1), cB + hstepB, voffB); PG8_STAGE(PG8_SA(0, 1), cA + hstepA, voffA);
        if (wr == 1) PG8_BAR;
        PG8_WAIT_V(4); PG8_BAR;
        PG8_STAGE(PG8_SB(1, 0), cB + kstep, voffB); PG8_STAGE(PG8_SA(1, 0), cA + kstep, voffA); PG8_STAGE(PG8_SB(1, 1), cB + hstepB + kstep, voffB);
        PG8_WAIT_V(6); PG8_BAR;
    }
    for (;;) {
        const bool has_next = S.next(ui + 1, nxt);
        const char* nA = has_next ? (const char*)g.A + (size_t)nxt.pm * tstepA : cA; const char* nB = has_next ? (const char*)g.Bt + (size_t)nxt.pn * tstepB : cB;
#pragma nounroll
        for (int t = 0; t < nt; t += 2) {
            const bool last = (t == nt - 2);
            const char* a1 = cA + (size_t)(t + 1) * kstep;
            const char* a2 = last ? nA : cA + (size_t)(t + 2) * kstep; const char* b2 = last ? nB : cB + (size_t)(t + 2) * kstep;
            const char* a3 = a2 + kstep; const char* b3 = b2 + kstep;
            if (last && has_next) S.a_ready(nxt);
            if constexpr (SP2) {
            PG8_LDB(B0, 0, 0); PG8_LDB(B1, 0, 1); PG8_SCHED; PG8_LDA(At, 0, 0); PG8_STAGE(PG8_SA(1, 1), a1 + hstepA, voffA);
            PG8_WAIT_V(8); PG8_WAIT_L(0); PG8_BAR; PG8_MMA(0, 0, At, B0); PG8_MMA(0, 1, At, B1); PG8_BAR; PG8_SCHED;
            PG8_LDA(At, 0, 1); PG8_STAGE(PG8_SB(0, 0), b2, voffB); PG8_STAGE(PG8_SB(0, 1), b2 + hstepB, voffB); PG8_STAGE(PG8_SA(0, 0), a2, voffA);
            PG8_WAIT_V(8); PG8_WAIT_L(0); PG8_BAR; PG8_MMA(1, 0, At, B0); PG8_MMA(1, 1, At, B1); PG8_BAR; PG8_SCHED;
            PG8_LDB(B0, 1, 0); PG8_LDB(B1, 1, 1); PG8_SCHED; PG8_LDA(At, 1, 0); PG8_STAGE(PG8_SA(0, 1), a2 + hstepA, voffA);
            PG8_WAIT_V(8); PG8_WAIT_L(0); PG8_BAR; PG8_MMA(0, 0, At, B0); PG8_MMA(0, 1, At, B1); PG8_BAR; PG8_SCHED;
            PG8_LDA(At, 1, 1); PG8_STAGE(PG8_SB(1, 0), b3, voffB); PG8_STAGE(PG8_SB(1, 1), b3 + hstepB, voffB); PG8_STAGE(PG8_SA(1, 0), a3, voffA);
            PG8_WAIT_V(8); PG8_WAIT_L(0); PG8_BAR; PG8_MMA(1, 0, At, B0); PG8_MMA(1, 1, At, B1); PG8_BAR; PG8_SCHED;
            } else {
            PG8_LDB(B0, 0, 0); PG8_SCHED; PG8_LDA(At, 0, 0); PG8_STAGE(PG8_SA(1, 1), a1 + hstepA, voffA);
            PG8_WAIT_L(8); PG8_BAR; PG8_WAIT_L(0); PG8_MMA(0, 0, At, B0); PG8_BAR; PG8_SCHED;
            PG8_LDB(B1, 0, 1); PG8_STAGE(PG8_SB(0, 0), b2, voffB);
            PG8_BAR; PG8_WAIT_L(0); PG8_MMA(0, 1, At, B1); PG8_BAR;
            PG8_LDA(At, 0, 1); PG8_STAGE(PG8_SA(0, 0), a2, voffA);
            PG8_BAR; PG8_WAIT_L(0); PG8_MMA(1, 0, At, B0); PG8_BAR; PG8_SCHED;
            PG8_STAGE(PG8_SB(0, 1), b2 + hstepB, voffB);
            PG8_WAIT_V(6); PG8_BAR; PG8_MMA(1, 1, At, B1); PG8_BAR;
            PG8_LDB(B0, 1, 0); PG8_SCHED; PG8_LDA(At, 1, 0); PG8_STAGE(PG8_SA(0, 1), a2 + hstepA, voffA);
            PG8_WAIT_L(8); PG8_BAR; PG8_WAIT_L(0); PG8_MMA(0, 0, At, B0); PG8_BAR; PG8_SCHED;
            PG8_LDB(B1, 1, 1); PG8_STAGE(PG8_SB(1, 0), b3, voffB);
            PG8_BAR; PG8_WAIT_L(0); PG8_MMA(0, 1, At, B1); PG8_BAR;
            PG8_LDA(At, 1, 1); PG8_STAGE(PG8_SA(1, 0), a3, voffA);
            PG8_BAR; PG8_WAIT_L(0); PG8_MMA(1, 0, At, B0); PG8_BAR; PG8_SCHED;
            PG8_STAGE(PG8_SB(1, 1), b3 + hstepB, voffB);
            PG8_WAIT_V(6); PG8_BAR; PG8_MMA(1, 1, At, B1); PG8_BAR;
            }
        }
        if constexpr (ALIGN_EPI) { if (wr == 0) PG8_BAR; }
        if constexpr (!Epi::AFTER_DRAIN) { int fr2 = fr, fq2 = fq; asm volatile("" : "+v"(fr2), "+v"(fq2));
            E(acc, cur, wr, wc, fr2, fq2); S.done(cur); }
        if (!has_next) break;
#pragma unroll
        for (int a = 0; a < 2; ++a)
#pragma unroll
            for (int b = 0; b < 2; ++b)
#pragma unroll
                for (int m = 0; m < 4; ++m)
#pragma unroll
                    for (int n = 0; n < 2; ++n) acc[a][b][m][n] = (f32x4){zf, zf, zf, zf};
        cur = nxt; cA = nA; cB = nB; ++ui;
        if constexpr (ALIGN_EPI) { if (wr == 1) PG8_BAR; }
    }
    PG8_WAIT_V(0);
    if constexpr (!ALIGN_EPI) { if (wr == 0) PG8_BAR; }
    PG8_BAR;
    if constexpr (Epi::AFTER_DRAIN) { E.fused(acc, cur, wr, wc, fr, fq, lds, wid, lane); S.done(cur); }
#undef PG8_SA
#undef PG8_SB
#undef PG8_STAGE
#undef PG8_LDA
#undef PG8_LDB
#undef PG8_MMA
#undef PG8_WAIT_V
#undef PG8_WAIT_L
#undef PG8_BAR
#undef PG8_SCHED
}
}

#define LAS __attribute__((address_space(3)))
typedef unsigned short bf16;
typedef float f32x2 __attribute__((ext_vector_type(2)));
typedef float f32x4 __attribute__((ext_vector_type(4)));
typedef float f32x16 __attribute__((ext_vector_type(16)));
typedef short bf16x8 __attribute__((ext_vector_type(8)));
typedef unsigned u32x4 __attribute__((ext_vector_type(4)));
typedef unsigned u32x2 __attribute__((ext_vector_type(2)));
typedef __bf16 bf16x2_t __attribute__((ext_vector_type(2)));
#define DI __device__ __forceinline__

DI unsigned pk2(float lo, float hi) { f32x2 v = {lo, hi}; bf16x2_t b = __builtin_convertvector(v, bf16x2_t); return __builtin_bit_cast(unsigned, b); }
DI float bflo(unsigned u) { return __uint_as_float(u << 16); }
DI float bfhi(unsigned u) { return __uint_as_float(u & 0xffff0000u); }
DI u32x4 pack8(f32x4 a, f32x4 b) { u32x4 w; w.x = pk2(a[0], a[1]); w.y = pk2(a[2], a[3]); w.z = pk2(b[0], b[1]); w.w = pk2(b[2], b[3]); return w; }
DI float shx(float v, int m) { const int l = (otid() & 63) ^ m; return __builtin_bit_cast(float, __builtin_amdgcn_ds_bpermute(l << 2, __builtin_bit_cast(int, v))); }
DI float wave_sum(float v) {
#pragma unroll
    for (int o = 1; o < 64; o <<= 1) v += shx(v, o);
    return v;
}
DI float ozero() { float z = 0.f; asm volatile("" : "+v"(z)); return z; }
DI float cos_turn(float t) { return __builtin_amdgcn_cosf(t); }
DI float sin_turn(float t) { return __builtin_amdgcn_sinf(t); }
DI float fexp2(float x) { return __builtin_amdgcn_exp2f(x); }
DI float frcp(float x) { return __builtin_amdgcn_rcpf(x); }
#define LDS_WAIT() asm volatile("s_waitcnt lgkmcnt(0)" ::: "memory")

constexpr int DM = 1024, NB = 8, SEQ = 2048, DEPTH = 4, CTXL = 256;
constexpr int NLAT = NB * SEQ, NCTX = NB * CTXL, MTOK = NLAT + NCTX;
constexpr int NPROJ = 1536, DFF = 2816, MIXD = 1280, NKEY = SEQ + CTXL;
constexpr int PO_KR = 384, PO_SU = 416, PO_SV = 672, PO_POOL = 928, PO_F = 1184, IN_DIM = 1440;
constexpr float LN_EPS = 1e-6f;
constexpr float ALPHA = 1.6817928305074290f;
constexpr float QSCALE = 0.10206207261596575f * 1.4426950408889634f;

constexpr size_t WS_XRES = 0;
constexpr size_t WS_HA   = WS_XRES + (size_t)MTOK * DM * 4;
constexpr size_t WS_PROJ = WS_HA + (size_t)MTOK * DM * 2;
constexpr size_t WS_QLAT = WS_PROJ + (size_t)MTOK * NPROJ * 2;
constexpr size_t WS_QCTX = WS_QLAT + (size_t)64 * SEQ * 96 * 2;
constexpr size_t WS_K    = WS_QCTX + (size_t)64 * CTXL * 96 * 2;
constexpr size_t WS_VT   = WS_K + (size_t)64 * NKEY * 96 * 2;
constexpr size_t WS_U    = WS_PROJ;
static_assert((size_t)MTOK * DFF * 2 <= WS_VT - WS_PROJ, "U overlay");
constexpr size_t WS_GTL  = WS_VT + (size_t)64 * 64 * NKEY * 2;
constexpr size_t WS_GTC  = WS_GTL + (size_t)2048 * 4096 * 2;
constexpr size_t WS_MIX  = WS_GTC + (size_t)2048 * 512 * 2;
constexpr size_t WS_WIN  = WS_MIX + (size_t)MTOK * MIXD * 2;
constexpr size_t WS_WQK  = WS_WIN + (size_t)1536 * 1024 * 2;
constexpr size_t WS_WV   = WS_WQK + (size_t)1280 * 384 * 2;
constexpr size_t WS_WF   = WS_WV + (size_t)512 * 384 * 2;
constexpr size_t WS_WOUT = WS_WF + (size_t)512 * 256 * 2;
constexpr size_t WS_W13  = WS_WOUT + (size_t)1024 * 1280 * 2;
constexpr size_t WS_W2   = WS_W13 + (size_t)5632 * 1024 * 2;
constexpr size_t WS_WPOOL= WS_W2 + (size_t)1024 * 2816 * 2;
constexpr size_t WS_WS   = WS_WPOOL + (size_t)4 * 64 * 64 * 2;
constexpr size_t WS_CSL  = WS_WS + (size_t)4 * 128 * 128 * 2;
constexpr size_t WS_CSC  = WS_CSL + (size_t)2048 * 4096 * 2;
constexpr size_t WS_MOD  = WS_CSC + (size_t)256 * 512 * 2;
constexpr size_t WS_ROPE = WS_MOD + (size_t)4 * 9 * 6144 * 4;
constexpr size_t WS_STQ  = WS_ROPE + (size_t)2048 * 32 * 4;
constexpr size_t WS_STKV = WS_STQ + (size_t)MTOK * 4 * 4;
constexpr size_t WS_ST   = WS_STKV + (size_t)MTOK * 4 * 4;
constexpr size_t WS_CTL  = WS_ST + (size_t)MTOK * 2 * 4;
constexpr size_t CTL_BYTES = 16384;
constexpr size_t WS_END  = WS_CTL + CTL_BYTES;
constexpr int MISC_OFF = 139264;

constexpr int LDS_BYTES = 147456;

struct Params { const float* in[27]; float* out; unsigned char* ws; int ph_lo, ph_hi; };
DI const float* inp(const Params& p, int i) { asm volatile("" : "+s"(i)); return p.in[i]; }
DI unsigned char* wsp(const Params& p) { unsigned char* w = p.ws; asm volatile("" : "+s"(w)); return w; }

#define XB_TMO      128
#define XB_XCNT(j)  (256  + 64 * (j))
#define XB_XSUB(j)  (1280 + 64 * (j))
#define XB_XGEN(j)  (2304 + 64 * (j))
#define XB_TOP      3328
#define XB_TOPGEN   3392
#define XCD_BAR_WORDS 3456
#define XB_SPIN_CAP (1u << 18)

__device__ __forceinline__ unsigned xb_ld(unsigned* p)              { return __hip_atomic_load(p, __ATOMIC_RELAXED, __HIP_MEMORY_SCOPE_AGENT); }
__device__ __forceinline__ unsigned xb_add(unsigned* p, unsigned v) { return __hip_atomic_fetch_add(p, v, __ATOMIC_RELAXED, __HIP_MEMORY_SCOPE_AGENT); }
__device__ __forceinline__ unsigned xb_xcc_id() { return (unsigned)__builtin_amdgcn_s_getreg((3 << 11) | 20) & 0xFu; }
#define XB_SPIN(cond, bar) do { unsigned _sp = 0; while (cond) { __builtin_amdgcn_s_sleep(1); \
    if ((++_sp & 255u) == 0u) { if (xb_ld(&(bar)[XB_TMO])) break; if (_sp > XB_SPIN_CAP) { atomicAdd(&(bar)[XB_TMO], 1u); break; } } } } while (0)

struct XcdBarrier {
    unsigned* bar; unsigned x;
    volatile LAS unsigned* st;
};

__device__ __forceinline__ XcdBarrier xcd_barrier_post(unsigned* bar, volatile LAS unsigned* st) {
    XcdBarrier b; b.bar = bar; b.x = xb_xcc_id(); b.st = st;
    if (threadIdx.x == 0) (void)xb_add(&bar[XB_XCNT(b.x)], 1u);
    return b;
}
__device__ __forceinline__ void xcd_barrier_complete(unsigned* bar, unsigned x, unsigned& nloc, unsigned& nx) {
    const unsigned G = gridDim.x * gridDim.y * gridDim.z;
    unsigned sum, cnt, mine, sp = 0u;
    for (;;) {
        sum = 0u; cnt = 0u; mine = 0u;
#pragma unroll
        for (unsigned j = 0; j < 16; ++j) { const unsigned c = xb_ld(&bar[XB_XCNT(j)]); sum += c; cnt += (c > 0u) ? 1u : 0u; mine = (j == x) ? c : mine; }
        if (sum == G) break;
        __builtin_amdgcn_s_sleep(1);
        if ((++sp & 255u) == 0u) { if (xb_ld(&bar[XB_TMO])) break; if (sp > XB_SPIN_CAP) { atomicAdd(&bar[XB_TMO], 1u); break; } }
    }
    nloc = mine > 0u ? mine : 1u; nx = cnt > 0u ? cnt : 1u;
}

__device__ __forceinline__ void xcd_barrier(const XcdBarrier& b) {
    asm volatile("s_waitcnt vmcnt(0)" ::: "memory");
    __syncthreads();
    if (threadIdx.x == 0) {
        unsigned* bar = b.bar;
        __builtin_amdgcn_s_waitcnt(0);
        unsigned nloc = b.st[0], nx = b.st[1];
        if (nloc == 0u) { xcd_barrier_complete(bar, b.x, nloc, nx); b.st[0] = nloc; b.st[1] = nx; }
        const unsigned old = xb_add(&bar[XB_XSUB(b.x)], 1u);
        const unsigned gen = old / nloc;
        if (old + 1u == (gen + 1u) * nloc) {
            __builtin_amdgcn_fence(__ATOMIC_RELEASE, "agent");
            asm volatile("s_waitcnt vmcnt(0)" ::: "memory");
            const unsigned og = xb_add(&bar[XB_TOP], 1u);
            const unsigned tg = og / nx;
            if (og + 1u == (tg + 1u) * nx) xb_add(&bar[XB_TOPGEN], 1u);
            else XB_SPIN(xb_ld(&bar[XB_TOPGEN]) == tg, bar);
            __builtin_amdgcn_fence(__ATOMIC_ACQUIRE, "agent");
            xb_add(&bar[XB_XGEN(b.x)], 1u);
            asm volatile("s_waitcnt vmcnt(0)" ::: "memory");
        } else {
            XB_SPIN(xb_ld(&bar[XB_XGEN(b.x)]) == gen, bar);
            __builtin_amdgcn_fence(__ATOMIC_ACQUIRE, "agent");
            asm volatile("s_waitcnt vmcnt(0)" ::: "memory");
        }
    }
    __syncthreads();
}

typedef pg8::f32x4 A4;
DI void row_info(int row, int& b, int& pos, bool& lat) { lat = row < NLAT; if (lat) { b = row >> 11; pos = row & 2047; } else { b = (row - NLAT) >> 8; pos = (row - NLAT) & 255; } }

struct EpiProj {
    static constexpr bool PERM = true, AFTER_DRAIN = false;
    bf16* O; float* statq; float* statkv;
    DI void operator()(const A4 (&acc)[2][2][4][2], const pg8::Unit& u, int wr, int wc, int fr, int fq) const {
        const int row0 = u.pm * 256 + wr * 64 + fr, col0 = u.pn * 256 + wc * 32 + 8 * fq;
#pragma unroll
        for (int ai = 0; ai < 2; ++ai)
#pragma unroll
            for (int m = 0; m < 4; ++m) {
                const int row = row0 + ai * 128 + m * 16;
                bf16* rowp = O + (size_t)row * NPROJ + col0;
#pragma unroll
                for (int bj = 0; bj < 2; ++bj) *(u32x4*)(rowp + bj * 128) = pack8(acc[ai][bj][m][0], acc[ai][bj][m][1]);
                if (u.pn <= 1) {
                    float s = 0.f;
#pragma unroll
                    for (int bj = 0; bj < 2; ++bj) {
                        if (u.pn == 1 && bj == 1) continue;
#pragma unroll
                        for (int n = 0; n < 2; ++n) { const A4 x = acc[ai][bj][m][n]; s += (x[0] * x[0] + x[1] * x[1]) + (x[2] * x[2] + x[3] * x[3]); }
                    }
                    s += shx(s, 16); s += shx(s, 32);
                    if (fq == 0) { if (u.pn == 0) statq[row * 4 + wc] = s; else statkv[row * 4 + wc] = s; }
                }
            }
    }
};

struct EpiQK {
    static constexpr bool PERM = true, AFTER_DRAIN = false;
    bf16* Ql; bf16* Qc; bf16* Kb; const float* statq; const float* statkv; const float* rope;
    DI void operator()(const A4 (&acc)[2][2][4][2], const pg8::Unit& u, int wr, int wc, int fr, int fq) const {
        const int row0 = u.pm * 256 + wr * 64 + fr, col0 = u.pn * 256 + wc * 32 + 8 * fq;
        const bool isq = u.pn < 3;
#pragma unroll
        for (int ai = 0; ai < 2; ++ai)
#pragma unroll
            for (int m = 0; m < 4; ++m) {
                const int row = row0 + ai * 128 + m * 16;
                int b, pos; bool lat; row_info(row, b, pos, lat);
                const f32x4 st = *(const f32x4*)((isq ? statq : statkv) + row * 4);
                const float ss = (st[0] + st[1]) + (st[2] + st[3]);
                const float rs = isq ? rsqrtf(ss * (1.f / 256.f) + LN_EPS) * QSCALE : rsqrtf(ss * (1.f / 128.f) + LN_EPS);
#pragma unroll
                for (int bj = 0; bj < 2; ++bj) {
                    const int c = col0 + bj * 128;
                    A4 v0 = acc[ai][bj][m][0] * rs, v1 = acc[ai][bj][m][1] * rs;
                    if (isq) {
                        const int g32 = c >> 5, head = g32 / 3, part = g32 - head * 3, d0 = part * 32 + 8 * fq;
                        if (part == 2 && lat) {
                            A4 p0, p1;
#pragma unroll
                            for (int j = 0; j < 4; ++j) { p0[j] = shx(v0[j], 16); p1[j] = shx(v1[j], 16); }
                            const float* rp = rope + pos * 32 + (fq >> 1) * 8;
                            const f32x4 c0 = *(const f32x4*)rp, c1 = *(const f32x4*)(rp + 4), s0 = *(const f32x4*)(rp + 16), s1 = *(const f32x4*)(rp + 20);
                            if (fq & 1) { v0 = p0 * s0 + v0 * c0; v1 = p1 * s1 + v1 * c1; }
                            else        { v0 = v0 * c0 - p0 * s0; v1 = v1 * c1 - p1 * s1; }
                        }
                        bf16* dst = lat ? Ql + ((size_t)(b * 8 + head) * SEQ + pos) * 96 + d0 : Qc + ((size_t)(b * 8 + head) * CTXL + pos) * 96 + d0;
                        *(u32x4*)dst = pack8(v0, v1);
                    } else {
                        const int cc = c - 768, head = cc >> 6, d0 = cc & 63;
                        bf16* dst = Kb + ((size_t)(b * 8 + head) * NKEY + (lat ? CTXL + pos : pos)) * 96 + d0;
                        *(u32x4*)dst = pack8(v0, v1);
                    }
                }
            }
    }
};

DI float rstd_kv_tok(const float* statkv, int t) { const f32x4 st = *(const f32x4*)(statkv + t * 4); return rsqrtf(((st[0] + st[1]) + (st[2] + st[3])) * (1.f / 128.f) + LN_EPS); }

struct EpiVt {
    static constexpr bool PERM = true, AFTER_DRAIN = false;
    bf16* Vt; const float* statkv;
    DI void operator()(const A4 (&acc)[2][2][4][2], const pg8::Unit& u, int wr, int wc, int fr, int fq) const {
        const int row0 = u.pm * 256 + wr * 64 + fr, col0 = u.pn * 256 + wc * 32 + 8 * fq;
#pragma unroll
        for (int bj = 0; bj < 2; ++bj) {
            const int t0 = col0 + bj * 128;
            int b, pos; bool lat; row_info(t0, b, pos, lat);
            A4 r0, r1;
#pragma unroll
            for (int j = 0; j < 4; ++j) { r0[j] = rstd_kv_tok(statkv, t0 + j); r1[j] = rstd_kv_tok(statkv, t0 + 4 + j); }
#pragma unroll
            for (int ai = 0; ai < 2; ++ai)
#pragma unroll
                for (int m = 0; m < 4; ++m) {
                    const int row = row0 + ai * 128 + m * 16, head = row >> 6, dv = row & 63;
                    bf16* dst = Vt + ((size_t)(b * 8 + head) * 64 + dv) * NKEY + (lat ? CTXL + pos : pos);
                    *(u32x4*)dst = pack8(acc[ai][bj][m][0] * r0, acc[ai][bj][m][1] * r1);
                }
        }
    }
};

struct EpiGt {
    static constexpr bool PERM = true, AFTER_DRAIN = false;
    bf16* Gl; bf16* Gc;
    DI void operator()(const A4 (&acc)[2][2][4][2], const pg8::Unit& u, int wr, int wc, int fr, int fq) const {
        const int row0 = u.pm * 256 + wr * 64 + fr, col0 = u.pn * 256 + wc * 32 + 8 * fq;
#pragma unroll
        for (int bj = 0; bj < 2; ++bj) {
            const int t0 = col0 + bj * 128;
            int b, pos; bool lat; row_info(t0, b, pos, lat);
#pragma unroll
            for (int ai = 0; ai < 2; ++ai)
#pragma unroll
                for (int m = 0; m < 4; ++m) {
                    const int row = row0 + ai * 128 + m * 16, n = row & 255, half = row >> 8;
                    bf16* dst = lat ? Gl + (size_t)(b * 256 + n) * 4096 + half * 2048 + pos : Gc + (size_t)(b * 256 + n) * 512 + half * 256 + pos;
                    *(u32x4*)dst = pack8(acc[ai][bj][m][0], acc[ai][bj][m][1]);
                }
        }
    }
};

struct EpiDft {
    static constexpr bool PERM = true, AFTER_DRAIN = false;
    bf16* mix; int row_base, rows_per_b;
    DI void operator()(const A4 (&acc)[2][2][4][2], const pg8::Unit& u, int wr, int wc, int fr, int fq) const {
        const int row0 = u.pm * 256 + wr * 64 + fr, n0 = wc * 32 + 8 * fq;
#pragma unroll
        for (int ai = 0; ai < 2; ++ai)
#pragma unroll
            for (int m = 0; m < 4; ++m) {
                const int k = row0 + ai * 128 + m * 16;
                bf16* rowp = mix + (size_t)(row_base + u.pn * rows_per_b + k) * MIXD + 1024 + n0;
#pragma unroll
                for (int bj = 0; bj < 2; ++bj) *(u32x4*)(rowp + bj * 128) = pack8(acc[ai][bj][m][0], acc[ai][bj][m][1]);
            }
    }
};

struct EpiRes {
    static constexpr bool PERM = true, AFTER_DRAIN = false;
    const float* Xin; float* Xout; const float* ST; const float* lg; const float* lb; const float* modl; int goff; int pm_off;
    DI void operator()(const A4 (&acc)[2][2][4][2], const pg8::Unit& u, int wr, int wc, int fr, int fq) const {
        const int row0 = u.pm * 256 + wr * 64 + fr, col0 = u.pn * 256 + wc * 32 + 8 * fq;
        const int bidx = (u.pm + pm_off < 64) ? ((u.pm + pm_off) >> 3) : 8;
        const float* gp = modl + bidx * 6144 + goff + col0;
        f32x4 g[2][2], ga[2][2], be[2][2];
#pragma unroll
        for (int bj = 0; bj < 2; ++bj) { g[bj][0] = *(const f32x4*)(gp + bj * 128); g[bj][1] = *(const f32x4*)(gp + bj * 128 + 4); }
        const bool has_ln = lg != nullptr;
        if (has_ln) {
#pragma unroll
            for (int bj = 0; bj < 2; ++bj) { ga[bj][0] = *(const f32x4*)(lg + col0 + bj * 128) * ALPHA; ga[bj][1] = *(const f32x4*)(lg + col0 + bj * 128 + 4) * ALPHA;
                                             be[bj][0] = *(const f32x4*)(lb + col0 + bj * 128) * ALPHA; be[bj][1] = *(const f32x4*)(lb + col0 + bj * 128 + 4) * ALPHA; }
        } else {
#pragma unroll
            for (int bj = 0; bj < 2; ++bj) { ga[bj][0] = (f32x4){ALPHA, ALPHA, ALPHA, ALPHA}; ga[bj][1] = ga[bj][0]; be[bj][0] = (f32x4){0.f, 0.f, 0.f, 0.f}; be[bj][1] = be[bj][0]; }
        }
#pragma unroll
        for (int ai = 0; ai < 2; ++ai)
#pragma unroll
            for (int m = 0; m < 4; ++m) {
                const int row = row0 + ai * 128 + m * 16;
                float mean = 0.f, rstd = 1.f;
                if (has_ln) { const f32x2 st = *(const f32x2*)(ST + 2 * row); mean = st[0]; rstd = st[1]; }
                const float* rin = Xin + (size_t)row * DM + col0; float* rout = Xout + (size_t)row * DM + col0;
#pragma unroll
                for (int bj = 0; bj < 2; ++bj) {
                    f32x4 x0 = *(const f32x4*)(rin + bj * 128), x1 = *(const f32x4*)(rin + bj * 128 + 4);
                    x0 = (x0 - mean) * rstd * ga[bj][0] + be[bj][0] + g[bj][0] * acc[ai][bj][m][0];
                    x1 = (x1 - mean) * rstd * ga[bj][1] + be[bj][1] + g[bj][1] * acc[ai][bj][m][1];
                    *(f32x4*)(rout + bj * 128) = x0; *(f32x4*)(rout + bj * 128 + 4) = x1;
                }
            }
    }
};

DI f32x4 silu4(f32x4 a) { f32x4 r; for (int j = 0; j < 4; ++j) r[j] = a[j] * frcp(1.f + fexp2(-1.4426950408889634f * a[j])); return r; }
struct EpiSwiglu {
    static constexpr bool PERM = true, AFTER_DRAIN = false;
    bf16* U;
    DI void operator()(const A4 (&acc)[2][2][4][2], const pg8::Unit& u, int wr, int wc, int fr, int fq) const {
        const int row0 = u.pm * 256 + wr * 64 + fr, col0 = u.pn * 128 + wc * 32 + 8 * fq;
#pragma unroll
        for (int ai = 0; ai < 2; ++ai)
#pragma unroll
            for (int m = 0; m < 4; ++m) {
                const f32x4 h0 = silu4(acc[ai][0][m][0]) * acc[ai][1][m][0], h1 = silu4(acc[ai][0][m][1]) * acc[ai][1][m][1];
                *(u32x4*)(U + (size_t)(row0 + ai * 128 + m * 16) * DFF + col0) = pack8(h0, h1);
            }
    }
};

template <int M, int N> struct StaticOrderT {
    static constexpr int nM = M / 256, nN = N / 256, nwg = nM * nN;
    int G, c;
    static DI void map(int L, pg8::Unit& u) {
        int wgid = L; { constexpr int q = nwg / 8, r = nwg % 8; const int xcd = wgid % 8, off = wgid / 8; wgid = (xcd < r ? xcd * (q + 1) : r * (q + 1) + (xcd - r) * q) + off; }
        constexpr int nig = 8 * nN; const int gid = wgid / nig, fm = gid * 8, gsz = (nM - fm) < 8 ? (nM - fm) : 8;
        if constexpr (nM % 8 == 0) { u.pm = fm + ((wgid % nig) & 7); u.pn = (wgid % nig) >> 3; }
        else { u.pm = fm + ((wgid % nig) % gsz); u.pn = (wgid % nig) / gsz; }
    }
    DI bool next(int i, pg8::Unit& u) const { const int L = i * G + c; if (L >= nwg) return false; map(L, u); return true; }
    DI void a_ready(const pg8::Unit&) const {}
    DI void done(const pg8::Unit&) const {}
};
constexpr int CW_GCTX = 3584;
struct SchedG {
    int c; unsigned* cnt;
    DI bool next(int i, pg8::Unit& u) const {
        int L;
        if (c < 224) { L = c + 224 * i; if (L >= 1456) return false; }
        else { if (i >= 4) return false; L = 1456 + (c - 224) + 32 * i; }
        if (L < 176) { u.pm = 64 + (L & 7); u.pn = L >> 3; }
        else StaticOrderT<NLAT, 2 * DFF>::map(L - 176, u);
        return true;
    }
    DI void a_ready(const pg8::Unit&) const {}
    DI void done(const pg8::Unit& u) const {
        if (u.pm >= 64) {
            asm volatile("s_waitcnt vmcnt(0)" ::: "memory");
            __syncthreads();
            if (otid() == 0) { __builtin_amdgcn_fence(__ATOMIC_RELEASE, "agent"); asm volatile("s_waitcnt vmcnt(0)" ::: "memory"); (void)xb_add(cnt, 1u); }
        }
    }
};
constexpr int CW_ECTX = 3648;
DI void publish_block(unsigned* cnt) {
    asm volatile("s_waitcnt vmcnt(0)" ::: "memory");
    __syncthreads();
    if (otid() == 0) { __builtin_amdgcn_fence(__ATOMIC_RELEASE, "agent"); asm volatile("s_waitcnt vmcnt(0)" ::: "memory"); (void)xb_add(cnt, 1u); }
}
template <int M, int N> struct StaticOrderSig {
    int G, c; unsigned* cnt;
    DI bool next(int i, pg8::Unit& u) const { const int L = i * G + c; if (L >= StaticOrderT<M, N>::nwg) return false; StaticOrderT<M, N>::map(L, u); return true; }
    DI void a_ready(const pg8::Unit&) const {}
    DI void done(const pg8::Unit&) const { publish_block(cnt); }
};
struct SchedHC {
    int c; unsigned* cnt; unsigned target;
    DI bool next(int i, pg8::Unit& u) const { if (i > 0 || c < 224 || c >= 256) return false; const int k = c - 224; u.pm = k & 7; u.pn = k >> 3; return true; }
    DI void a_ready(const pg8::Unit&) const {
        if (otid() == 0) { unsigned sp = 0; while (xb_ld(cnt) < target) { __builtin_amdgcn_s_sleep(1); if (++sp > (1u << 22)) break; }
            __builtin_amdgcn_fence(__ATOMIC_ACQUIRE, "agent"); asm volatile("s_waitcnt vmcnt(0)" ::: "memory"); }
        __syncthreads();
    }
    DI void done(const pg8::Unit&) const {}
};
template <int LDA, int LDB, int KDIM, class Sched, class Epi> DI void run_gemm_s(LAS unsigned char* lds, const bf16* A, const bf16* Bt, int M, int N, const Sched& S, const Epi& E) {
    pg8::Gemm g{A, Bt, M, N};
    pg8::gemm_phase<Epi, Sched, true, true, LDA, LDB, KDIM>(lds, g, S, E);
    __syncthreads();
}
template <int LDA, int LDB, int KDIM, int M, int N, class Epi> DI void run_gemm(LAS unsigned char* lds, const bf16* A, const bf16* Bt, int G, int c, const Epi& E) {
    pg8::Gemm g{A, Bt, M, N};
    StaticOrderT<M, N> S; S.G = G; S.c = c;
    pg8::gemm_phase<Epi, StaticOrderT<M, N>, true, true, LDA, LDB, KDIM>(lds, g, S, E);
    __syncthreads();
}

template <int NR> DI void row_pass_n(const float* const (&src)[NR], const float* lg, const float* lb, float* const (&dstx)[NR], bf16* const (&dsth)[NR],
                                     const float* const (&sc)[NR], const float* const (&sh)[NR], float* const (&stat)[NR], bool has_stat, bool has_x, bool has_h, int lane) {
    f32x4 v[NR][4]; float s[NR];
#pragma unroll
    for (int r = 0; r < NR; ++r) { const f32x4* xr = (const f32x4*)src[r] + lane; s[r] = 0.f;
#pragma unroll
        for (int j = 0; j < 4; ++j) { v[r][j] = xr[64 * j]; } }
    if (lg) {
#pragma unroll
        for (int r = 0; r < NR; ++r)
#pragma unroll
            for (int j = 0; j < 4; ++j) s[r] += (v[r][j][0] + v[r][j][1]) + (v[r][j][2] + v[r][j][3]);
#pragma unroll
        for (int o = 1; o < 64; o <<= 1)
#pragma unroll
            for (int r = 0; r < NR; ++r) s[r] += shx(s[r], o);
        float s2[NR];
#pragma unroll
        for (int r = 0; r < NR; ++r) { const float mean = s[r] * (1.f / DM); s2[r] = 0.f;
#pragma unroll
            for (int j = 0; j < 4; ++j) { v[r][j] = v[r][j] - mean; s2[r] += (v[r][j][0] * v[r][j][0] + v[r][j][1] * v[r][j][1]) + (v[r][j][2] * v[r][j][2] + v[r][j][3] * v[r][j][3]); } }
#pragma unroll
        for (int o = 1; o < 64; o <<= 1)
#pragma unroll
            for (int r = 0; r < NR; ++r) s2[r] += shx(s2[r], o);
#pragma unroll
        for (int j = 0; j < 4; ++j) { const f32x4 gg = ((const f32x4*)lg)[lane + 64 * j], bb = ((const f32x4*)lb)[lane + 64 * j];
#pragma unroll
            for (int r = 0; r < NR; ++r) { const float rstd = rsqrtf(s2[r] * (1.f / DM) + LN_EPS); v[r][j] = v[r][j] * rstd * gg + bb; } }
        if (has_stat) {
#pragma unroll
            for (int r = 0; r < NR; ++r) if (lane == 0) { f32x2 st2; st2[0] = s[r] * (1.f / DM); st2[1] = rsqrtf(s2[r] * (1.f / DM) + LN_EPS); *(f32x2*)stat[r] = st2; }
        }
    }
    if (has_x) {
#pragma unroll
        for (int r = 0; r < NR; ++r)
#pragma unroll
            for (int j = 0; j < 4; ++j) ((f32x4*)dstx[r])[lane + 64 * j] = v[r][j];
    }
    if (has_h) {
#pragma unroll
        for (int r = 0; r < NR; ++r)
#pragma unroll
            for (int j = 0; j < 4; ++j) {
                const f32x4 a = ((const f32x4*)sc[r])[lane + 64 * j], d = ((const f32x4*)sh[r])[lane + 64 * j];
                const f32x4 h = v[r][j] * (a + 1.f) + d;
                u32x2 w; w.x = pk2(h[0], h[1]); w.y = pk2(h[2], h[3]);
                ((u32x2*)dsth[r])[lane + 64 * j] = w;
            }
    }
}
DI void rows_phase(const Params& p, int mode, int nrows, const float* lg, const float* lb, const float* modl, int sc_off, int sh_off, int gw, int ngw, int lane) {
    float* XRES = (float*)(wsp(p) + WS_XRES); bf16* HA = (bf16*)(wsp(p) + WS_HA); float* STA = (float*)(wsp(p) + WS_ST);
    constexpr int NR = 3;
    for (int row0 = gw; row0 < nrows; row0 += NR * ngw) {
        const float* src[NR]; float* dx[NR]; bf16* dh[NR]; const float* sc[NR]; const float* sh[NR]; float* stp[NR];
#pragma unroll
        for (int r = 0; r < NR; ++r) {
            int row = row0 + r * ngw; if (row >= nrows) row = row0;
            const int bidx = row < NLAT ? (row >> 11) : 8;
            src[r] = (mode == 0) ? (row < NLAT ? inp(p, 0) + (size_t)row * DM : inp(p, 2) + (size_t)(row - NLAT) * DM) : XRES + (size_t)row * DM;
            dx[r] = p.out + (size_t)(row < NLAT ? row : 0) * DM; dh[r] = HA + (size_t)row * DM; stp[r] = STA + 2 * row;
            sc[r] = modl + bidx * 6144 + sc_off; sh[r] = modl + bidx * 6144 + sh_off;
        }
        row_pass_n<NR>(src, lg, lb, dx, dh, sc, sh, stp, mode == 1, mode == 2, mode != 2, lane);
    }
}

template <class RM> DI void tr_item(const float* W, int ldsrc, int k0, int n0, bf16* dst, int lddst, int coloff, const float* kscale, RM rm, LAS float* scr, int lane) {
    {
        const int kq = lane >> 3, nq = lane & 7;
        f32x4 wv[8];
#pragma unroll
        for (int i = 0; i < 8; ++i) wv[i] = *(const f32x4*)(W + (size_t)(k0 + 8 * i + kq) * ldsrc + n0 + 4 * nq);
#pragma unroll
        for (int i = 0; i < 8; ++i) { const int kk = 8 * i + kq; f32x4 w = wv[i]; if (kscale) w = w * kscale[k0 + kk];
            LAS float* d = scr + kk * 33 + 4 * nq; d[0] = w[0]; d[1] = w[1]; d[2] = w[2]; d[3] = w[3]; }
    }
    LDS_WAIT(); asm volatile("" ::: "memory");
    const int c = lane & 7;
#pragma unroll
    for (int j = 0; j < 4; ++j) { const int n = (lane >> 3) + 8 * j; const LAS float* s = scr + (8 * c) * 33 + n;
        u32x4 o; o.x = pk2(s[0 * 33], s[1 * 33]); o.y = pk2(s[2 * 33], s[3 * 33]); o.z = pk2(s[4 * 33], s[5 * 33]); o.w = pk2(s[6 * 33], s[7 * 33]);
        *(u32x4*)(dst + (size_t)rm(n0 + n) * lddst + coloff + k0 + 8 * c) = o; }
    LDS_WAIT(); asm volatile("" ::: "memory");
}
struct RmId { int off; DI int operator()(int n) const { return n + off; } };
struct RmFfn { int off; DI int operator()(int n) const { return 256 * (n >> 7) + (n & 127) + off; } };

DI void zero_rect(bf16* dst, int ld, int row0, int nrows, int col0, int ncols, int gtid, int gthreads) {
    const int cpr = ncols >> 3, total = nrows * cpr; const unsigned zu = __float_as_uint(ozero());
    for (int e = gtid; e < total; e += gthreads) { const int r = e / cpr, cc = e - r * cpr; *(u32x4*)(dst + (size_t)(row0 + r) * ld + col0 + cc * 8) = (u32x4){zu, zu, zu, zu}; }
}

DI void phase_convert(const Params& p, int l, LAS unsigned char* lds, int gw, int ngw, int lane, int gtid, int gthreads) {
    unsigned char* ws = wsp(p);
    LAS float* scr = (LAS float*)(lds + (otid() >> 6) * 16384);
    bf16* Wtin = (bf16*)(ws + WS_WIN); bf16* Wtqk = (bf16*)(ws + WS_WQK); bf16* Wtv = (bf16*)(ws + WS_WV); bf16* Wtf = (bf16*)(ws + WS_WF);
    bf16* Wtout = (bf16*)(ws + WS_WOUT); bf16* Wt13 = (bf16*)(ws + WS_W13); bf16* Wt2 = (bf16*)(ws + WS_W2); bf16* Wtpool = (bf16*)(ws + WS_WPOOL); bf16* Wsb = (bf16*)(ws + WS_WS);
    const float* w_in = inp(p, 6) + (size_t)l * 1024 * 1440; const float* qn = inp(p, 7) + l * 256; const float* w_uq = inp(p, 8) + (size_t)l * 256 * 768;
    const float* kvn = inp(p, 9) + l * 128; const float* w_uk = inp(p, 10) + (size_t)l * 128 * 512; const float* w_uv = inp(p, 11) + (size_t)l * 128 * 512;
    const float* w_sp = inp(p, 14) + (size_t)l * 4 * 128 * 128; const float* w_pool = inp(p, 16) + (size_t)l * 4 * 64 * 64; const float* w_f = inp(p, 18) + (size_t)l * 256 * 256;
    const float* w_out = inp(p, 19) + (size_t)l * 1280 * 1024; const float* w1 = inp(p, 22) + (size_t)l * 1024 * DFF; const float* w3 = inp(p, 23) + (size_t)l * 1024 * DFF; const float* w2 = inp(p, 24) + (size_t)l * DFF * 1024;
    constexpr int I_IN = 16 * 45, I_UQ = 4 * 24, I_UK = 2 * 16, I_UV = 2 * 16, I_OUT = 20 * 32, I_F1 = 16 * 88, I_F3 = 16 * 88, I_F2 = 44 * 32, I_POOL = 8;
    constexpr int NITEMS = I_IN + I_UQ + I_UK + I_UV + I_OUT + I_F1 + I_F3 + I_F2 + I_POOL;
    for (int it = gw; it < NITEMS; it += ngw) {
        int r = it;
        if (r < I_IN) { tr_item(w_in, 1440, 64 * (r / 45), 32 * (r % 45), Wtin, 1024, 0, nullptr, RmId{0}, scr, lane); continue; } r -= I_IN;
        if (r < I_UQ) { tr_item(w_uq, 768, 64 * (r / 24), 32 * (r % 24), Wtqk, 384, 0, qn, RmId{0}, scr, lane); continue; } r -= I_UQ;
        if (r < I_UK) { tr_item(w_uk, 512, 64 * (r / 16), 32 * (r % 16), Wtqk, 384, 256, kvn, RmId{768}, scr, lane); continue; } r -= I_UK;
        if (r < I_UV) { tr_item(w_uv, 512, 64 * (r / 16), 32 * (r % 16), Wtv, 384, 256, kvn, RmId{0}, scr, lane); continue; } r -= I_UV;
        if (r < I_OUT) { tr_item(w_out, 1024, 64 * (r / 32), 32 * (r % 32), Wtout, 1280, 0, nullptr, RmId{0}, scr, lane); continue; } r -= I_OUT;
        if (r < I_F1) { tr_item(w1, DFF, 64 * (r / 88), 32 * (r % 88), Wt13, 1024, 0, nullptr, RmFfn{0}, scr, lane); continue; } r -= I_F1;
        if (r < I_F3) { tr_item(w3, DFF, 64 * (r / 88), 32 * (r % 88), Wt13, 1024, 0, nullptr, RmFfn{128}, scr, lane); continue; } r -= I_F3;
        if (r < I_F2) { tr_item(w2, 1024, 64 * (r / 32), 32 * (r % 32), Wt2, DFF, 0, nullptr, RmId{0}, scr, lane); continue; } r -= I_F2;
        { const int gi = r >> 1; tr_item(w_pool + gi * 4096, 64, 0, 32 * (r & 1), Wtpool + gi * 4096, 64, 0, nullptr, RmId{0}, scr, lane); }
    }
    zero_rect(Wtin, 1024, 1440, 96, 0, 1024, gtid, gthreads);
    zero_rect(Wtqk, 384, 0, 768, 256, 128, gtid, gthreads);
    zero_rect(Wtqk, 384, 768, 512, 0, 256, gtid, gthreads);
    zero_rect(Wtv, 384, 0, 512, 0, 256, gtid, gthreads);
    for (int e = gtid; e < 4 * 128 * 128 / 4; e += gthreads) { const f32x4 v = ((const f32x4*)w_sp)[e]; u32x2 w; w.x = pk2(v[0], v[1]); w.y = pk2(v[2], v[3]); ((u32x2*)Wsb)[e] = w; }
    for (int e = gtid; e < 256 * 256; e += gthreads) {
        const int n = e & 255, gc = e >> 8, g = gc >> 6, c = gc & 63;
        float sc_ = 0.f, ss_ = 0.f;
        for (int m = 0; m < 64; ++m) { const float w = w_f[(size_t)(g * 64 + m) * 256 + n]; const float a = (float)((m * c) & 63) * (1.f / 64.f); sc_ += cos_turn(a) * w; ss_ += sin_turn(a) * w; }
        Wtf[(size_t)n * 256 + gc] = (bf16)(pk2(sc_, 0.f) & 0xffffu); Wtf[(size_t)(256 + n) * 256 + gc] = (bf16)(pk2(-ss_, 0.f) & 0xffffu);
    }
}

DI void phase_prologue(const Params& p, LAS unsigned char* lds, int G, int bid) {
    const int tid = otid();
    LAS float* S = (LAS float*)lds;
    LAS float* red = (LAS float*)(lds + 40960);
    const float* cvec = inp(p, 1); const float* ccv = inp(p, 3); const float* w_mod = inp(p, 4); const float* b_mod = inp(p, 5);
    float* MOD = (float*)(wsp(p) + WS_MOD);
    for (int i = tid; i < 9 * 1024; i += 512) { const float v = i < 8192 ? cvec[i] : ccv[i - 8192]; S[i] = v * frcp(1.f + fexp2(-1.4426950408889634f * v)); }
    __syncthreads();
    for (int item = bid; item < 4 * 96; item += G) {
        const int l = item / 96, n0 = (item - l * 96) * 64, j = tid & 63, ks = tid >> 6;
        const float* W = w_mod + (size_t)l * 1024 * 6144 + n0 + j;
        float a0 = 0, a1 = 0, a2 = 0, a3 = 0, a4 = 0, a5 = 0, a6 = 0, a7 = 0, a8 = 0;
#pragma unroll 32
        for (int k = ks * 128; k < ks * 128 + 128; ++k) {
            const float w = W[(size_t)k * 6144];
            a0 += S[k] * w; a1 += S[1024 + k] * w; a2 += S[2048 + k] * w; a3 += S[3072 + k] * w; a4 += S[4096 + k] * w;
            a5 += S[5120 + k] * w; a6 += S[6144 + k] * w; a7 += S[7168 + k] * w; a8 += S[8192 + k] * w;
        }
        LAS float* rr = red + ks * 576 + j;
        rr[0] = a0; rr[64] = a1; rr[128] = a2; rr[192] = a3; rr[256] = a4; rr[320] = a5; rr[384] = a6; rr[448] = a7; rr[512] = a8;
        __syncthreads();
        for (int o = tid; o < 576; o += 512) {
            const int r = o >> 6, jj = o & 63; float s = b_mod[l * 6144 + n0 + jj];
#pragma unroll
            for (int k2 = 0; k2 < 8; ++k2) s += red[k2 * 576 + o];
            MOD[(size_t)(l * 9 + r) * 6144 + n0 + jj] = s;
        }
        __syncthreads();
    }
    const int gtid = bid * 512 + tid, gthreads = G * 512;
    bf16* CSL = (bf16*)(wsp(p) + WS_CSL); bf16* CSC = (bf16*)(wsp(p) + WS_CSC);
    for (int ch = gtid; ch < 1048576 + 16384; ch += gthreads) {
        float v[8];
        if (ch < 1048576) {
            const int k = ch >> 9, l0 = (ch & 511) * 8, half = l0 >> 11, lb = l0 & 2047; const float scale = 0.00276213586400995f;
#pragma unroll
            for (int j = 0; j < 8; ++j) { const float a = (float)((k * (lb + j)) & 2047) * (1.f / 2048.f); v[j] = (half ? sin_turn(a) : cos_turn(a)) * scale; }
            u32x4 w; w.x = pk2(v[0], v[1]); w.y = pk2(v[2], v[3]); w.z = pk2(v[4], v[5]); w.w = pk2(v[6], v[7]);
            *(u32x4*)(CSL + (size_t)k * 4096 + l0) = w;
        } else {
            const int c2 = ch - 1048576, k = c2 >> 6, l0 = (c2 & 63) * 8, half = l0 >> 8, lb = l0 & 255; const float scale = 1.f / 128.f;
#pragma unroll
            for (int j = 0; j < 8; ++j) { const float a = (float)((k * (lb + j)) & 255) * (1.f / 256.f); v[j] = (half ? sin_turn(a) : cos_turn(a)) * scale; }
            u32x4 w; w.x = pk2(v[0], v[1]); w.y = pk2(v[2], v[3]); w.z = pk2(v[4], v[5]); w.w = pk2(v[6], v[7]);
            *(u32x4*)(CSC + (size_t)k * 512 + l0) = w;
        }
    }
    float* ROPE = (float*)(wsp(p) + WS_ROPE);
    for (int e = gtid; e < 2048 * 16; e += gthreads) {
        const int pos = e >> 4, f = e & 15, axis = f >> 3, fi = f & 7;
        const float coord = (float)(axis ? (pos & 63) : (pos >> 6));
        const float inv = fexp2(-(float)fi * (13.287712379549449f / 8.f));
        const float ang = coord * inv * 0.15915494309189535f;
        ROPE[pos * 32 + f] = cos_turn(ang); ROPE[pos * 32 + 16 + f] = sin_turn(ang);
    }
}

DI f32x4 mfma16(bf16x8 a, bf16x8 b, f32x4 c) { return __builtin_amdgcn_mfma_f32_16x16x32_bf16(a, b, c, 0, 0, 0); }
DI f32x16 mfma32(bf16x8 a, bf16x8 b, f32x16 c) { return __builtin_amdgcn_mfma_f32_32x32x16_bf16(a, b, c, 0, 0, 0); }

DI void sgu_item(const Params& p, int l, int ci, int g, LAS unsigned char* lds) {
    const int tid = otid(), lane = tid & 63, w = tid >> 6;
    const bf16* proj = (const bf16*)(wsp(p) + WS_PROJ); bf16* mix = (bf16*)(wsp(p) + WS_MIX); const bf16* Wsb = (const bf16*)(wsp(p) + WS_WS);
    const float* gam = inp(p, 12) + l * 256; const float* bet = inp(p, 13) + l * 256; const float* bsp = inp(p, 15) + l * 512;
    constexpr int PITCH = 136;
    LAS bf16* vnT = (LAS bf16*)lds;
    const int r0 = ci * 128;
    const int fr = lane & 15, fq = lane >> 4, pp = 16 * w + fr, tok = r0 + pp;
    bf16x8 wfr[4]; u32x2 uu[4];
#pragma unroll
    for (int ks = 0; ks < 4; ++ks) wfr[ks] = *(const bf16x8*)(Wsb + (size_t)(g * 128 + pp) * 128 + ks * 32 + fq * 8);
#pragma unroll
    for (int ct = 0; ct < 4; ++ct) uu[ct] = *(const u32x2*)(proj + (size_t)tok * NPROJ + PO_SU + g * 64 + ct * 16 + fq * 4);
    const float bs = bsp[g * 128 + pp];
    {
        const int q = tid >> 2, j = tid & 3;
        const u32x4* src = (const u32x4*)(proj + (size_t)(r0 + q) * NPROJ + PO_SV + j * 64);
        float v[64]; float s = 0.f;
#pragma unroll
        for (int i = 0; i < 8; ++i) { const u32x4 x = src[i];
            v[8 * i + 0] = bflo(x.x); v[8 * i + 1] = bfhi(x.x); v[8 * i + 2] = bflo(x.y); v[8 * i + 3] = bfhi(x.y);
            v[8 * i + 4] = bflo(x.z); v[8 * i + 5] = bfhi(x.z); v[8 * i + 6] = bflo(x.w); v[8 * i + 7] = bfhi(x.w); }
#pragma unroll
        for (int i = 0; i < 64; ++i) s += v[i];
        s += shx(s, 1); s += shx(s, 2);
        const float mean = s * (1.f / 256.f); float s2 = 0.f;
#pragma unroll
        for (int i = 0; i < 64; ++i) { v[i] -= mean; s2 += v[i] * v[i]; }
        s2 += shx(s2, 1); s2 += shx(s2, 2);
        const float rstd = rsqrtf(s2 * (1.f / 256.f) + LN_EPS);
        if (j == g) {
#pragma unroll
            for (int c = 0; c < 64; ++c) { const float vn = v[c] * rstd * gam[g * 64 + c] + bet[g * 64 + c]; vnT[c * PITCH + q] = (bf16)(pk2(vn, 0.f) & 0xffffu); }
        }
    }
    __syncthreads();
    {
        f32x4 acc[4]; const float zf = ozero();
#pragma unroll
        for (int ct = 0; ct < 4; ++ct) acc[ct] = (f32x4){zf, zf, zf, zf};
#pragma unroll
        for (int ks = 0; ks < 4; ++ks) {
            const bf16x8 bfr = wfr[ks];
#pragma unroll
            for (int ct = 0; ct < 4; ++ct) { const bf16x8 afr = *(const LAS bf16x8*)(vnT + (ct * 16 + fr) * PITCH + ks * 32 + fq * 8); acc[ct] = mfma16(afr, bfr, acc[ct]); }
        }
#pragma unroll
        for (int ct = 0; ct < 4; ++ct) {
            const int c0 = g * 64 + ct * 16 + fq * 4;
            u32x2 o; o.x = pk2(bflo(uu[ct].x) * (acc[ct][0] + bs), bfhi(uu[ct].x) * (acc[ct][1] + bs)); o.y = pk2(bflo(uu[ct].y) * (acc[ct][2] + bs), bfhi(uu[ct].y) * (acc[ct][3] + bs));
            *(u32x2*)(mix + (size_t)tok * MIXD + 512 + c0) = o;
        }
    }
    __syncthreads();
}

DI void pool_item(const Params& p, int l, int ti, int gi, LAS unsigned char* lds) {
    const int tid = otid(), lane = tid & 63, w = tid >> 6;
    const bf16* proj = (const bf16*)(wsp(p) + WS_PROJ); bf16* mix = (bf16*)(wsp(p) + WS_MIX); const bf16* Wtp = (const bf16*)(wsp(p) + WS_WPOOL) + gi * 4096;
    const float* pscale = inp(p, 17) + l * 256 + gi * 64;
    LAS float* Pl = (LAS float*)lds;
    LAS bf16* Dl = (LAS bf16*)(lds + 40960);
    const int r0 = ti * 128, half = 1 << gi;
    int sb, se; if (r0 < NLAT) { sb = r0 & ~2047; se = sb + 2048; } else { sb = NLAT + ((r0 - NLAT) & ~255); se = sb + 256; }
    const unsigned zu = __float_as_uint(ozero());
    const int fr = lane & 15, fq = lane >> 4;
    bf16x8 wfr[2][4]; f32x4 psc[4];
#pragma unroll
    for (int ks = 0; ks < 2; ++ks)
#pragma unroll
        for (int nt = 0; nt < 4; ++nt) wfr[ks][nt] = *(const bf16x8*)(Wtp + (nt * 16 + fr) * 64 + ks * 32 + fq * 8);
#pragma unroll
    for (int nt = 0; nt < 4; ++nt) psc[nt] = *(const f32x4*)(pscale + nt * 16 + fq * 4);
    for (int e = tid; e < 144 * 8; e += 512) {
        const int rr = e >> 3, c8 = (e & 7) * 8, r = r0 - 8 + rr;
        u32x4 x = (u32x4){zu, zu, zu, zu};
        if (r >= sb && r < se) x = *(const u32x4*)(proj + (size_t)r * NPROJ + PO_POOL + gi * 64 + c8);
        LAS float* d = Pl + rr * 65 + c8;
        d[0] = bflo(x.x); d[1] = bfhi(x.x); d[2] = bflo(x.y); d[3] = bfhi(x.y); d[4] = bflo(x.z); d[5] = bfhi(x.z); d[6] = bflo(x.w); d[7] = bfhi(x.w);
    }
    __syncthreads();
    {
        const int c = tid & 63, t0 = (tid >> 6) * 16;
        float s = 0.f;
        for (int rr = t0 + 8 - half; rr < t0 + 8 + half; ++rr) s += Pl[rr * 65 + c];
        float add[15], sub[15], ctr[16];
#pragma unroll
        for (int i = 0; i < 15; ++i) { add[i] = Pl[(t0 + i + 8 + half) * 65 + c]; sub[i] = Pl[(t0 + i + 8 - half) * 65 + c]; }
#pragma unroll
        for (int i = 0; i < 16; ++i) ctr[i] = Pl[(t0 + i + 8) * 65 + c];
#pragma unroll
        for (int i = 0; i < 16; ++i) {
            const int r = r0 + t0 + i;
            const int lo = max(r - half, sb), hi = min(r + half, se);
            const float d = s * frcp((float)(hi - lo)) - ctr[i];
            Dl[(t0 + i) * 72 + c] = (bf16)(pk2(d, 0.f) & 0xffffu);
            if (i < 15) s += add[i] - sub[i];
        }
    }
    __syncthreads();
    {
        const int t = 16 * w + fr;
        f32x4 acc[4]; const float zf = ozero();
#pragma unroll
        for (int nt = 0; nt < 4; ++nt) acc[nt] = (f32x4){zf, zf, zf, zf};
#pragma unroll
        for (int ks = 0; ks < 2; ++ks) {
            const bf16x8 bfr = *(const LAS bf16x8*)(Dl + t * 72 + ks * 32 + fq * 8);
#pragma unroll
            for (int nt = 0; nt < 4; ++nt) acc[nt] = mfma16(wfr[ks][nt], bfr, acc[nt]);
        }
#pragma unroll
        for (int nt = 0; nt < 4; ++nt) {
            const int n0 = nt * 16 + fq * 4; const f32x4 sc = psc[nt];
            u32x2 o; o.x = pk2(acc[nt][0] * sc[0], acc[nt][1] * sc[1]); o.y = pk2(acc[nt][2] * sc[2], acc[nt][3] * sc[3]);
            *(u32x2*)(mix + (size_t)(r0 + t) * MIXD + 768 + gi * 64 + n0) = o;
        }
    }
    __syncthreads();
}

DI void krope_items(const Params& p, int gtid, int gthreads) {
    const bf16* proj = (const bf16*)(wsp(p) + WS_PROJ); bf16* Kb = (bf16*)(wsp(p) + WS_K); const float* rope = (const float*)(wsp(p) + WS_ROPE);
    for (int e = gtid; e < MTOK * 2; e += gthreads) {
        const int row = e >> 1, axis = e & 1;
        int b, pos; bool lat; row_info(row, b, pos, lat);
        const u32x4 x1 = *(const u32x4*)(proj + (size_t)row * NPROJ + PO_KR + axis * 16), x2 = *(const u32x4*)(proj + (size_t)row * NPROJ + PO_KR + axis * 16 + 8);
        u32x4 o1 = x1, o2 = x2;
        if (lat) {
            const float* rp = rope + pos * 32 + axis * 8;
            float a[8], c[8], cs[8], sn[8];
            a[0] = bflo(x1.x); a[1] = bfhi(x1.x); a[2] = bflo(x1.y); a[3] = bfhi(x1.y); a[4] = bflo(x1.z); a[5] = bfhi(x1.z); a[6] = bflo(x1.w); a[7] = bfhi(x1.w);
            c[0] = bflo(x2.x); c[1] = bfhi(x2.x); c[2] = bflo(x2.y); c[3] = bfhi(x2.y); c[4] = bflo(x2.z); c[5] = bfhi(x2.z); c[6] = bflo(x2.w); c[7] = bfhi(x2.w);
#pragma unroll
            for (int j = 0; j < 8; ++j) { cs[j] = rp[j]; sn[j] = rp[16 + j]; }
            float y1[8], y2[8];
#pragma unroll
            for (int j = 0; j < 8; ++j) { y1[j] = a[j] * cs[j] - c[j] * sn[j]; y2[j] = a[j] * sn[j] + c[j] * cs[j]; }
            o1.x = pk2(y1[0], y1[1]); o1.y = pk2(y1[2], y1[3]); o1.z = pk2(y1[4], y1[5]); o1.w = pk2(y1[6], y1[7]);
            o2.x = pk2(y2[0], y2[1]); o2.y = pk2(y2[2], y2[3]); o2.z = pk2(y2[4], y2[5]); o2.w = pk2(y2[6], y2[7]);
        }
        const int key = lat ? CTXL + pos : pos;
#pragma unroll
        for (int h = 0; h < 8; ++h) { bf16* dst = Kb + ((size_t)(b * 8 + h) * NKEY + key) * 96 + 64 + axis * 16; *(u32x4*)dst = o1; *(u32x4*)(dst + 8) = o2; }
    }
}

DI int swap23(int r) { return (r & ~12) | ((r & 4) << 1) | ((r & 8) >> 1); }
DI void attn_item(const bf16* Qp, const bf16* Kp, const bf16* Vtp, int nkeys, bf16* outp  , LAS unsigned char* lds) {
    const int tid = otid(), lane = tid & 63, w = tid >> 6, r = lane & 31, hh = lane >> 5, gk = w >> 2, wq = w & 3;
    constexpr int KP = 208, VP = 144, KT = 64 * KP, VT = 64 * VP;
    LAS unsigned char* Kl = lds; LAS unsigned char* Vl = lds + 4 * KT;
    bf16x8 qf[6];
#pragma unroll
    for (int kk = 0; kk < 6; ++kk) qf[kk] = *(const bf16x8*)(Qp + (size_t)(32 * wq + r) * 96 + kk * 16 + hh * 8);
    const float zf = ozero();
    f32x16 o0, o1;
#pragma unroll
    for (int i = 0; i < 16; ++i) { o0[i] = zf; o1[i] = zf; }
    float mrun = -60.f, lrun = zf;
    unsigned kg[3], kl[3], vg[2], vl[2];
#pragma unroll
    for (int i = 0; i < 3; ++i) { const int c = tid + 512 * i, tile = c / 768, cc = c - tile * 768, row = cc / 12, col = cc - row * 12;
        kg[i] = (unsigned)((tile * 64 + row) * 96 + col * 8); kl[i] = (unsigned)(tile * KT + swap23(row) * KP + col * 16); }
#pragma unroll
    for (int i = 0; i < 2; ++i) { const int c = tid + 512 * i, tile = c >> 9, cc = c & 511, dv = cc >> 3, col = cc & 7;
        vg[i] = (unsigned)(dv * NKEY + tile * 64 + col * 8); vl[i] = (unsigned)(tile * VT + dv * VP + col * 16); }
    const int npairs = nkeys >> 7;
    u32x4 sk[3], sv[2];
#pragma unroll
    for (int i = 0; i < 3; ++i) sk[i] = *(const u32x4*)(Kp + kg[i]);
#pragma unroll
    for (int i = 0; i < 2; ++i) sv[i] = *(const u32x4*)(Vtp + vg[i]);
#pragma unroll
    for (int i = 0; i < 3; ++i) *(LAS u32x4*)(Kl + kl[i]) = sk[i];
#pragma unroll
    for (int i = 0; i < 2; ++i) *(LAS u32x4*)(Vl + vl[i]) = sv[i];
    __syncthreads();
    for (int kp = 0; kp < npairs; ++kp) {
        const int cur = kp & 1;
        if (kp + 1 < npairs) {
            const bf16* kgp = Kp + (size_t)(kp + 1) * 128 * 96; const bf16* vgp = Vtp + (kp + 1) * 128;
#pragma unroll
            for (int i = 0; i < 3; ++i) sk[i] = *(const u32x4*)(kgp + kg[i]);
#pragma unroll
            for (int i = 0; i < 2; ++i) sv[i] = *(const u32x4*)(vgp + vg[i]);
        }
        const LAS unsigned char* kb = Kl + (cur * 2 + gk) * KT; const LAS unsigned char* vb = Vl + (cur * 2 + gk) * VT;
        f32x16 s0, s1; const float negm = -mrun;
#pragma unroll
        for (int i = 0; i < 16; ++i) { s0[i] = negm; s1[i] = negm; }
#pragma unroll
        for (int kk = 0; kk < 6; ++kk) {
            const bf16x8 ka0 = *(const LAS bf16x8*)(kb + r * KP + kk * 32 + hh * 16);
            const bf16x8 ka1 = *(const LAS bf16x8*)(kb + (32 + r) * KP + kk * 32 + hh * 16);
            s0 = mfma32(ka0, qf[kk], s0); s1 = mfma32(ka1, qf[kk], s1);
        }
        float mx = s0[0];
#pragma unroll
        for (int i = 1; i < 16; ++i) mx = fmaxf(mx, s0[i]);
#pragma unroll
        for (int i = 0; i < 16; ++i) mx = fmaxf(mx, s1[i]);
        if (__builtin_amdgcn_ballot_w64(mx > 6.f) != 0ull) {
            mx = fmaxf(mx, shx(mx, 32));
            const float dm = fmaxf(mx, 0.f), alpha = fexp2(-dm);
            mrun += dm; lrun *= alpha;
#pragma unroll
            for (int i = 0; i < 16; ++i) { s0[i] -= dm; s1[i] -= dm; o0[i] *= alpha; o1[i] *= alpha; }
        }
        float ls = 0.f;
#pragma unroll
        for (int i = 0; i < 16; ++i) { s0[i] = fexp2(s0[i]); s1[i] = fexp2(s1[i]); ls += s0[i] + s1[i]; }
        lrun += ls;
        bf16x8 pf[2][2];
#pragma unroll
        for (int s2 = 0; s2 < 2; ++s2) {
            u32x4 a, b2;
            a.x = pk2(s0[8 * s2 + 0], s0[8 * s2 + 1]); a.y = pk2(s0[8 * s2 + 2], s0[8 * s2 + 3]); a.z = pk2(s0[8 * s2 + 4], s0[8 * s2 + 5]); a.w = pk2(s0[8 * s2 + 6], s0[8 * s2 + 7]);
            b2.x = pk2(s1[8 * s2 + 0], s1[8 * s2 + 1]); b2.y = pk2(s1[8 * s2 + 2], s1[8 * s2 + 3]); b2.z = pk2(s1[8 * s2 + 4], s1[8 * s2 + 5]); b2.w = pk2(s1[8 * s2 + 6], s1[8 * s2 + 7]);
            pf[0][s2] = __builtin_bit_cast(bf16x8, a); pf[1][s2] = __builtin_bit_cast(bf16x8, b2);
        }
#pragma unroll
        for (int d = 0; d < 2; ++d)
#pragma unroll
            for (int s2 = 0; s2 < 2; ++s2) {
                const bf16x8 v0 = *(const LAS bf16x8*)(vb + r * VP + (d * 32 + s2 * 16 + hh * 8) * 2);
                const bf16x8 v1 = *(const LAS bf16x8*)(vb + (32 + r) * VP + (d * 32 + s2 * 16 + hh * 8) * 2);
                o0 = mfma32(v0, pf[d][s2], o0); o1 = mfma32(v1, pf[d][s2], o1);
            }
        if (kp + 1 < npairs) {
            LAS unsigned char* kn = Kl + (cur ^ 1) * 2 * KT; LAS unsigned char* vn = Vl + (cur ^ 1) * 2 * VT;
#pragma unroll
            for (int i = 0; i < 3; ++i) *(LAS u32x4*)(kn + kl[i]) = sk[i];
#pragma unroll
            for (int i = 0; i < 2; ++i) *(LAS u32x4*)(vn + vl[i]) = sv[i];
        }
        __syncthreads();
    }
    lrun += shx(lrun, 32);
    LAS float* mg = (LAS float*)lds + wq * (34 * 64) + lane;
    if (gk == 1) {
#pragma unroll
        for (int i = 0; i < 16; ++i) { mg[i * 64] = o0[i]; mg[(16 + i) * 64] = o1[i]; }
        mg[32 * 64] = mrun; mg[33 * 64] = lrun;
    }
    __syncthreads();
    if (gk == 0) {
        const float m1 = mg[32 * 64], l1 = mg[33 * 64];
        const float m = fmaxf(mrun, m1), a0 = fexp2(mrun - m), a1 = fexp2(m1 - m);
        const float inv = frcp(lrun * a0 + l1 * a1), c0 = a0 * inv, c1 = a1 * inv;
        bf16* orow = outp + (size_t)(32 * wq + r) * MIXD;
#pragma unroll
        for (int i4 = 0; i4 < 4; ++i4) {
            u32x2 a, b2;
            a.x = pk2(o0[4 * i4] * c0 + mg[(4 * i4) * 64] * c1, o0[4 * i4 + 1] * c0 + mg[(4 * i4 + 1) * 64] * c1);
            a.y = pk2(o0[4 * i4 + 2] * c0 + mg[(4 * i4 + 2) * 64] * c1, o0[4 * i4 + 3] * c0 + mg[(4 * i4 + 3) * 64] * c1);
            b2.x = pk2(o1[4 * i4] * c0 + mg[(16 + 4 * i4) * 64] * c1, o1[4 * i4 + 1] * c0 + mg[(16 + 4 * i4 + 1) * 64] * c1);
            b2.y = pk2(o1[4 * i4 + 2] * c0 + mg[(16 + 4 * i4 + 2) * 64] * c1, o1[4 * i4 + 3] * c0 + mg[(16 + 4 * i4 + 3) * 64] * c1);
            *(u32x2*)(orow + 8 * i4 + 4 * hh) = a; *(u32x2*)(orow + 32 + 8 * i4 + 4 * hh) = b2;
        }
    }
    __syncthreads();
}

DI void attn_any(const Params& p, int item, LAS unsigned char* lds) {
    unsigned char* ws = wsp(p);
    const bool isl = item < 1024;
    const int bh = isl ? (item >> 4) : ((item - 1024) >> 1), qb = isl ? (item & 15) : ((item - 1024) & 1), b = bh >> 3, h = bh & 7;
    const bf16* Qp = isl ? (const bf16*)(ws + WS_QLAT) + ((size_t)bh * SEQ + qb * 128) * 96 : (const bf16*)(ws + WS_QCTX) + ((size_t)bh * CTXL + qb * 128) * 96;
    const bf16* Kp = (const bf16*)(ws + WS_K) + (size_t)bh * NKEY * 96;
    const bf16* Vtp = (const bf16*)(ws + WS_VT) + (size_t)bh * 64 * NKEY;
    bf16* outp = (bf16*)(ws + WS_MIX) + (size_t)(isl ? (b * SEQ + qb * 128) : (NLAT + b * CTXL + qb * 128)) * MIXD + h * 64;
    attn_item(Qp, Kp, Vtp, isl ? NKEY : CTXL, outp, lds);
    if (!isl) publish_block((unsigned*)(ws + WS_CTL) + CW_ECTX);
}

#ifndef PROBE_REP_SUB
#define PROBE_REP_SUB -1
#endif
#ifndef PROBE_SYNCS
#define PROBE_SYNCS 0
#endif
constexpr int NSUB = 13 + (PROBE_REP_SUB >= 0 ? 1 : 0), NSTEP = 2 + NSUB * DEPTH;
__global__ void __launch_bounds__(512, 2) mk_fwd(Params p) {
    extern __shared__ __attribute__((aligned(16))) unsigned char lds_raw[];
    LAS unsigned char* lds = (LAS unsigned char*)lds_raw;
    cg::grid_group grid = cg::this_grid();
    volatile LAS unsigned* MISC = (volatile LAS unsigned*)(lds + MISC_OFF);
    if (threadIdx.x < 4) MISC[threadIdx.x] = 0u;
    __syncthreads();
    const XcdBarrier xbar = xcd_barrier_post((unsigned*)(p.ws + WS_CTL), MISC);
    if (p.ph_lo < 0) grid.sync();
    for (int st = p.ph_lo; st < p.ph_hi; ++st) {
        int G = gridDim.x, bid = blockIdx.x; asm volatile("" : "+s"(G), "+s"(bid));
        const int vcu = (G % 8 == 0) ? (bid % 8) * (G / 8) + bid / 8 : bid;
        const int ngw = G * 8, gthreads = G * 512;
        const int tid = otid(), lane = tid & 63, wave = tid >> 6, gw = bid * 8 + wave, gtid = bid * 512 + tid;
        const int l = (st - 1) / NSUB, subx = (st - 1) - l * NSUB, sub = (st == 0) ? 100 : (st == NSTEP - 1) ? 101 : ((PROBE_REP_SUB >= 0 && subx > PROBE_REP_SUB) ? subx - 1 : subx);
        const bool need_sync = !(sub == 3 || sub == 4 || sub == 5 || sub == 7 || sub == 8 || sub == 100);
        if (st > p.ph_lo && need_sync) xcd_barrier(xbar);
        unsigned char* ws = wsp(p);
        float* XRES = (float*)(ws + WS_XRES); bf16* HA = (bf16*)(ws + WS_HA); bf16* PROJ = (bf16*)(ws + WS_PROJ);
        bf16* MIX = (bf16*)(ws + WS_MIX); bf16* U = (bf16*)(ws + WS_U);
        const float* MOD = (const float*)(ws + WS_MOD);
        float* STQ = (float*)(ws + WS_STQ); float* STKV = (float*)(ws + WS_STKV);
        const bool last = (l == DEPTH - 1);
        const int Mtail = last ? NLAT : MTOK;
        const float* modl = MOD + (size_t)l * 9 * 6144;
        if (PROBE_SYNCS > 0 && sub == 101) { for (int i = 0; i < PROBE_SYNCS; ++i) xcd_barrier(xbar); }
        switch (sub) {
        case 100: phase_prologue(p, lds, G, bid); break;
        case 101: {
            rows_phase(p, 2, NLAT, inp(p, 25) + (DEPTH - 1) * DM, inp(p, 26) + (DEPTH - 1) * DM, modl, 0, 0, gw, ngw, lane);
        } break;
        case 0: {
            const float* lg = (l == 0) ? nullptr : inp(p, 25) + (l - 1) * DM; const float* lb = (l == 0) ? nullptr : inp(p, 26) + (l - 1) * DM;
            rows_phase(p, l == 0 ? 0 : 1, MTOK, lg, lb, modl, 1024, 0, gw, ngw, lane);
            phase_convert(p, l, lds, gw, ngw, lane, gtid, gthreads);
        } break;
        case 1: {
            EpiProj E{PROJ, STQ, STKV};
            run_gemm<DM, DM, DM, MTOK, NPROJ>(lds, HA, (const bf16*)(ws + WS_WIN), G, bid, E);
        } break;
        case 2: {
            EpiQK E{(bf16*)(ws + WS_QLAT), (bf16*)(ws + WS_QCTX), (bf16*)(ws + WS_K), STQ, STKV, (const float*)(ws + WS_ROPE)};
            run_gemm<NPROJ, 384, 384, MTOK, 1280>(lds, PROJ, (const bf16*)(ws + WS_WQK), G, bid, E);
        } break;
        case 3: {
            EpiVt E{(bf16*)(ws + WS_VT), STKV};
            run_gemm<384, NPROJ, 384, 512, MTOK>(lds, (const bf16*)(ws + WS_WV), PROJ, G, (bid + G - 104) % G, E);
        } break;
        case 4: {
            EpiGt E{(bf16*)(ws + WS_GTL), (bf16*)(ws + WS_GTC)};
            run_gemm<256, NPROJ, 256, 512, MTOK>(lds, (const bf16*)(ws + WS_WF), PROJ + PO_F, G, (bid + G - 104) % G, E);
        } break;
        case 5: {
            int first, cnt;
            if (G == 256) { if (bid < 104) { first = bid * 5; cnt = 5; } else if (bid < 248) { first = 520 + (bid - 104) * 4; cnt = 4; } else { first = 1096 + (bid - 248) * 7; cnt = 7; } }
            else { first = bid; cnt = (1152 - bid + G - 1) / G; }
            for (int k = 0; k < cnt; ++k) { const int it = (G == 256) ? first + k : first + k * G;
                if (it < 576) sgu_item(p, l, it >> 2, it & 3, lds); else pool_item(p, l, (it - 576) >> 2, (it - 576) & 3, lds); }
            krope_items(p, gtid, gthreads);
        } break;
        case 6: {
            EpiDft E{MIX, 0, SEQ};
            run_gemm<4096, 4096, 4096, 2048, 2048>(lds, (const bf16*)(ws + WS_CSL), (const bf16*)(ws + WS_GTL), G, vcu, E);
        } break;
        case 7: {
            if (!last) { EpiDft E{MIX, NLAT, CTXL};
              StaticOrderSig<256, 2048> S{G, (vcu + G - 64) % G, (unsigned*)(ws + WS_CTL) + CW_ECTX};
              run_gemm_s<512, 512, 512>(lds, (const bf16*)(ws + WS_CSC), (const bf16*)(ws + WS_GTC), 256, 2048, S, E); }
        } break;
        case 8: {
            if (G == 256) {
                int first, cnt, citem = -1;
                if (vcu < 64) { first = 2 * vcu; cnt = 2; } else if (vcu < 72) { first = 128 + 5 * (vcu - 64); cnt = 5; }
                else if (vcu < 104) { first = 168 + 3 * (vcu - 72); cnt = 3; } else { first = 264 + 5 * (vcu - 104); cnt = 5; if (!last && vcu < 232) citem = 1024 + (vcu - 104); }
                if (citem >= 0) attn_any(p, citem, lds);
                for (int k = 0; k < cnt; ++k) attn_any(p, first + k, lds);
                if (!last) {
                    SchedHC S{vcu + 152, (unsigned*)(ws + WS_CTL) + CW_ECTX, 136u * (unsigned)(l + 1)};
                    EpiRes E2{(l == 0) ? inp(p, 2) : XRES + (size_t)NLAT * DM, XRES + (size_t)NLAT * DM, (const float*)(ws + WS_ST) + 2 * NLAT, (l == 0) ? nullptr : inp(p, 25) + (l - 1) * DM, (l == 0) ? nullptr : inp(p, 26) + (l - 1) * DM, modl, 2048, 64};
                    run_gemm_s<MIXD, MIXD, MIXD>(lds, MIX + (size_t)NLAT * MIXD, (const bf16*)(ws + WS_WOUT), NCTX, DM, S, E2);
                }
            } else {
                for (int it = vcu; it < (last ? 1024 : 1152); it += G) attn_any(p, it, lds);
            }
        } break;
        case 9: {
            EpiRes E{(l == 0) ? inp(p, 0) : XRES, XRES, (const float*)(ws + WS_ST), (l == 0) ? nullptr : inp(p, 25) + (l - 1) * DM, (l == 0) ? nullptr : inp(p, 26) + (l - 1) * DM, modl, 2048, 0};
            if (last || G == 256) run_gemm<MIXD, MIXD, MIXD, NLAT, DM>(lds, MIX, (const bf16*)(ws + WS_WOUT), G, bid, E);
            else run_gemm<MIXD, MIXD, MIXD, MTOK, DM>(lds, MIX, (const bf16*)(ws + WS_WOUT), G, bid, E);
        } break;
        case 10: {
            rows_phase(p, 1, Mtail, inp(p, 20) + l * DM, inp(p, 21) + l * DM, modl, 4096, 3072, gw, ngw, lane);
        } break;
        case 11: {
            EpiSwiglu E{U};
            if (last || G != 256) {
                if (last) run_gemm<DM, DM, DM, NLAT, 2 * DFF>(lds, HA, (const bf16*)(ws + WS_W13), G, bid, E);
                else run_gemm<DM, DM, DM, MTOK, 2 * DFF>(lds, HA, (const bf16*)(ws + WS_W13), G, bid, E);
            } else {
                unsigned* cnt = (unsigned*)(ws + WS_CTL) + CW_GCTX;
                { SchedG S{bid, cnt}; run_gemm_s<DM, DM, DM>(lds, HA, (const bf16*)(ws + WS_W13), MTOK, 2 * DFF, S, E); }
                { SchedHC S{bid, cnt, 176u * (unsigned)(l + 1)}; EpiRes E2{XRES + (size_t)NLAT * DM, XRES + (size_t)NLAT * DM, (const float*)(ws + WS_ST) + 2 * NLAT, inp(p, 20) + l * DM, inp(p, 21) + l * DM, modl, 5120, 64};
                  run_gemm_s<DFF, DFF, DFF>(lds, U + (size_t)NLAT * DFF, (const bf16*)(ws + WS_W2), NCTX, DM, S, E2); }
            }
        } break;
        case 12: {
            EpiRes E{XRES, XRES, (const float*)(ws + WS_ST), inp(p, 20) + l * DM, inp(p, 21) + l * DM, modl, 5120, 0};
            if (last || G == 256) run_gemm<DFF, DFF, DFF, NLAT, DM>(lds, U, (const bf16*)(ws + WS_W2), G, bid, E);
            else run_gemm<DFF, DFF, DFF, MTOK, DM>(lds, U, (const bf16*)(ws + WS_W2), G, bid, E);
        } break;
        }
        __syncthreads();
    }
}

#ifndef MK_SPLIT
#define MK_SPLIT 0
#endif
extern "C" void kernel_launch(void* const* d_in, const int* in_sizes, int n_in, void* d_out, int out_size, void* d_ws, size_t ws_size, hipStream_t stream) {
    static int grid = 0;
    if (grid == 0) {
        if (n_in != 27 || out_size != NLAT * DM || ws_size < WS_END) { fprintf(stderr, "kernel_launch: unexpected shapes / workspace (%d inputs, out %d, ws %zu < %zu)\n", n_in, out_size, ws_size, (size_t)WS_END); grid = -1; return; }
        int dev = 0, cus = 0, per_cu = 0;
        hipGetDevice(&dev);
        hipDeviceGetAttribute(&cus, hipDeviceAttributeMultiprocessorCount, dev);
        hipFuncSetAttribute((const void*)mk_fwd, hipFuncAttributeMaxDynamicSharedMemorySize, LDS_BYTES);
        hipOccupancyMaxActiveBlocksPerMultiprocessor(&per_cu, (const void*)mk_fwd, 512, LDS_BYTES);
        if (per_cu < 1) { fprintf(stderr, "kernel_launch: occupancy query reports %d blocks per CU\n", per_cu); per_cu = 1; }
        grid = cus >= 256 ? 256 : cus;
        (void)hipGetLastError();
    }
    if (grid < 0) return;
    if (hipMemsetAsync((char*)d_ws + WS_CTL, 0, CTL_BYTES, stream) != hipSuccess) { fprintf(stderr, "kernel_launch: memset failed\n"); return; }
    Params p{};
    for (int i = 0; i < 27; ++i) p.in[i] = (const float*)d_in[i];
    p.out = (float*)d_out; p.ws = (unsigned char*)d_ws;
#if MK_SPLIT
    for (int ph = 0; ph < NSTEP; ++ph) {
        p.ph_lo = ph; p.ph_hi = ph + 1;
        void* args[] = {&p};
        hipError_t e = hipLaunchCooperativeKernel((const void*)mk_fwd, dim3(grid), dim3(512), args, LDS_BYTES, stream);
        if (e != hipSuccess) { fprintf(stderr, "cooperative launch failed: %s\n", hipGetErrorString(e)); return; }
    }
#else
    p.ph_lo = 0; p.ph_hi = NSTEP;
    void* args[] = {&p};
    hipError_t e = hipLaunchCooperativeKernel((const void*)mk_fwd, dim3(grid), dim3(512), args, LDS_BYTES, stream);
    if (e != hipSuccess) fprintf(stderr, "cooperative launch failed: %s (grid %d)\n", hipGetErrorString(e), grid);
#endif
}
```

```cpp
#include <hip/hip_runtime.h>
#include <hip/hip_cooperative_groups.h>
#include <cstdio>
#include <cstdint>
namespace cg = cooperative_groups;
__device__ __forceinline__ int otid() { int t = threadIdx.x; asm volatile("" : "+v"(t)); return t; }
namespace pg8 {
#define PG8_LAS __attribute__((address_space(3)))
typedef unsigned short bf16_t;
typedef short bf16x8 __attribute__((ext_vector_type(8)));
typedef float f32x4 __attribute__((ext_vector_type(4)));
typedef unsigned u32x4 __attribute__((ext_vector_type(4)));
constexpr int BM = 256, BK = 64, HALF = 128, HTB = HALF * BK * 2  , STAGE_BYTES = 8 * HTB, NXCD = 8, WGM = 8;

__host__ __device__ __forceinline__ int lds_byte(int r, int c) { const int st = (r >> 4) * 2 + (c >> 5), rr = r & 15, cc = c & 31, ob = rr * 64 + cc * 2; return st * 1024 + (ob ^ (((ob >> 9) & 1) << 5)); }
__host__ __device__ __forceinline__ void stage_rc(int b, int& R, int& C) { const int st = b / 1024, sb = b % 1024, swz = sb ^ (((sb >> 9) & 1) << 5); R = (st >> 1) * 16 + swz / 64; C = (st & 1) * 32 + (swz % 64) / 2; }
__host__ __device__ __forceinline__ int perm32(int rho) { const int n = rho >> 4, i = rho & 15; return 8 * (i >> 2) + 4 * n + (i & 3); }

struct Unit { int pm, pn; };
struct Gemm { const bf16_t* A; const bf16_t* Bt; int M, N; };

struct StaticOrder {
    int nM, nN, nwg, G, c;
    __host__ __device__ void init(int M, int N, int G_, int c_) { nM = M / BM; nN = N / BM; nwg = nM * nN; G = G_; c = c_; }
    __host__ __device__ bool next(int i, Unit& u) const {
        const long L = (long)i * G + c; if (L >= nwg) return false;
        int wgid = (int)L; { const int q = nwg / NXCD, r = nwg % NXCD, xcd = wgid % NXCD, off = wgid / NXCD; wgid = (xcd < r ? xcd * (q + 1) : r * (q + 1) + (xcd - r) * q) + off; }
        const int nig = WGM * nN, gid = wgid / nig, fm = gid * WGM, gsz = (nM - fm) < WGM ? (nM - fm) : WGM;
        u.pm = fm + ((wgid % nig) % gsz); u.pn = (wgid % nig) / gsz; return true;
    }
    __device__ __forceinline__ void a_ready(const Unit&) const {}
    __device__ __forceinline__ void done(const Unit&) const {}
};


template <class Epi, class Sched, bool ALIGN_EPI, bool SP2, int LDA, int LDB, int KDIM>
__device__ __forceinline__ void gemm_phase(PG8_LAS unsigned char* lds, const Gemm g, const Sched& S, const Epi& E) {
    const int tid = otid(), wid = __builtin_amdgcn_readfirstlane(tid >> 6), lane = tid & 63, wr = wid >> 2, wc = wid & 3, fr = lane & 15, fq = lane >> 4;
    constexpr int K = KDIM, nt = K / BK;
    unsigned voffA[2], voffB[2];
#pragma unroll
    for (int i = 0; i < 2; ++i) { int R, C; stage_rc(tid * 16 + i * 8192, R, C); const int Rb = Epi::PERM ? ((R & ~31) + perm32(R & 31)) : R;
        voffA[i] = (unsigned)(R * LDA + C) * 2u; voffB[i] = (unsigned)(Rb * LDB + C) * 2u; }
    constexpr size_t kstep = (size_t)(BK * 2);
    constexpr size_t hstepA = (size_t)HALF * LDA * 2, hstepB = (size_t)HALF * LDB * 2;
    constexpr size_t tstepA = 2 * hstepA, tstepB = 2 * hstepB;
    const unsigned ldsw = (unsigned)wid * 1024u;
    const int aoff = lds_byte(wr * 64 + fr, fq * 8), boff = lds_byte(wc * 32 + fr, fq * 8);
#define PG8_SA(b, h) (((b) * 2 + (h)) * HTB)
#define PG8_SB(b, h) ((4 + (b) * 2 + (h)) * HTB)
#define PG8_STAGE(bufoff, gbase, voff) do { _Pragma("unroll") for (int _i = 0; _i < 2; ++_i) \
        __builtin_amdgcn_global_load_lds((const unsigned*)((const char*)(gbase) + (voff)[_i]), (PG8_LAS unsigned*)(lds + (bufoff) + ldsw + _i * 8192), 16, 0, 0); } while (0)
#define PG8_LDA(dst, b, h) do { _Pragma("unroll") for (int m = 0; m < 4; ++m) _Pragma("unroll") for (int k = 0; k < 2; ++k) dst[m][k] = *(const PG8_LAS bf16x8*)(lds + PG8_SA(b, h) + aoff + m * 2048 + k * 1024); } while (0)
#define PG8_LDB(dst, b, h) do { _Pragma("unroll") for (int n = 0; n < 2; ++n) _Pragma("unroll") for (int k = 0; k < 2; ++k) dst[n][k] = *(const PG8_LAS bf16x8*)(lds + PG8_SB(b, h) + boff + n * 2048 + k * 1024); } while (0)
#define PG8_MMA(ai, bj, At, Bt) do { __builtin_amdgcn_s_setprio(1); _Pragma("unroll") for (int m = 0; m < 4; ++m) _Pragma("unroll") for (int n = 0; n < 2; ++n) _Pragma("unroll") for (int k = 0; k < 2; ++k) \
        acc[ai][bj][m][n] = __builtin_amdgcn_mfma_f32_16x16x32_bf16(Bt[n][k], At[m][k], acc[ai][bj][m][n], 0, 0, 0); __builtin_amdgcn_s_setprio(0); } while (0)
#define PG8_WAIT_V(n) asm volatile("s_waitcnt vmcnt(" #n ")" ::: "memory")
#define PG8_WAIT_L(n) asm volatile("s_waitcnt lgkmcnt(" #n ")" ::: "memory")
#define PG8_BAR __builtin_amdgcn_s_barrier()
#define PG8_SCHED __builtin_amdgcn_sched_barrier(0)
    Unit cur, nxt; int ui = 0;
    if (!S.next(0, cur)) return;
    float zf = 0.f; asm volatile("" : "+v"(zf));
    f32x4 acc[2][2][4][2];
#pragma unroll
    for (int a = 0; a < 2; ++a)
#pragma unroll
        for (int b = 0; b < 2; ++b)
#pragma unroll
            for (int m = 0; m < 4; ++m)
#pragma unroll
                for (int n = 0; n < 2; ++n) acc[a][b][m][n] = (f32x4){zf, zf, zf, zf};
    bf16x8 At[4][2], B0[2][2], B1[2][2];
    const char* cA = (const char*)g.A + (size_t)cur.pm * tstepA; const char* cB = (const char*)g.Bt + (size_t)cur.pn * tstepB;
    S.a_ready(cur);
    if constexpr (SP2) {
        PG8_STAGE(PG8_SB(0, 0), cB, voffB); PG8_STAGE(PG8_SB(0, 1), cB + hstepB, voffB); PG8_STAGE(PG8_SA(0, 0), cA, voffA); PG8_STAGE(PG8_SA(0, 1), cA + hstepA, voffA);
        if (wr == 1) PG8_BAR;
        PG8_WAIT_V(2); PG8_BAR;
        PG8_STAGE(PG8_SB(1, 0), cB + kstep, voffB); PG8_STAGE(PG8_SA(1, 0), cA + kstep, voffA); PG8_STAGE(PG8_SB(1, 1), cB + hstepB + kstep, voffB);
        PG8_WAIT_V(6); PG8_BAR;
    } else {
        PG8_STAGE(PG8_SB(0, 0), cB, voffB); PG8_STAGE(PG8_SA(0, 0), cA, voffA); PG8_STAGE(PG8_SB(0, 1), cB + hstepB, voffB); PG8_STAGE(PG8_SA(0, 1), cA + hstepA, voffA);
        if (wr == 1) PG8_BAR;
        PG8_WAIT_V(4); PG8_BAR;
        PG8_STAGE(PG8_SB(1, 0), cB + kstep, voffB); PG8_STAGE(PG8_SA(1, 0), cA + kstep, voffA); PG8_STAGE(PG8_SB(1, 1), cB + hstepB + kstep, voffB);
        PG8_WAIT_V(6); PG8_BAR;
    }
    for (;;) {
        const bool has_next = S.next(ui + 1, nxt);
        const char* nA = has_next ? (const char*)g.A + (size_t)nxt.pm * tstepA : cA; const char* nB = has_next ? (const char*)g.Bt + (size_t)nxt.pn * tstepB : cB;
#pragma nounroll
        for (int t = 0; t < nt; t += 2) {
            const bool last = (t == nt - 2);
            const char* a1 = cA + (size_t)(t + 1) * kstep;
            const char* a2 = last ? nA : cA + (size_t)(t + 2) * kstep; const char* b2 = last ? nB : cB + (size_t)(t + 2) * kstep;
            const char* a3 = a2 + kstep; const char* b3 = b2 + kstep;
            if (last && has_next) S.a_ready(nxt);
            if constexpr (SP2) {
            PG8_LDB(B0, 0, 0); PG8_LDB(B1, 0, 1); PG8_SCHED; PG8_LDA(At, 0, 0); PG8_STAGE(PG8_SA(1, 1), a1 + hstepA, voffA);
            PG8_WAIT_V(8); PG8_WAIT_L(0); PG8_BAR; PG8_MMA(0, 0, At, B0); PG8_MMA(0, 1, At, B1); PG8_BAR; PG8_SCHED;
            PG8_LDA(At, 0, 1); PG8_STAGE(PG8_SB(0, 0), b2, voffB); PG8_STAGE(PG8_SB(0, 1), b2 + hstepB, voffB); PG8_STAGE(PG8_SA(0, 0), a2, voffA);
            PG8_WAIT_V(8); PG8_WAIT_L(0); PG8_BAR; PG8_MMA(1, 0, At, B0); PG8_MMA(1, 1, At, B1); PG8_BAR; PG8_SCHED;
            PG8_LDB(B0, 1, 0); PG8_LDB(B1, 1, 1); PG8_SCHED; PG8_LDA(At, 1, 0); PG8_STAGE(PG8_SA(0, 1), a2 + hstepA, voffA);
            PG8_WAIT_V(8); PG8_WAIT_L(0); PG8_BAR; PG8_MMA(0, 0, At, B0); PG8_MMA(0, 1, At, B1); PG8_BAR; PG8_SCHED;
            PG8_LDA(At, 1, 1); PG8_STAGE(PG8_SB(1, 0), b3, voffB); PG8_STAGE(PG8_SB(1, 1), b3 + hstepB, voffB); PG8_STAGE(PG8_SA(1, 0), a3, voffA);
            PG8_WAIT_V(8); PG8_WAIT_L(0); PG8_BAR; PG8_MMA(1, 0, At, B0); PG8_MMA(1, 1, At, B1); PG8_BAR; PG8_SCHED;
            } else {
            PG8_LDB(B0, 0, 0); PG8_SCHED; PG8_LDA(At, 0, 0); PG8_STAGE(PG8_SA(1, 1), a1 + hstepA, voffA);
            PG8_WAIT_L(8); PG8_BAR; PG8_WAIT_L(0); PG8_MMA(0, 0, At, B0); PG8_BAR; PG8_SCHED;
            PG8_LDB(B1, 0, 1); PG8_STAGE(PG8_SB(0, 0), b2, voffB);
            PG8_BAR; PG8_WAIT_L(0); PG8_MMA(0, 1, At, B1); PG8_BAR;
            PG8_LDA(At, 0, 1); PG8_STAGE(PG8_SA(0, 0), a2, voffA);
            PG8_BAR; PG8_WAIT_L(0); PG8_MMA(1, 0, At, B0); PG8_BAR; PG8_SCHED;
            PG8_STAGE(PG8_SB(0, 1), b2 + hstepB, voffB);
            PG8_WAIT_V(6); PG8_BAR; PG8_MMA(1, 1, At, B1); PG8_BAR;
            PG8_LDB(B0, 1, 0); PG8_SCHED; PG8_LDA(At, 1, 0); PG8_STAGE(PG8_SA(0, 1), a2 + hstepA, voffA);
            PG8_WAIT_L(8); PG8_BAR; PG8_WAIT_L(0); PG8_MMA(0, 0, At, B0); PG8_BAR; PG8_SCHED;
            PG8_LDB(B1, 1, 1); PG8_STAGE(PG8_SB(1, 0), b3, voffB);
            PG8_BAR; PG8_WAIT_L(0); PG8_MMA(0, 1, At, B1); PG8_BAR;
            PG8_LDA(At, 1, 1); PG8_STAGE(PG8_SA(1, 0), a3, voffA);
            PG8_BAR; PG8_WAIT_L(0); PG8_MMA(1, 0, At, B0); PG8_BAR; PG8_SCHED;
            PG8_STAGE(PG8_SB(1, 1), b3 + hstepB, voffB);
            PG8_WAIT_V(6); PG8_BAR; PG8_MMA(1, 1, At, B1); PG8_BAR;
            }
        }
        if constexpr (ALIGN_EPI) { if (wr == 0) PG8_BAR; }
        if constexpr (!Epi::AFTER_DRAIN) { int fr2 = fr, fq2 = fq; asm volatile("" : "+v"(fr2), "+v"(fq2));
            E(acc, cur, wr, wc, fr2, fq2); S.done(cur); }
        if (!has_next) break;
#pragma unroll
        for (int a = 0; a < 2; ++a)
#pragma unroll
            for (int b = 0; b < 2; ++b)
#pragma unroll
                for (int m = 0; m < 4; ++m)
#pragma unroll
                    for (int n = 0; n < 2; ++n) acc[a][b][m][n] = (f32x4){zf, zf, zf, zf};
        cur = nxt; cA = nA; cB = nB; ++ui;
        if constexpr (ALIGN_EPI) { if (wr == 1) PG8_BAR; }
    }
    PG8_WAIT_V(0);
    if constexpr (!ALIGN_EPI) { if (wr == 0) PG8_BAR; }
    PG8_BAR;
    if constexpr (Epi::AFTER_DRAIN) { E.fused(acc, cur, wr, wc, fr, fq, lds, wid, lane); S.done(cur); }
#undef PG8_SA
#undef PG8_SB
#undef PG8_STAGE
#undef PG8_LDA
#undef PG8_LDB
#undef PG8_MMA
#undef PG8_WAIT_V
#undef PG8_WAIT_L
#undef PG8_BAR
#undef PG8_SCHED
}
}

#define LAS __attribute__((address_space(3)))
typedef unsigned short bf16;
typedef float f32x2 __attribute__((ext_vector_type(2)));
typedef float f32x4 __attribute__((ext_vector_type(4)));
typedef float f32x16 __attribute__((ext_vector_type(16)));
typedef short bf16x8 __attribute__((ext_vector_type(8)));
typedef unsigned u32x4 __attribute__((ext_vector_type(4)));
typedef unsigned u32x2 __attribute__((ext_vector_type(2)));
typedef __bf16 bf16x2_t __attribute__((ext_vector_type(2)));
#define DI __device__ __forceinline__

DI unsigned pk2(float lo, float hi) { f32x2 v = {lo, hi}; bf16x2_t b = __builtin_convertvector(v, bf16x2_t); return __builtin_bit_cast(unsigned, b); }
DI float bflo(unsigned u) { return __uint_as_float(u << 16); }
DI float bfhi(unsigned u) { return __uint_as_float(u & 0xffff0000u); }
DI u32x4 pack8(f32x4 a, f32x4 b) { u32x4 w; w.x = pk2(a[0], a[1]); w.y = pk2(a[2], a[3]); w.z = pk2(b[0], b[1]); w.w = pk2(b[2], b[3]); return w; }
DI float shx(float v, int m) { const int l = (otid() & 63) ^ m; return __builtin_bit_cast(float, __builtin_amdgcn_ds_bpermute(l << 2, __builtin_bit_cast(int, v))); }
DI float wave_sum(float v) {
#pragma unroll
    for (int o = 1; o < 64; o <<= 1) v += shx(v, o);
    return v;
}
DI float ozero() { float z = 0.f; asm volatile("" : "+v"(z)); return z; }
DI float cos_turn(float t) { return __builtin_amdgcn_cosf(t); }
DI float sin_turn(float t) { return __builtin_amdgcn_sinf(t); }
DI float fexp2(float x) { return __builtin_amdgcn_exp2f(x); }
DI float frcp(float x) { return __builtin_amdgcn_rcpf(x); }
#define LDS_WAIT() asm volatile("s_waitcnt lgkmcnt(0)" ::: "memory")

constexpr int DM = 1024, NB = 8, SEQ = 2048, DEPTH = 4, CTXL = 256;
constexpr int NLAT = NB * SEQ, NCTX = NB * CTXL, MTOK = NLAT + NCTX;
constexpr int NPROJ = 1536, DFF = 2816, MIXD = 1280, NKEY = SEQ + CTXL;
constexpr int PO_KR = 384, PO_SU = 416, PO_SV = 672, PO_POOL = 928, PO_F = 1184, IN_DIM = 1440;
constexpr float LN_EPS = 1e-6f;
constexpr float ALPHA = 1.6817928305074290f;
constexpr float QSCALE = 0.10206207261596575f * 1.4426950408889634f;

constexpr size_t WS_XRES = 0;
constexpr size_t WS_HA   = WS_XRES + (size_t)MTOK * DM * 4;
constexpr size_t WS_PROJ = WS_HA + (size_t)MTOK * DM * 2;
constexpr size_t WS_QLAT = WS_PROJ + (size_t)MTOK * NPROJ * 2;
constexpr size_t WS_QCTX = WS_QLAT + (size_t)64 * SEQ * 96 * 2;
constexpr size_t WS_K    = WS_QCTX + (size_t)64 * CTXL * 96 * 2;
constexpr size_t WS_VT   = WS_K + (size_t)64 * NKEY * 96 * 2;
constexpr size_t WS_U    = WS_PROJ;
static_assert((size_t)MTOK * DFF * 2 <= WS_VT - WS_PROJ, "U overlay");
constexpr size_t WS_GTL  = WS_VT + (size_t)64 * 64 * NKEY * 2;
constexpr size_t WS_GTC  = WS_GTL + (size_t)2048 * 4096 * 2;
constexpr size_t WS_MIX  = WS_GTC + (size_t)2048 * 512 * 2;
constexpr size_t WS_WIN  = WS_MIX + (size_t)MTOK * MIXD * 2;
constexpr size_t WS_WQK  = WS_WIN + (size_t)1536 * 1024 * 2;
constexpr size_t WS_WV   = WS_WQK + (size_t)1280 * 384 * 2;
constexpr size_t WS_WF   = WS_WV + (size_t)512 * 384 * 2;
constexpr size_t WS_WOUT = WS_WF + (size_t)512 * 256 * 2;
constexpr size_t WS_W13  = WS_WOUT + (size_t)1024 * 1280 * 2;
constexpr size_t WS_W2   = WS_W13 + (size_t)5632 * 1024 * 2;
constexpr size_t WS_WPOOL= WS_W2 + (size_t)1024 * 2816 * 2;
constexpr size_t WS_WS   = WS_WPOOL + (size_t)4 * 64 * 64 * 2;
constexpr size_t WS_CSL  = WS_WS + (size_t)4 * 128 * 128 * 2;
constexpr size_t WS_CSC  = WS_CSL + (size_t)2048 * 4096 * 2;
constexpr size_t WS_MOD  = WS_CSC + (size_t)256 * 512 * 2;
constexpr size_t WS_ROPE = WS_MOD + (size_t)4 * 9 * 6144 * 4;
constexpr size_t WS_STQ  = WS_ROPE + (size_t)2048 * 32 * 4;
constexpr size_t WS_STKV = WS_STQ + (size_t)MTOK * 4 * 4;
constexpr size_t WS_ST   = WS_STKV + (size_t)MTOK * 4 * 4;
constexpr size_t WS_CTL  = WS_ST + (size_t)MTOK * 2 * 4;
constexpr size_t CTL_BYTES = 16384;
constexpr size_t WS_END  = WS_CTL + CTL_BYTES;
constexpr int MISC_OFF = 139264;

constexpr int LDS_BYTES = 147456;

struct Params { const float* in[27]; float* out; unsigned char* ws; int ph_lo, ph_hi; };
DI const float* inp(const Params& p, int i) { asm volatile("" : "+s"(i)); return p.in[i]; }
DI unsigned char* wsp(const Params& p) { unsigned char* w = p.ws; asm volatile("" : "+s"(w)); return w; }

#define XB_TMO      128
#define XB_XCNT(j)  (256  + 64 * (j))
#define XB_XSUB(j)  (1280 + 64 * (j))
#define XB_XGEN(j)  (2304 + 64 * (j))
#define XB_TOP      3328
#define XB_TOPGEN   3392
#define XCD_BAR_WORDS 3456
#define XB_SPIN_CAP (1u << 18)

__device__ __forceinline__ unsigned xb_ld(unsigned* p)              { return __hip_atomic_load(p, __ATOMIC_RELAXED, __HIP_MEMORY_SCOPE_AGENT); }
__device__ __forceinline__ unsigned xb_add(unsigned* p, unsigned v) { return __hip_atomic_fetch_add(p, v, __ATOMIC_RELAXED, __HIP_MEMORY_SCOPE_AGENT); }
__device__ __forceinline__ unsigned xb_xcc_id() { return (unsigned)__builtin_amdgcn_s_getreg((3 << 11) | 20) & 0xFu; }
#define XB_SPIN(cond, bar) do { unsigned _sp = 0; while (cond) { __builtin_amdgcn_s_sleep(1); \
    if ((++_sp & 255u) == 0u) { if (xb_ld(&(bar)[XB_TMO])) break; if (_sp > XB_SPIN_CAP) { atomicAdd(&(bar)[XB_TMO], 1u); break; } } } } while (0)

struct XcdBarrier {
    unsigned* bar; unsigned x;
    volatile LAS unsigned* st;
};

__device__ __forceinline__ XcdBarrier xcd_barrier_post(unsigned* bar, volatile LAS unsigned* st) {
    XcdBarrier b; b.bar = bar; b.x = xb_xcc_id(); b.st = st;
    if (threadIdx.x == 0) (void)xb_add(&bar[XB_XCNT(b.x)], 1u);
    return b;
}
__device__ __forceinline__ void xcd_barrier_complete(unsigned* bar, unsigned x, unsigned& nloc, unsigned& nx) {
    const unsigned G = gridDim.x * gridDim.y * gridDim.z;
    unsigned sum, cnt, mine, sp = 0u;
    for (;;) {
        sum = 0u; cnt = 0u; mine = 0u;
#pragma unroll
        for (unsigned j = 0; j < 16; ++j) { const unsigned c = xb_ld(&bar[XB_XCNT(j)]); sum += c; cnt += (c > 0u) ? 1u : 0u; mine = (j == x) ? c : mine; }
        if (sum == G) break;
        __builtin_amdgcn_s_sleep(1);
        if ((++sp & 255u) == 0u) { if (xb_ld(&bar[XB_TMO])) break; if (sp > XB_SPIN_CAP) { atomicAdd(&bar[XB_TMO], 1u); break; } }
    }
    nloc = mine > 0u ? mine : 1u; nx = cnt > 0u ? cnt : 1u;
}

__device__ __forceinline__ void xcd_barrier(const XcdBarrier& b) {
    asm volatile("s_waitcnt vmcnt(0)" ::: "memory");
    __syncthreads();
    if (threadIdx.x == 0) {
        unsigned* bar = b.bar;
        __builtin_amdgcn_s_waitcnt(0);
        unsigned nloc = b.st[0], nx = b.st[1];
        if (nloc == 0u) { xcd_barrier_complete(bar, b.x, nloc, nx); b.st[0] = nloc; b.st[1] = nx; }
        const unsigned old = xb_add(&bar[XB_XSUB(b.x)], 1u);
        const unsigned gen = old / nloc;
        if (old + 1u == (gen + 1u) * nloc) {
            __builtin_amdgcn_fence(__ATOMIC_RELEASE, "agent");
            asm volatile("s_waitcnt vmcnt(0)" ::: "memory");
            const unsigned og = xb_add(&bar[XB_TOP], 1u);
            const unsigned tg = og / nx;
            if (og + 1u == (tg + 1u) * nx) xb_add(&bar[XB_TOPGEN], 1u);
            else XB_SPIN(xb_ld(&bar[XB_TOPGEN]) == tg, bar);
            __builtin_amdgcn_fence(__ATOMIC_ACQUIRE, "agent");
            xb_add(&bar[XB_XGEN(b.x)], 1u);
            asm volatile("s_waitcnt vmcnt(0)" ::: "memory");
        } else {
            XB_SPIN(xb_ld(&bar[XB_XGEN(b.x)]) == gen, bar);
            __builtin_amdgcn_fence(__ATOMIC_ACQUIRE, "agent");
            asm volatile("s_waitcnt vmcnt(0)" ::: "memory");
        }
    }
    __syncthreads();
}

typedef pg8::f32x4 A4;
DI void row_info(int row, int& b, int& pos, bool& lat) { lat = row < NLAT; if (lat) { b = row >> 11; pos = row & 2047; } else { b = (row - NLAT) >> 8; pos = (row - NLAT) & 255; } }

struct EpiProj {
    static constexpr bool PERM = true, AFTER_DRAIN = false;
    bf16* O; float* statq; float* statkv;
    DI void operator()(const A4 (&acc)[2][2][4][2], const pg8::Unit& u, int wr, int wc, int fr, int fq) const {
        const int row0 = u.pm * 256 + wr * 64 + fr, col0 = u.pn * 256 + wc * 32 + 8 * fq;
#pragma unroll
        for (int ai = 0; ai < 2; ++ai)
#pragma unroll
            for (int m = 0; m < 4; ++m) {
                const int row = row0 + ai * 128 + m * 16;
                bf16* rowp = O + (size_t)row * NPROJ + col0;
#pragma unroll
                for (int bj = 0; bj < 2; ++bj) *(u32x4*)(rowp + bj * 128) = pack8(acc[ai][bj][m][0], acc[ai][bj][m][1]);
                if (u.pn <= 1) {
                    float s = 0.f;
#pragma unroll
                    for (int bj = 0; bj < 2; ++bj) {
                        if (u.pn == 1 && bj == 1) continue;
#pragma unroll
                        for (int n = 0; n < 2; ++n) { const A4 x = acc[ai][bj][m][n]; s += (x[0] * x[0] + x[1] * x[1]) + (x[2] * x[2] + x[3] * x[3]); }
                    }
                    s += shx(s, 16); s += shx(s, 32);
                    if (fq == 0) { if (u.pn == 0) statq[row * 4 + wc] = s; else statkv[row * 4 + wc] = s; }
                }
            }
    }
};

struct EpiQK {
    static constexpr bool PERM = true, AFTER_DRAIN = false;
    bf16* Ql; bf16* Qc; bf16* Kb; const float* statq; const float* statkv; const float* rope;
    DI void operator()(const A4 (&acc)[2][2][4][2], const pg8::Unit& u, int wr, int wc, int fr, int fq) const {
        const int row0 = u.pm * 256 + wr * 64 + fr, col0 = u.pn * 256 + wc * 32 + 8 * fq;
        const bool isq = u.pn < 3;
#pragma unroll
        for (int ai = 0; ai < 2; ++ai)
#pragma unroll
            for (int m = 0; m < 4; ++m) {
                const int row = row0 + ai * 128 + m * 16;
                int b, pos; bool lat; row_info(row, b, pos, lat);
                const f32x4 st = *(const f32x4*)((isq ? statq : statkv) + row * 4);
                const float ss = (st[0] + st[1]) + (st[2] + st[3]);
                const float rs = isq ? rsqrtf(ss * (1.f / 256.f) + LN_EPS) * QSCALE : rsqrtf(ss * (1.f / 128.f) + LN_EPS);
#pragma unroll
                for (int bj = 0; bj < 2; ++bj) {
                    const int c = col0 + bj * 128;
                    A4 v0 = acc[ai][bj][m][0] * rs, v1 = acc[ai][bj][m][1] * rs;
                    if (isq) {
                        const int g32 = c >> 5, head = g32 / 3, part = g32 - head * 3, d0 = part * 32 + 8 * fq;
                        if (part == 2 && lat) {
                            A4 p0, p1;
#pragma unroll
                            for (int j = 0; j < 4; ++j) { p0[j] = shx(v0[j], 16); p1[j] = shx(v1[j], 16); }
                            const float* rp = rope + pos * 32 + (fq >> 1) * 8;
                            const f32x4 c0 = *(const f32x4*)rp, c1 = *(const f32x4*)(rp + 4), s0 = *(const f32x4*)(rp + 16), s1 = *(const f32x4*)(rp + 20);
                            if (fq & 1) { v0 = p0 * s0 + v0 * c0; v1 = p1 * s1 + v1 * c1; }
                            else        { v0 = v0 * c0 - p0 * s0; v1 = v1 * c1 - p1 * s1; }
                        }
                        bf16* dst = lat ? Ql + ((size_t)(b * 8 + head) * SEQ + pos) * 96 + d0 : Qc + ((size_t)(b * 8 + head) * CTXL + pos) * 96 + d0;
                        *(u32x4*)dst = pack8(v0, v1);
                    } else {
                        const int cc = c - 768, head = cc >> 6, d0 = cc & 63;
                        bf16* dst = Kb + ((size_t)(b * 8 + head) * NKEY + (lat ? CTXL + pos : pos)) * 96 + d0;
                        *(u32x4*)dst = pack8(v0, v1);
                    }
                }
            }
    }
};

DI float rstd_kv_tok(const float* statkv, int t) { const f32x4 st = *(const f32x4*)(statkv + t * 4); return rsqrtf(((st[0] + st[1]) + (st[2] + st[3])) * (1.f / 128.f) + LN_EPS); }

struct EpiVt {
    static constexpr bool PERM = true, AFTER_DRAIN = false;
    bf16* Vt; const float* statkv;
    DI void operator()(const A4 (&acc)[2][2][4][2], const pg8::Unit& u, int wr, int wc, int fr, int fq) const {
        const int row0 = u.pm * 256 + wr * 64 + fr, col0 = u.pn * 256 + wc * 32 + 8 * fq;
#pragma unroll
        for (int bj = 0; bj < 2; ++bj) {
            const int t0 = col0 + bj * 128;
            int b, pos; bool lat; row_info(t0, b, pos, lat);
            A4 r0, r1;
#pragma unroll
            for (int j = 0; j < 4; ++j) { r0[j] = rstd_kv_tok(statkv, t0 + j); r1[j] = rstd_kv_tok(statkv, t0 + 4 + j); }
#pragma unroll
            for (int ai = 0; ai < 2; ++ai)
#pragma unroll
                for (int m = 0; m < 4; ++m) {
                    const int row = row0 + ai * 128 + m * 16, head = row >> 6, dv = row & 63;
                    bf16* dst = Vt + ((size_t)(b * 8 + head) * 64 + dv) * NKEY + (lat ? CTXL + pos : pos);
                    *(u32x4*)dst = pack8(acc[ai][bj][m][0] * r0, acc[ai][bj][m][1] * r1);
                }
        }
    }
};

struct EpiGt {
    static constexpr bool PERM = true, AFTER_DRAIN = false;
    bf16* Gl; bf16* Gc;
    DI void operator()(const A4 (&acc)[2][2][4][2], const pg8::Unit& u, int wr, int wc, int fr, int fq) const {
        const int row0 = u.pm * 256 + wr * 64 + fr, col0 = u.pn * 256 + wc * 32 + 8 * fq;
#pragma unroll
        for (int bj = 0; bj < 2; ++bj) {
            const int t0 = col0 + bj * 128;
            int b, pos; bool lat; row_info(t0, b, pos, lat);
#pragma unroll
            for (int ai = 0; ai < 2; ++ai)
#pragma unroll
                for (int m = 0; m < 4; ++m) {
                    const int row = row0 + ai * 128 + m * 16, n = row & 255, half = row >> 8;
                    bf16* dst = lat ? Gl + (size_t)(b * 256 + n) * 4096 + half * 2048 + pos : Gc + (size_t)(b * 256 + n) * 512 + half * 256 + pos;
                    *(u32x4*)dst = pack8(acc[ai][bj][m][0], acc[ai][bj][m][1]);
                }
        }
    }
};

struct EpiDft {
    static constexpr bool PERM = true, AFTER_DRAIN = false;
    bf16* mix; int row_base, rows_per_b;
    DI void operator()(const A4 (&acc)[2][2][4][2], const pg8::Unit& u, int wr, int wc, int fr, int fq) const {
        const int row0 = u.pm * 256 + wr * 64 + fr, n0 = wc * 32 + 8 * fq;
#pragma unroll
        for (int ai = 0; ai < 2; ++ai)
#pragma unroll
            for (int m = 0; m < 4; ++m) {
                const int k = row0 + ai * 128 + m * 16;
                bf16* rowp = mix + (size_t)(row_base + u.pn * rows_per_b + k) * MIXD + 1024 + n0;
#pragma unroll
                for (int bj = 0; bj < 2; ++bj) *(u32x4*)(rowp + bj * 128) = pack8(acc[ai][bj][m][0], acc[ai][bj][m][1]);
            }
    }
};

struct EpiRes {
    static constexpr bool PERM = true, AFTER_DRAIN = false;
    const float* Xin; float* Xout; const float* ST; const float* lg; const float* lb; const float* modl; int goff; int pm_off;
    DI void operator()(const A4 (&acc)[2][2][4][2], const pg8::Unit& u, int wr, int wc, int fr, int fq) const {
        const int row0 = u.pm * 256 + wr * 64 + fr, col0 = u.pn * 256 + wc * 32 + 8 * fq;
        const int bidx = (u.pm + pm_off < 64) ? ((u.pm + pm_off) >> 3) : 8;
        const float* gp = modl + bidx * 6144 + goff + col0;
        f32x4 g[2][2], ga[2][2], be[2][2];
#pragma unroll
        for (int bj = 0; bj < 2; ++bj) { g[bj][0] = *(const f32x4*)(gp + bj * 128); g[bj][1] = *(const f32x4*)(gp + bj * 128 + 4); }
        const bool has_ln = lg != nullptr;
        if (has_ln) {
#pragma unroll
            for (int bj = 0; bj < 2; ++bj) { ga[bj][0] = *(const f32x4*)(lg + col0 + bj * 128) * ALPHA; ga[bj][1] = *(const f32x4*)(lg + col0 + bj * 128 + 4) * ALPHA;
                                             be[bj][0] = *(const f32x4*)(lb + col0 + bj * 128) * ALPHA; be[bj][1] = *(const f32x4*)(lb + col0 + bj * 128 + 4) * ALPHA; }
        } else {
#pragma unroll
            for (int bj = 0; bj < 2; ++bj) { ga[bj][0] = (f32x4){ALPHA, ALPHA, ALPHA, ALPHA}; ga[bj][1] = ga[bj][0]; be[bj][0] = (f32x4){0.f, 0.f, 0.f, 0.f}; be[bj][1] = be[bj][0]; }
        }
#pragma unroll
        for (int ai = 0; ai < 2; ++ai)
#pragma unroll
            for (int m = 0; m < 4; ++m) {
                const int row = row0 + ai * 128 + m * 16;
                float mean = 0.f, rstd = 1.f;
                if (has_ln) { const f32x2 st = *(const f32x2*)(ST + 2 * row); mean = st[0]; rstd = st[1]; }
                const float* rin = Xin + (size_t)row * DM + col0; float* rout = Xout + (size_t)row * DM + col0;
#pragma unroll
                for (int bj = 0; bj < 2; ++bj) {
                    f32x4 x0 = *(const f32x4*)(rin + bj * 128), x1 = *(const f32x4*)(rin + bj * 128 + 4);
                    x0 = (x0 - mean) * rstd * ga[bj][0] + be[bj][0] + g[bj][0] * acc[ai][bj][m][0];
                    x1 = (x1 - mean) * rstd * ga[bj][1] + be[bj][1] + g[bj][1] * acc[ai][bj][m][1];
                    *(f32x4*)(rout + bj * 128) = x0; *(f32x4*)(rout + bj * 128 + 4) = x1;
                }
            }
    }
};

DI f32x4 silu4(f32x4 a) { f32x4 r; for (int j = 0; j < 4; ++j) r[j] = a[j] * frcp(1.f + fexp2(-1.4426950408889634f * a[j])); return r; }
struct EpiSwiglu {
    static constexpr bool PERM = true, AFTER_DRAIN = false;
    bf16* U;
    DI void operator()(const A4 (&acc)[2][2][4][2], const pg8::Unit& u, int wr, int wc, int fr, int fq) const {
        const int row0 = u.pm * 256 + wr * 64 + fr, col0 = u.pn * 128 + wc * 32 + 8 * fq;
#pragma unroll
        for (int ai = 0; ai < 2; ++ai)
#pragma unroll
            for (int m = 0; m < 4; ++m) {
                const f32x4 h0 = silu4(acc[ai][0][m][0]) * acc[ai][1][m][0], h1 = silu4(acc[ai][0][m][1]) * acc[ai][1][m][1];
                *(u32x4*)(U + (size_t)(row0 + ai * 128 + m * 16) * DFF + col0) = pack8(h0, h1);
            }
    }
};

template <int M, int N> struct StaticOrderT {
    static constexpr int nM = M / 256, nN = N / 256, nwg = nM * nN;
    int G, c;
    static DI void map(int L, pg8::Unit& u) {
        int wgid = L; { constexpr int q = nwg / 8, r = nwg % 8; const int xcd = wgid % 8, off = wgid / 8; wgid = (xcd < r ? xcd * (q + 1) : r * (q + 1) + (xcd - r) * q) + off; }
        constexpr int nig = 8 * nN; const int gid = wgid / nig, fm = gid * 8, gsz = (nM - fm) < 8 ? (nM - fm) : 8;
        if constexpr (nM % 8 == 0) { u.pm = fm + ((wgid % nig) & 7); u.pn = (wgid % nig) >> 3; }
        else { u.pm = fm + ((wgid % nig) % gsz); u.pn = (wgid % nig) / gsz; }
    }
    DI bool next(int i, pg8::Unit& u) const { const int L = i * G + c; if (L >= nwg) return false; map(L, u); return true; }
    DI void a_ready(const pg8::Unit&) const {}
    DI void done(const pg8::Unit&) const {}
};
constexpr int CW_GCTX = 3584;
struct SchedG {
    int c; unsigned* cnt;
    DI bool next(int i, pg8::Unit& u) const {
        int L;
        if (c < 224) { L = c + 224 * i; if (L >= 1456) return false; }
        else { if (i >= 4) return false; L = 1456 + (c - 224) + 32 * i; }
        if (L < 176) { u.pm = 64 + (L & 7); u.pn = L >> 3; }
        else StaticOrderT<NLAT, 2 * DFF>::map(L - 176, u);
        return true;
    }
    DI void a_ready(const pg8::Unit&) const {}
    DI void done(const pg8::Unit& u) const {
        if (u.pm >= 64) {
            asm volatile("s_waitcnt vmcnt(0)" ::: "memory");
            __syncthreads();
            if (otid() == 0) { __builtin_amdgcn_fence(__ATOMIC_RELEASE, "agent"); asm volatile("s_waitcnt vmcnt(0)" ::: "memory"); (void)xb_add(cnt, 1u); }
        }
    }
};
constexpr int CW_ECTX = 3648;
DI void publish_block(unsigned* cnt) {
    asm volatile("s_waitcnt vmcnt(0)" ::: "memory");
    __syncthreads();
    if (otid() == 0) { __builtin_amdgcn_fence(__ATOMIC_RELEASE, "agent"); asm volatile("s_waitcnt vmcnt(0)" ::: "memory"); (void)xb_add(cnt, 1u); }
}
template <int M, int N> struct StaticOrderSig {
    int G, c; unsigned* cnt;
    DI bool next(int i, pg8::Unit& u) const { const int L = i * G + c; if (L >= StaticOrderT<M, N>::nwg) return false; StaticOrderT<M, N>::map(L, u); return true; }
    DI void a_ready(const pg8::Unit&) const {}
    DI void done(const pg8::Unit&) const { publish_block(cnt); }
};
struct SchedHC {
    int c; unsigned* cnt; unsigned target;
    DI bool next(int i, pg8::Unit& u) const { if (i > 0 || c < 224 || c >= 256) return false; const int k = c - 224; u.pm = k & 7; u.pn = k >> 3; return true; }
    DI void a_ready(const pg8::Unit&) const {
        if (otid() == 0) { unsigned sp = 0; while (xb_ld(cnt) < target) { __builtin_amdgcn_s_sleep(1); if (++sp > (1u << 22)) break; }
            __builtin_amdgcn_fence(__ATOMIC_ACQUIRE, "agent"); asm volatile("s_waitcnt vmcnt(0)" ::: "memory"); }
        __syncthreads();
    }
    DI void done(const pg8::Unit&) const {}
};
template <int LDA, int LDB, int KDIM, class Sched, class Epi> DI void run_gemm_s(LAS unsigned char* lds, const bf16* A, const bf16* Bt, int M, int N, const Sched& S, const Epi& E) {
    pg8::Gemm g{A, Bt, M, N};
    pg8::gemm_phase<Epi, Sched, true, true, LDA, LDB, KDIM>(lds, g, S, E);
    __syncthreads();
}
template <int LDA, int LDB, int KDIM, int M, int N, class Epi> DI void run_gemm(LAS unsigned char* lds, const bf16* A, const bf16* Bt, int G, int c, const Epi& E) {
    pg8::Gemm g{A, Bt, M, N};
    StaticOrderT<M, N> S; S.G = G; S.c = c;
    pg8::gemm_phase<Epi, StaticOrderT<M, N>, true, true, LDA, LDB, KDIM>(lds, g, S, E);
    __syncthreads();
}

template <int NR> DI void row_pass_n(const float* const (&src)[NR], const float* lg, const float* lb, float* const (&dstx)[NR], bf16* const (&dsth)[NR],
                                     const float* const (&sc)[NR], const float* const (&sh)[NR], float* const (&stat)[NR], bool has_stat, bool has_x, bool has_h, int lane) {
    f32x4 v[NR][4]; float s[NR];
#pragma unroll
    for (int r = 0; r < NR; ++r) { const f32x4* xr = (const f32x4*)src[r] + lane; s[r] = 0.f;
#pragma unroll
        for (int j = 0; j < 4; ++j) { v[r][j] = xr[64 * j]; } }
    if (lg) {
#pragma unroll
        for (int r = 0; r < NR; ++r)
#pragma unroll
            for (int j = 0; j < 4; ++j) s[r] += (v[r][j][0] + v[r][j][1]) + (v[r][j][2] + v[r][j][3]);
#pragma unroll
        for (int o = 1; o < 64; o <<= 1)
#pragma unroll
            for (int r = 0; r < NR; ++r) s[r] += shx(s[r], o);
        float s2[NR];
#pragma unroll
        for (int r = 0; r < NR; ++r) { const float mean = s[r] * (1.f / DM); s2[r] = 0.f;
#pragma unroll
            for (int j = 0; j < 4; ++j) { v[r][j] = v[r][j] - mean; s2[r] += (v[r][j][0] * v[r][j][0] + v[r][j][1] * v[r][j][1]) + (v[r][j][2] * v[r][j][2] + v[r][j][3] * v[r][j][3]); } }
#pragma unroll
        for (int o = 1; o < 64; o <<= 1)
#pragma unroll
            for (int r = 0; r < NR; ++r) s2[r] += shx(s2[r], o);
#pragma unroll
        for (int j = 0; j < 4; ++j) { const f32x4 gg = ((const f32x4*)lg)[lane + 64 * j], bb = ((const f32x4*)lb)[lane + 64 * j];
#pragma unroll
            for (int r = 0; r < NR; ++r) { const float rstd = rsqrtf(s2[r] * (1.f / DM) + LN_EPS); v[r][j] = v[r][j] * rstd * gg + bb; } }
        if (has_stat) {
#pragma unroll
            for (int r = 0; r < NR; ++r) if (lane == 0) { f32x2 st2; st2[0] = s[r] * (1.f / DM); st2[1] = rsqrtf(s2[r] * (1.f / DM) + LN_EPS); *(f32x2*)stat[r] = st2; }
        }
    }
    if (has_x) {
#pragma unroll
        for (int r = 0; r < NR; ++r)
#pragma unroll
            for (int j = 0; j < 4; ++j) ((f32x4*)dstx[r])[lane + 64 * j] = v[r][j];
    }
    if (has_h) {
#pragma unroll
        for (int r = 0; r < NR; ++r)
#pragma unroll
            for (int j = 0; j < 4; ++j) {
                const f32x4 a = ((const f32x4*)sc[r])[lane + 64 * j], d = ((const f32x4*)sh[r])[lane + 64 * j];
                const f32x4 h = v[r][j] * (a + 1.f) + d;
                u32x2 w; w.x = pk2(h[0], h[1]); w.y = pk2(h[2], h[3]);
                ((u32x2*)dsth[r])[lane + 64 * j] = w;
            }
    }
}
DI void rows_phase(const Params& p, int mode, int nrows, const float* lg, const float* lb, const float* modl, int sc_off, int sh_off, int gw, int ngw, int lane) {
    float* XRES = (float*)(wsp(p) + WS_XRES); bf16* HA = (bf16*)(wsp(p) + WS_HA); float* STA = (float*)(wsp(p) + WS_ST);
    constexpr int NR = 3;
    for (int row0 = gw; row0 < nrows; row0 += NR * ngw) {
        const float* src[NR]; float* dx[NR]; bf16* dh[NR]; const float* sc[NR]; const float* sh[NR]; float* stp[NR];
#pragma unroll
        for (int r = 0; r < NR; ++r) {
            int row = row0 + r * ngw; if (row >= nrows) row = row0;
            const int bidx = row < NLAT ? (row >> 11) : 8;
            src[r] = (mode == 0) ? (row < NLAT ? inp(p, 0) + (size_t)row * DM : inp(p, 2) + (size_t)(row - NLAT) * DM) : XRES + (size_t)row * DM;
            dx[r] = p.out + (size_t)(row < NLAT ? row : 0) * DM; dh[r] = HA + (size_t)row * DM; stp[r] = STA + 2 * row;
            sc[r] = modl + bidx * 6144 + sc_off; sh[r] = modl + bidx * 6144 + sh_off;
        }
        row_pass_n<NR>(src, lg, lb, dx, dh, sc, sh, stp, mode == 1, mode == 2, mode != 2, lane);
    }
}

template <class RM> DI void tr_item(const float* W, int ldsrc, int k0, int n0, bf16* dst, int lddst, int coloff, const float* kscale, RM rm, LAS float* scr, int lane) {
    {
        const int kq = lane >> 3, nq = lane & 7;
        f32x4 wv[8];
#pragma unroll
        for (int i = 0; i < 8; ++i) wv[i] = *(const f32x4*)(W + (size_t)(k0 + 8 * i + kq) * ldsrc + n0 + 4 * nq);
#pragma unroll
        for (int i = 0; i < 8; ++i) { const int kk = 8 * i + kq; f32x4 w = wv[i]; if (kscale) w = w * kscale[k0 + kk];
            LAS float* d = scr + kk * 33 + 4 * nq; d[0] = w[0]; d[1] = w[1]; d[2] = w[2]; d[3] = w[3]; }
    }
    LDS_WAIT(); asm volatile("" ::: "memory");
    const int c = lane & 7;
#pragma unroll
    for (int j = 0; j < 4; ++j) { const int n = (lane >> 3) + 8 * j; const LAS float* s = scr + (8 * c) * 33 + n;
        u32x4 o; o.x = pk2(s[0 * 33], s[1 * 33]); o.y = pk2(s[2 * 33], s[3 * 33]); o.z = pk2(s[4 * 33], s[5 * 33]); o.w = pk2(s[6 * 33], s[7 * 33]);
        *(u32x4*)(dst + (size_t)rm(n0 + n) * lddst + coloff + k0 + 8 * c) = o; }
    LDS_WAIT(); asm volatile("" ::: "memory");
}
struct RmId { int off; DI int operator()(int n) const { return n + off; } };
struct RmFfn { int off; DI int operator()(int n) const { return 256 * (n >> 7) + (n & 127) + off; } };

DI void zero_rect(bf16* dst, int ld, int row0, int nrows, int col0, int ncols, int gtid, int gthreads) {
    const int cpr = ncols >> 3, total = nrows * cpr; const unsigned zu = __float_as_uint(ozero());
    for (int e = gtid; e < total; e += gthreads) { const int r = e / cpr, cc = e - r * cpr; *(u32x4*)(dst + (size_t)(row0 + r) * ld + col0 + cc * 8) = (u32x4){zu, zu, zu, zu}; }
}

DI void phase_convert(const Params& p, int l, LAS unsigned char* lds, int gw, int ngw, int lane, int gtid, int gthreads) {
    unsigned char* ws = wsp(p);
    LAS float* scr = (LAS float*)(lds + (otid() >> 6) * 16384);
    bf16* Wtin = (bf16*)(ws + WS_WIN); bf16* Wtqk = (bf16*)(ws + WS_WQK); bf16* Wtv = (bf16*)(ws + WS_WV); bf16* Wtf = (bf16*)(ws + WS_WF);
    bf16* Wtout = (bf16*)(ws + WS_WOUT); bf16* Wt13 = (bf16*)(ws + WS_W13); bf16* Wt2 = (bf16*)(ws + WS_W2); bf16* Wtpool = (bf16*)(ws + WS_WPOOL); bf16* Wsb = (bf16*)(ws + WS_WS);
    const float* w_in = inp(p, 6) + (size_t)l * 1024 * 1440; const float* qn = inp(p, 7) + l * 256; const float* w_uq = inp(p, 8) + (size_t)l * 256 * 768;
    const float* kvn = inp(p, 9) + l * 128; const float* w_uk = inp(p, 10) + (size_t)l * 128 * 512; const float* w_uv = inp(p, 11) + (size_t)l * 128 * 512;
    const float* w_sp = inp(p, 14) + (size_t)l * 4 * 128 * 128; const float* w_pool = inp(p, 16) + (size_t)l * 4 * 64 * 64; const float* w_f = inp(p, 18) + (size_t)l * 256 * 256;
    const float* w_out = inp(p, 19) + (size_t)l * 1280 * 1024; const float* w1 = inp(p, 22) + (size_t)l * 1024 * DFF; const float* w3 = inp(p, 23) + (size_t)l * 1024 * DFF; const float* w2 = inp(p, 24) + (size_t)l * DFF * 1024;
    constexpr int I_IN = 16 * 45, I_UQ = 4 * 24, I_UK = 2 * 16, I_UV = 2 * 16, I_OUT = 20 * 32, I_F1 = 16 * 88, I_F3 = 16 * 88, I_F2 = 44 * 32, I_POOL = 8;
    constexpr int NITEMS = I_IN + I_UQ + I_UK + I_UV + I_OUT + I_F1 + I_F3 + I_F2 + I_POOL;
    for (int it = gw; it < NITEMS; it += ngw) {
        int r = it;
        if (r < I_IN) { tr_item(w_in, 1440, 64 * (r / 45), 32 * (r % 45), Wtin, 1024, 0, nullptr, RmId{0}, scr, lane); continue; } r -= I_IN;
        if (r < I_UQ) { tr_item(w_uq, 768, 64 * (r / 24), 32 * (r % 24), Wtqk, 384, 0, qn, RmId{0}, scr, lane); continue; } r -= I_UQ;
        if (r < I_UK) { tr_item(w_uk, 512, 64 * (r / 16), 32 * (r % 16), Wtqk, 384, 256, kvn, RmId{768}, scr, lane); continue; } r -= I_UK;
        if (r < I_UV) { tr_item(w_uv, 512, 64 * (r / 16), 32 * (r % 16), Wtv, 384, 256, kvn, RmId{0}, scr, lane); continue; } r -= I_UV;
        if (r < I_OUT) { tr_item(w_out, 1024, 64 * (r / 32), 32 * (r % 32), Wtout, 1280, 0, nullptr, RmId{0}, scr, lane); continue; } r -= I_OUT;
        if (r < I_F1) { tr_item(w1, DFF, 64 * (r / 88), 32 * (r % 88), Wt13, 1024, 0, nullptr, RmFfn{0}, scr, lane); continue; } r -= I_F1;
        if (r < I_F3) { tr_item(w3, DFF, 64 * (r / 88), 32 * (r % 88), Wt13, 1024, 0, nullptr, RmFfn{128}, scr, lane); continue; } r -= I_F3;
        if (r < I_F2) { tr_item(w2, 1024, 64 * (r / 32), 32 * (r % 32), Wt2, DFF, 0, nullptr, RmId{0}, scr, lane); continue; } r -= I_F2;
        { const int gi = r >> 1; tr_item(w_pool + gi * 4096, 64, 0, 32 * (r & 1), Wtpool + gi * 4096, 64, 0, nullptr, RmId{0}, scr, lane); }
    }
    zero_rect(Wtin, 1024, 1440, 96, 0, 1024, gtid, gthreads);
    zero_rect(Wtqk, 384, 0, 768, 256, 128, gtid, gthreads);
    zero_rect(Wtqk, 384, 768, 512, 0, 256, gtid, gthreads);
    zero_rect(Wtv, 384, 0, 512, 0, 256, gtid, gthreads);
    for (int e = gtid; e < 4 * 128 * 128 / 4; e += gthreads) { const f32x4 v = ((const f32x4*)w_sp)[e]; u32x2 w; w.x = pk2(v[0], v[1]); w.y = pk2(v[2], v[3]); ((u32x2*)Wsb)[e] = w; }
    for (int e = gtid; e < 256 * 256; e += gthreads) {
        const int n = e & 255, gc = e >> 8, g = gc >> 6, c = gc & 63;
        float sc_ = 0.f, ss_ = 0.f;
        for (int m = 0; m < 64; ++m) { const float w = w_f[(size_t)(g * 64 + m) * 256 + n]; const float a = (float)((m * c) & 63) * (1.f / 64.f); sc_ += cos_turn(a) * w; ss_ += sin_turn(a) * w; }
        Wtf[(size_t)n * 256 + gc] = (bf16)(pk2(sc_, 0.f) & 0xffffu); Wtf[(size_t)(256 + n) * 256 + gc] = (bf16)(pk2(-ss_, 0.f) & 0xffffu);
    }
}

DI void phase_prologue(const Params& p, LAS unsigned char* lds, int G, int bid) {
    const int tid = otid();
    LAS float* S = (LAS float*)lds;
    LAS float* red = (LAS float*)(lds + 40960);
    const float* cvec = inp(p, 1); const float* ccv = inp(p, 3); const float* w_mod = inp(p, 4); const float* b_mod = inp(p, 5);
    float* MOD = (float*)(wsp(p) + WS_MOD);
    for (int i = tid; i < 9 * 1024; i += 512) { const float v = i < 8192 ? cvec[i] : ccv[i - 8192]; S[i] = v * frcp(1.f + fexp2(-1.4426950408889634f * v)); }
    __syncthreads();
    for (int item = bid; item < 4 * 48; item += G) {
        const int l = item / 48, n0 = (item - l * 48) * 128, lane = tid & 63, ks = tid >> 6, kp = lane >> 5, c4 = (lane & 31) * 4;
        const float* W = w_mod + (size_t)l * 1024 * 6144 + n0 + c4;
        f32x4 acc[9];
#pragma unroll
        for (int r = 0; r < 9; ++r) acc[r] = (f32x4){0.f, 0.f, 0.f, 0.f};
#pragma unroll 16
        for (int i = 0; i < 64; ++i) {
            const int k = ks * 128 + 2 * i + kp;
            const f32x4 w = *(const f32x4*)(W + (size_t)k * 6144);
#pragma unroll
            for (int r = 0; r < 9; ++r) acc[r] = acc[r] + w * S[r * 1024 + k];
        }
        LAS float* rr = red + ((ks * 2 + kp) * 9) * 128 + c4;
#pragma unroll
        for (int r = 0; r < 9; ++r) { rr[r * 128 + 0] = acc[r][0]; rr[r * 128 + 1] = acc[r][1]; rr[r * 128 + 2] = acc[r][2]; rr[r * 128 + 3] = acc[r][3]; }
        __syncthreads();
        for (int o = tid; o < 9 * 128; o += 512) {
            const int r = o >> 7, jj = o & 127; float s = b_mod[l * 6144 + n0 + jj];
#pragma unroll
            for (int k2 = 0; k2 < 16; ++k2) s += red[k2 * 1152 + o];
            MOD[(size_t)(l * 9 + r) * 6144 + n0 + jj] = s;
        }
        __syncthreads();
    }
    const int gtid = bid * 512 + tid, gthreads = G * 512;
    bf16* CSL = (bf16*)(wsp(p) + WS_CSL); bf16* CSC = (bf16*)(wsp(p) + WS_CSC);
    for (int ch = gtid; ch < 1048576 + 16384; ch += gthreads) {
        float v[8];
        if (ch < 1048576) {
            const int k = ch >> 9, l0 = (ch & 511) * 8, half = l0 >> 11, lb = l0 & 2047; const float scale = 0.00276213586400995f;
#pragma unroll
            for (int j = 0; j < 8; ++j) { const float a = (float)((k * (lb + j)) & 2047) * (1.f / 2048.f); v[j] = (half ? sin_turn(a) : cos_turn(a)) * scale; }
            u32x4 w; w.x = pk2(v[0], v[1]); w.y = pk2(v[2], v[3]); w.z = pk2(v[4], v[5]); w.w = pk2(v[6], v[7]);
            *(u32x4*)(CSL + (size_t)k * 4096 + l0) = w;
        } else {
            const int c2 = ch - 1048576, k = c2 >> 6, l0 = (c2 & 63) * 8, half = l0 >> 8, lb = l0 & 255; const float scale = 1.f / 128.f;
#pragma unroll
            for (int j = 0; j < 8; ++j) { const float a = (float)((k * (lb + j)) & 255) * (1.f / 256.f); v[j] = (half ? sin_turn(a) : cos_turn(a)) * scale; }
            u32x4 w; w.x = pk2(v[0], v[1]); w.y = pk2(v[2], v[3]); w.z = pk2(v[4], v[5]); w.w = pk2(v[6], v[7]);
            *(u32x4*)(CSC + (size_t)k * 512 + l0) = w;
        }
    }
    float* ROPE = (float*)(wsp(p) + WS_ROPE);
    for (int e = gtid; e < 2048 * 16; e += gthreads) {
        const int pos = e >> 4, f = e & 15, axis = f >> 3, fi = f & 7;
        const float coord = (float)(axis ? (pos & 63) : (pos >> 6));
        const float inv = fexp2(-(float)fi * (13.287712379549449f / 8.f));
        const float ang = coord * inv * 0.15915494309189535f;
        ROPE[pos * 32 + f] = cos_turn(ang); ROPE[pos * 32 + 16 + f] = sin_turn(ang);
    }
}

DI f32x4 mfma16(bf16x8 a, bf16x8 b, f32x4 c) { return __builtin_amdgcn_mfma_f32_16x16x32_bf16(a, b, c, 0, 0, 0); }
DI f32x16 mfma32(bf16x8 a, bf16x8 b, f32x16 c) { return __builtin_amdgcn_mfma_f32_32x32x16_bf16(a, b, c, 0, 0, 0); }

DI void sgu_item(const Params& p, int l, int ci, int g, LAS unsigned char* lds) {
    const int tid = otid(), lane = tid & 63, w = tid >> 6;
    const bf16* proj = (const bf16*)(wsp(p) + WS_PROJ); bf16* mix = (bf16*)(wsp(p) + WS_MIX); const bf16* Wsb = (const bf16*)(wsp(p) + WS_WS);
    const float* gam = inp(p, 12) + l * 256; const float* bet = inp(p, 13) + l * 256; const float* bsp = inp(p, 15) + l * 512;
    constexpr int PITCH = 136;
    LAS bf16* vnT = (LAS bf16*)lds;
    const int r0 = ci * 128;
    const int fr = lane & 15, fq = lane >> 4, pp = 16 * w + fr, tok = r0 + pp;
    bf16x8 wfr[4]; u32x2 uu[4];
#pragma unroll
    for (int ks = 0; ks < 4; ++ks) wfr[ks] = *(const bf16x8*)(Wsb + (size_t)(g * 128 + pp) * 128 + ks * 32 + fq * 8);
#pragma unroll
    for (int ct = 0; ct < 4; ++ct) uu[ct] = *(const u32x2*)(proj + (size_t)tok * NPROJ + PO_SU + g * 64 + ct * 16 + fq * 4);
    const float bs = bsp[g * 128 + pp];
    {
        const int q = tid >> 2, j = tid & 3;
        const u32x4* src = (const u32x4*)(proj + (size_t)(r0 + q) * NPROJ + PO_SV + j * 64);
        float v[64]; float s = 0.f;
#pragma unroll
        for (int i = 0; i < 8; ++i) { const u32x4 x = src[i];
            v[8 * i + 0] = bflo(x.x); v[8 * i + 1] = bfhi(x.x); v[8 * i + 2] = bflo(x.y); v[8 * i + 3] = bfhi(x.y);
            v[8 * i + 4] = bflo(x.z); v[8 * i + 5] = bfhi(x.z); v[8 * i + 6] = bflo(x.w); v[8 * i + 7] = bfhi(x.w); }
#pragma unroll
        for (int i = 0; i < 64; ++i) s += v[i];
        s += shx(s, 1); s += shx(s, 2);
        const float mean = s * (1.f / 256.f); float s2 = 0.f;
#pragma unroll
        for (int i = 0; i < 64; ++i) { v[i] -= mean; s2 += v[i] * v[i]; }
        s2 += shx(s2, 1); s2 += shx(s2, 2);
        const float rstd = rsqrtf(s2 * (1.f / 256.f) + LN_EPS);
        if (j == g) {
#pragma unroll
            for (int c = 0; c < 64; ++c) { const float vn = v[c] * rstd * gam[g * 64 + c] + bet[g * 64 + c]; vnT[c * PITCH + q] = (bf16)(pk2(vn, 0.f) & 0xffffu); }
        }
    }
    __syncthreads();
    {
        f32x4 acc[4]; const float zf = ozero();
#pragma unroll
        for (int ct = 0; ct < 4; ++ct) acc[ct] = (f32x4){zf, zf, zf, zf};
#pragma unroll
        for (int ks = 0; ks < 4; ++ks) {
            const bf16x8 bfr = wfr[ks];
#pragma unroll
            for (int ct = 0; ct < 4; ++ct) { const bf16x8 afr = *(const LAS bf16x8*)(vnT + (ct * 16 + fr) * PITCH + ks * 32 + fq * 8); acc[ct] = mfma16(afr, bfr, acc[ct]); }
        }
#pragma unroll
        for (int ct = 0; ct < 4; ++ct) {
            const int c0 = g * 64 + ct * 16 + fq * 4;
            u32x2 o; o.x = pk2(bflo(uu[ct].x) * (acc[ct][0] + bs), bfhi(uu[ct].x) * (acc[ct][1] + bs)); o.y = pk2(bflo(uu[ct].y) * (acc[ct][2] + bs), bfhi(uu[ct].y) * (acc[ct][3] + bs));
            *(u32x2*)(mix + (size_t)tok * MIXD + 512 + c0) = o;
        }
    }
    __syncthreads();
}

DI void pool_item(const Params& p, int l, int ti, int gi, LAS unsigned char* lds) {
    const int tid = otid(), lane = tid & 63, w = tid >> 6;
    const bf16* proj = (const bf16*)(wsp(p) + WS_PROJ); bf16* mix = (bf16*)(wsp(p) + WS_MIX); const bf16* Wtp = (const bf16*)(wsp(p) + WS_WPOOL) + gi * 4096;
    const float* pscale = inp(p, 17) + l * 256 + gi * 64;
    LAS float* Pl = (LAS float*)lds;
    LAS bf16* Dl = (LAS bf16*)(lds + 40960);
    const int r0 = ti * 128, half = 1 << gi;
    int sb, se; if (r0 < NLAT) { sb = r0 & ~2047; se = sb + 2048; } else { sb = NLAT + ((r0 - NLAT) & ~255); se = sb + 256; }
    const unsigned zu = __float_as_uint(ozero());
    const int fr = lane & 15, fq = lane >> 4;
    bf16x8 wfr[2][4]; f32x4 psc[4];
#pragma unroll
    for (int ks = 0; ks < 2; ++ks)
#pragma unroll
        for (int nt = 0; nt < 4; ++nt) wfr[ks][nt] = *(const bf16x8*)(Wtp + (nt * 16 + fr) * 64 + ks * 32 + fq * 8);
#pragma unroll
    for (int nt = 0; nt < 4; ++nt) psc[nt] = *(const f32x4*)(pscale + nt * 16 + fq * 4);
    for (int e = tid; e < 144 * 8; e += 512) {
        const int rr = e >> 3, c8 = (e & 7) * 8, r = r0 - 8 + rr;
        u32x4 x = (u32x4){zu, zu, zu, zu};
        if (r >= sb && r < se) x = *(const u32x4*)(proj + (size_t)r * NPROJ + PO_POOL + gi * 64 + c8);
        LAS float* d = Pl + rr * 65 + c8;
        d[0] = bflo(x.x); d[1] = bfhi(x.x); d[2] = bflo(x.y); d[3] = bfhi(x.y); d[4] = bflo(x.z); d[5] = bfhi(x.z); d[6] = bflo(x.w); d[7] = bfhi(x.w);
    }
    __syncthreads();
    {
        const int c = tid & 63, t0 = (tid >> 6) * 16;
        float s = 0.f;
        for (int rr = t0 + 8 - half; rr < t0 + 8 + half; ++rr) s += Pl[rr * 65 + c];
        float add[15], sub[15], ctr[16];
#pragma unroll
        for (int i = 0; i < 15; ++i) { add[i] = Pl[(t0 + i + 8 + half) * 65 + c]; sub[i] = Pl[(t0 + i + 8 - half) * 65 + c]; }
#pragma unroll
        for (int i = 0; i < 16; ++i) ctr[i] = Pl[(t0 + i + 8) * 65 + c];
#pragma unroll
        for (int i = 0; i < 16; ++i) {
            const int r = r0 + t0 + i;
            const int lo = max(r - half, sb), hi = min(r + half, se);
            const float d = s * frcp((float)(hi - lo)) - ctr[i];
            Dl[(t0 + i) * 72 + c] = (bf16)(pk2(d, 0.f) & 0xffffu);
            if (i < 15) s += add[i] - sub[i];
        }
    }
    __syncthreads();
    {
        const int t = 16 * w + fr;
        f32x4 acc[4]; const float zf = ozero();
#pragma unroll
        for (int nt = 0; nt < 4; ++nt) acc[nt] = (f32x4){zf, zf, zf, zf};
#pragma unroll
        for (int ks = 0; ks < 2; ++ks) {
            const bf16x8 bfr = *(const LAS bf16x8*)(Dl + t * 72 + ks * 32 + fq * 8);
#pragma unroll
            for (int nt = 0; nt < 4; ++nt) acc[nt] = mfma16(wfr[ks][nt], bfr, acc[nt]);
        }
#pragma unroll
        for (int nt = 0; nt < 4; ++nt) {
            const int n0 = nt * 16 + fq * 4; const f32x4 sc = psc[nt];
            u32x2 o; o.x = pk2(acc[nt][0] * sc[0], acc[nt][1] * sc[1]); o.y = pk2(acc[nt][2] * sc[2], acc[nt][3] * sc[3]);
            *(u32x2*)(mix + (size_t)(r0 + t) * MIXD + 768 + gi * 64 + n0) = o;
        }
    }
    __syncthreads();
}

DI void krope_items(const Params& p, int gtid, int gthreads) {
    const bf16* proj = (const bf16*)(wsp(p) + WS_PROJ); bf16* Kb = (bf16*)(wsp(p) + WS_K); const float* rope = (const float*)(wsp(p) + WS_ROPE);
    for (int e = gtid; e < MTOK * 2; e += gthreads) {
        const int row = e >> 1, axis = e & 1;
        int b, pos; bool lat; row_info(row, b, pos, lat);
        const u32x4 x1 = *(const u32x4*)(proj + (size_t)row * NPROJ + PO_KR + axis * 16), x2 = *(const u32x4*)(proj + (size_t)row * NPROJ + PO_KR + axis * 16 + 8);
        u32x4 o1 = x1, o2 = x2;
        if (lat) {
            const float* rp = rope + pos * 32 + axis * 8;
            float a[8], c[8], cs[8], sn[8];
            a[0] = bflo(x1.x); a[1] = bfhi(x1.x); a[2] = bflo(x1.y); a[3] = bfhi(x1.y); a[4] = bflo(x1.z); a[5] = bfhi(x1.z); a[6] = bflo(x1.w); a[7] = bfhi(x1.w);
            c[0] = bflo(x2.x); c[1] = bfhi(x2.x); c[2] = bflo(x2.y); c[3] = bfhi(x2.y); c[4] = bflo(x2.z); c[5] = bfhi(x2.z); c[6] = bflo(x2.w); c[7] = bfhi(x2.w);
#pragma unroll
            for (int j = 0; j < 8; ++j) { cs[j] = rp[j]; sn[j] = rp[16 + j]; }
            float y1[8], y2[8];
#pragma unroll
            for (int j = 0; j < 8; ++j) { y1[j] = a[j] * cs[j] - c[j] * sn[j]; y2[j] = a[j] * sn[j] + c[j] * cs[j]; }
            o1.x = pk2(y1[0], y1[1]); o1.y = pk2(y1[2], y1[3]); o1.z = pk2(y1[4], y1[5]); o1.w = pk2(y1[6], y1[7]);
            o2.x = pk2(y2[0], y2[1]); o2.y = pk2(y2[2], y2[3]); o2.z = pk2(y2[4], y2[5]); o2.w = pk2(y2[6], y2[7]);
        }
        const int key = lat ? CTXL + pos : pos;
#pragma unroll
        for (int h = 0; h < 8; ++h) { bf16* dst = Kb + ((size_t)(b * 8 + h) * NKEY + key) * 96 + 64 + axis * 16; *(u32x4*)dst = o1; *(u32x4*)(dst + 8) = o2; }
    }
}

DI int swap23(int r) { return (r & ~12) | ((r & 4) << 1) | ((r & 8) >> 1); }
DI void attn_item(const bf16* Qp, const bf16* Kp, const bf16* Vtp, int nkeys, bf16* outp  , LAS unsigned char* lds) {
    const int tid = otid(), lane = tid & 63, w = tid >> 6, r = lane & 31, hh = lane >> 5, gk = w >> 2, wq = w & 3;
    constexpr int KP = 208, VP = 144, KT = 64 * KP, VT = 64 * VP;
    LAS unsigned char* Kl = lds; LAS unsigned char* Vl = lds + 4 * KT;
    bf16x8 qf[6];
#pragma unroll
    for (int kk = 0; kk < 6; ++kk) qf[kk] = *(const bf16x8*)(Qp + (size_t)(32 * wq + r) * 96 + kk * 16 + hh * 8);
    const float zf = ozero();
    f32x16 o0, o1;
#pragma unroll
    for (int i = 0; i < 16; ++i) { o0[i] = zf; o1[i] = zf; }
    float mrun = -60.f, lrun = zf;
    unsigned kg[3], kl[3], vg[2], vl[2];
#pragma unroll
    for (int i = 0; i < 3; ++i) { const int c = tid + 512 * i, tile = c / 768, cc = c - tile * 768, row = cc / 12, col = cc - row * 12;
        kg[i] = (unsigned)((tile * 64 + row) * 96 + col * 8); kl[i] = (unsigned)(tile * KT + swap23(row) * KP + col * 16); }
#pragma unroll
    for (int i = 0; i < 2; ++i) { const int c = tid + 512 * i, tile = c >> 9, cc = c & 511, dv = cc >> 3, col = cc & 7;
        vg[i] = (unsigned)(dv * NKEY + tile * 64 + col * 8); vl[i] = (unsigned)(tile * VT + dv * VP + col * 16); }
    const int npairs = nkeys >> 7;
    u32x4 sk[3], sv[2];
#pragma unroll
    for (int i = 0; i < 3; ++i) sk[i] = *(const u32x4*)(Kp + kg[i]);
#pragma unroll
    for (int i = 0; i < 2; ++i) sv[i] = *(const u32x4*)(Vtp + vg[i]);
#pragma unroll
    for (int i = 0; i < 3; ++i) *(LAS u32x4*)(Kl + kl[i]) = sk[i];
#pragma unroll
    for (int i = 0; i < 2; ++i) *(LAS u32x4*)(Vl + vl[i]) = sv[i];
    __syncthreads();
    for (int kp = 0; kp < npairs; ++kp) {
        const int cur = kp & 1;
        if (kp + 1 < npairs) {
            const bf16* kgp = Kp + (size_t)(kp + 1) * 128 * 96; const bf16* vgp = Vtp + (kp + 1) * 128;
#pragma unroll
            for (int i = 0; i < 3; ++i) sk[i] = *(const u32x4*)(kgp + kg[i]);
#pragma unroll
            for (int i = 0; i < 2; ++i) sv[i] = *(const u32x4*)(vgp + vg[i]);
        }
        const LAS unsigned char* kb = Kl + (cur * 2 + gk) * KT; const LAS unsigned char* vb = Vl + (cur * 2 + gk) * VT;
        f32x16 s0, s1; const float negm = -mrun;
#pragma unroll
        for (int i = 0; i < 16; ++i) { s0[i] = negm; s1[i] = negm; }
#pragma unroll
        for (int kk = 0; kk < 6; ++kk) {
            const bf16x8 ka0 = *(const LAS bf16x8*)(kb + r * KP + kk * 32 + hh * 16);
            const bf16x8 ka1 = *(const LAS bf16x8*)(kb + (32 + r) * KP + kk * 32 + hh * 16);
            s0 = mfma32(ka0, qf[kk], s0); s1 = mfma32(ka1, qf[kk], s1);
        }
        float mx = s0[0];
#pragma unroll
        for (int i = 1; i < 16; ++i) mx = fmaxf(mx, s0[i]);
#pragma unroll
        for (int i = 0; i < 16; ++i) mx = fmaxf(mx, s1[i]);
        if (__builtin_amdgcn_ballot_w64(mx > 6.f) != 0ull) {
            mx = fmaxf(mx, shx(mx, 32));
            const float dm = fmaxf(mx, 0.f), alpha = fexp2(-dm);
            mrun += dm; lrun *= alpha;
#pragma unroll
            for (int i = 0; i < 16; ++i) { s0[i] -= dm; s1[i] -= dm; o0[i] *= alpha; o1[i] *= alpha; }
        }
        float ls = 0.f;
#pragma unroll
        for (int i = 0; i < 16; ++i) { s0[i] = fexp2(s0[i]); s1[i] = fexp2(s1[i]); ls += s0[i] + s1[i]; }
        lrun += ls;
        bf16x8 pf[2][2];
#pragma unroll
        for (int s2 = 0; s2 < 2; ++s2) {
            u32x4 a, b2;
            a.x = pk2(s0[8 * s2 + 0], s0[8 * s2 + 1]); a.y = pk2(s0[8 * s2 + 2], s0[8 * s2 + 3]); a.z = pk2(s0[8 * s2 + 4], s0[8 * s2 + 5]); a.w = pk2(s0[8 * s2 + 6], s0[8 * s2 + 7]);
            b2.x = pk2(s1[8 * s2 + 0], s1[8 * s2 + 1]); b2.y = pk2(s1[8 * s2 + 2], s1[8 * s2 + 3]); b2.z = pk2(s1[8 * s2 + 4], s1[8 * s2 + 5]); b2.w = pk2(s1[8 * s2 + 6], s1[8 * s2 + 7]);
            pf[0][s2] = __builtin_bit_cast(bf16x8, a); pf[1][s2] = __builtin_bit_cast(bf16x8, b2);
        }
#pragma unroll
        for (int d = 0; d < 2; ++d)
#pragma unroll
            for (int s2 = 0; s2 < 2; ++s2) {
                const bf16x8 v0 = *(const LAS bf16x8*)(vb + r * VP + (d * 32 + s2 * 16 + hh * 8) * 2);
                const bf16x8 v1 = *(const LAS bf16x8*)(vb + (32 + r) * VP + (d * 32 + s2 * 16 + hh * 8) * 2);
                o0 = mfma32(v0, pf[d][s2], o0); o1 = mfma32(v1, pf[d][s2], o1);
            }
        if (kp + 1 < npairs) {
            LAS unsigned char* kn = Kl + (cur ^ 1) * 2 * KT; LAS unsigned char* vn = Vl + (cur ^ 1) * 2 * VT;
#pragma unroll
            for (int i = 0; i < 3; ++i) *(LAS u32x4*)(kn + kl[i]) = sk[i];
#pragma unroll
            for (int i = 0; i < 2; ++i) *(LAS u32x4*)(vn + vl[i]) = sv[i];
        }
        __syncthreads();
    }
    lrun += shx(lrun, 32);
    LAS float* mg = (LAS float*)lds + wq * (34 * 64) + lane;
    if (gk == 1) {
#pragma unroll
        for (int i = 0; i < 16; ++i) { mg[i * 64] = o0[i]; mg[(16 + i) * 64] = o1[i]; }
        mg[32 * 64] = mrun; mg[33 * 64] = lrun;
    }
    __syncthreads();
    if (gk == 0) {
        const float m1 = mg[32 * 64], l1 = mg[33 * 64];
        const float m = fmaxf(mrun, m1), a0 = fexp2(mrun - m), a1 = fexp2(m1 - m);
        const float inv = frcp(lrun * a0 + l1 * a1), c0 = a0 * inv, c1 = a1 * inv;
        bf16* orow = outp + (size_t)(32 * wq + r) * MIXD;
#pragma unroll
        for (int i4 = 0; i4 < 4; ++i4) {
            u32x2 a, b2;
            a.x = pk2(o0[4 * i4] * c0 + mg[(4 * i4) * 64] * c1, o0[4 * i4 + 1] * c0 + mg[(4 * i4 + 1) * 64] * c1);
            a.y = pk2(o0[4 * i4 + 2] * c0 + mg[(4 * i4 + 2) * 64] * c1, o0[4 * i4 + 3] * c0 + mg[(4 * i4 + 3) * 64] * c1);
            b2.x = pk2(o1[4 * i4] * c0 + mg[(16 + 4 * i4) * 64] * c1, o1[4 * i4 + 1] * c0 + mg[(16 + 4 * i4 + 1) * 64] * c1);
            b2.y = pk2(o1[4 * i4 + 2] * c0 + mg[(16 + 4 * i4 + 2) * 64] * c1, o1[4 * i4 + 3] * c0 + mg[(16 + 4 * i4 + 3) * 64] * c1);
            *(u32x2*)(orow + 8 * i4 + 4 * hh) = a; *(u32x2*)(orow + 32 + 8 * i4 + 4 * hh) = b2;
        }
    }
    __syncthreads();
}

DI void attn_any(const Params& p, int item, LAS unsigned char* lds) {
    unsigned char* ws = wsp(p);
    const bool isl = item < 1024;
    const int bh = isl ? (item >> 4) : ((item - 1024) >> 1), qb = isl ? (item & 15) : ((item - 1024) & 1), b = bh >> 3, h = bh & 7;
    const bf16* Qp = isl ? (const bf16*)(ws + WS_QLAT) + ((size_t)bh * SEQ + qb * 128) * 96 : (const bf16*)(ws + WS_QCTX) + ((size_t)bh * CTXL + qb * 128) * 96;
    const bf16* Kp = (const bf16*)(ws + WS_K) + (size_t)bh * NKEY * 96;
    const bf16* Vtp = (const bf16*)(ws + WS_VT) + (size_t)bh * 64 * NKEY;
    bf16* outp = (bf16*)(ws + WS_MIX) + (size_t)(isl ? (b * SEQ + qb * 128) : (NLAT + b * CTXL + qb * 128)) * MIXD + h * 64;
    attn_item(Qp, Kp, Vtp, isl ? NKEY : CTXL, outp, lds);
    if (!isl) publish_block((unsigned*)(ws + WS_CTL) + CW_ECTX);
}

#ifndef PROBE_REP_SUB
#define PROBE_REP_SUB -1
#endif
#ifndef PROBE_SYNCS
#define PROBE_SYNCS 0
#endif
constexpr int NSUB = 13 + (PROBE_REP_SUB >= 0 ? 1 : 0), NSTEP = 2 + NSUB * DEPTH;
__global__ void __launch_bounds__(512, 2) mk_fwd(Params p) {
    extern __shared__ __attribute__((aligned(16))) unsigned char lds_raw[];
    LAS unsigned char* lds = (LAS unsigned char*)lds_raw;
    cg::grid_group grid = cg::this_grid();
    volatile LAS unsigned* MISC = (volatile LAS unsigned*)(lds + MISC_OFF);
    if (threadIdx.x < 4) MISC[threadIdx.x] = 0u;
    __syncthreads();
    const XcdBarrier xbar = xcd_barrier_post((unsigned*)(p.ws + WS_CTL), MISC);
    if (p.ph_lo < 0) grid.sync();
    for (int st = p.ph_lo; st < p.ph_hi; ++st) {
        int G = gridDim.x, bid = blockIdx.x; asm volatile("" : "+s"(G), "+s"(bid));
        const int vcu = (G % 8 == 0) ? (bid % 8) * (G / 8) + bid / 8 : bid;
        const int ngw = G * 8, gthreads = G * 512;
        const int tid = otid(), lane = tid & 63, wave = tid >> 6, gw = bid * 8 + wave, gtid = bid * 512 + tid;
        const int l = (st - 1) / NSUB, subx = (st - 1) - l * NSUB, sub = (st == 0) ? 100 : (st == NSTEP - 1) ? 101 : ((PROBE_REP_SUB >= 0 && subx > PROBE_REP_SUB) ? subx - 1 : subx);
        const bool need_sync = !(sub == 3 || sub == 4 || sub == 5 || sub == 7 || sub == 8 || sub == 100);
        if (st > p.ph_lo && need_sync) xcd_barrier(xbar);
        unsigned char* ws = wsp(p);
        float* XRES = (float*)(ws + WS_XRES); bf16* HA = (bf16*)(ws + WS_HA); bf16* PROJ = (bf16*)(ws + WS_PROJ);
        bf16* MIX = (bf16*)(ws + WS_MIX); bf16* U = (bf16*)(ws + WS_U);
        const float* MOD = (const float*)(ws + WS_MOD);
        float* STQ = (float*)(ws + WS_STQ); float* STKV = (float*)(ws + WS_STKV);
        const bool last = (l == DEPTH - 1);
        const int Mtail = last ? NLAT : MTOK;
        const float* modl = MOD + (size_t)l * 9 * 6144;
        if (PROBE_SYNCS > 0 && sub == 101) { for (int i = 0; i < PROBE_SYNCS; ++i) xcd_barrier(xbar); }
        switch (sub) {
        case 100: phase_prologue(p, lds, G, bid); break;
        case 101: {
            rows_phase(p, 2, NLAT, inp(p, 25) + (DEPTH - 1) * DM, inp(p, 26) + (DEPTH - 1) * DM, modl, 0, 0, gw, ngw, lane);
        } break;
        case 0: {
            const float* lg = (l == 0) ? nullptr : inp(p, 25) + (l - 1) * DM; const float* lb = (l == 0) ? nullptr : inp(p, 26) + (l - 1) * DM;
            rows_phase(p, l == 0 ? 0 : 1, MTOK, lg, lb, modl, 1024, 0, gw, ngw, lane);
            phase_convert(p, l, lds, gw, ngw, lane, gtid, gthreads);
        } break;
        case 1: {
            EpiProj E{PROJ, STQ, STKV};
            run_gemm<DM, DM, DM, MTOK, NPROJ>(lds, HA, (const bf16*)(ws + WS_WIN), G, bid, E);
        } break;
        case 2: {
            EpiQK E{(bf16*)(ws + WS_QLAT), (bf16*)(ws + WS_QCTX), (bf16*)(ws + WS_K), STQ, STKV, (const float*)(ws + WS_ROPE)};
            run_gemm<NPROJ, 384, 384, MTOK, 1280>(lds, PROJ, (const bf16*)(ws + WS_WQK), G, bid, E);
        } break;
        case 3: {
            EpiVt E{(bf16*)(ws + WS_VT), STKV};
            run_gemm<384, NPROJ, 384, 512, MTOK>(lds, (const bf16*)(ws + WS_WV), PROJ, G, (bid + G - 104) % G, E);
        } break;
        case 4: {
            EpiGt E{(bf16*)(ws + WS_GTL), (bf16*)(ws + WS_GTC)};
            run_gemm<256, NPROJ, 256, 512, MTOK>(lds, (const bf16*)(ws + WS_WF), PROJ + PO_F, G, (bid + G - 104) % G, E);
        } break;
        case 5: {
            int first, cnt;
            if (G == 256) { if (bid < 104) { first = bid * 5; cnt = 5; } else if (bid < 248) { first = 520 + (bid - 104) * 4; cnt = 4; } else { first = 1096 + (bid - 248) * 7; cnt = 7; } }
            else { first = bid; cnt = (1152 - bid + G - 1) / G; }
            for (int k = 0; k < cnt; ++k) { const int it = (G == 256) ? first + k : first + k * G;
                if (it < 576) sgu_item(p, l, it >> 2, it & 3, lds); else pool_item(p, l, (it - 576) >> 2, (it - 576) & 3, lds); }
            krope_items(p, gtid, gthreads);
        } break;
        case 6: {
            EpiDft E{MIX, 0, SEQ};
            run_gemm<4096, 4096, 4096, 2048, 2048>(lds, (const bf16*)(ws + WS_CSL), (const bf16*)(ws + WS_GTL), G, vcu, E);
        } break;
        case 7: {
            if (!last) { EpiDft E{MIX, NLAT, CTXL};
              StaticOrderSig<256, 2048> S{G, (vcu + G - 64) % G, (unsigned*)(ws + WS_CTL) + CW_ECTX};
              run_gemm_s<512, 512, 512>(lds, (const bf16*)(ws + WS_CSC), (const bf16*)(ws + WS_GTC), 256, 2048, S, E); }
        } break;
        case 8: {
            if (G == 256) {
                int first, cnt, citem = -1;
                if (vcu < 64) { first = 2 * vcu; cnt = 2; } else if (vcu < 72) { first = 128 + 5 * (vcu - 64); cnt = 5; }
                else if (vcu < 104) { first = 168 + 3 * (vcu - 72); cnt = 3; } else { first = 264 + 5 * (vcu - 104); cnt = 5; if (!last && vcu < 232) citem = 1024 + (vcu - 104); }
                if (citem >= 0) attn_any(p, citem, lds);
                for (int k = 0; k < cnt; ++k) attn_any(p, first + k, lds);
                if (!last) {
                    SchedHC S{vcu + 152, (unsigned*)(ws + WS_CTL) + CW_ECTX, 136u * (unsigned)(l + 1)};
                    EpiRes E2{(l == 0) ? inp(p, 2) : XRES + (size_t)NLAT * DM, XRES + (size_t)NLAT * DM, (const float*)(ws + WS_ST) + 2 * NLAT, (l == 0) ? nullptr : inp(p, 25) + (l - 1) * DM, (l == 0) ? nullptr : inp(p, 26) + (l - 1) * DM, modl, 2048, 64};
                    run_gemm_s<MIXD, MIXD, MIXD>(lds, MIX + (size_t)NLAT * MIXD, (const bf16*)(ws + WS_WOUT), NCTX, DM, S, E2);
                }
            } else {
                for (int it = vcu; it < (last ? 1024 : 1152); it += G) attn_any(p, it, lds);
            }
        } break;
        case 9: {
            EpiRes E{(l == 0) ? inp(p, 0) : XRES, XRES, (const float*)(ws + WS_ST), (l == 0) ? nullptr : inp(p, 25) + (l - 1) * DM, (l == 0) ? nullptr : inp(p, 26) + (l - 1) * DM, modl, 2048, 0};
            if (last || G == 256) run_gemm<MIXD, MIXD, MIXD, NLAT, DM>(lds, MIX, (const bf16*)(ws + WS_WOUT), G, bid, E);
            else run_gemm<MIXD, MIXD, MIXD, MTOK, DM>(lds, MIX, (const bf16*)(ws + WS_WOUT), G, bid, E);
        } break;
        case 10: {
            rows_phase(p, 1, Mtail, inp(p, 20) + l * DM, inp(p, 21) + l * DM, modl, 4096, 3072, gw, ngw, lane);
        } break;
        case 11: {
            EpiSwiglu E{U};
            if (last || G != 256) {
                if (last) run_gemm<DM, DM, DM, NLAT, 2 * DFF>(lds, HA, (const bf16*)(ws + WS_W13), G, bid, E);
                else run_gemm<DM, DM, DM, MTOK, 2 * DFF>(lds, HA, (const bf16*)(ws + WS_W13), G, bid, E);
            } else {
                unsigned* cnt = (unsigned*)(ws + WS_CTL) + CW_GCTX;
                { SchedG S{bid, cnt}; run_gemm_s<DM, DM, DM>(lds, HA, (const bf16*)(ws + WS_W13), MTOK, 2 * DFF, S, E); }
                { SchedHC S{bid, cnt, 176u * (unsigned)(l + 1)}; EpiRes E2{XRES + (size_t)NLAT * DM, XRES + (size_t)NLAT * DM, (const float*)(ws + WS_ST) + 2 * NLAT, inp(p, 20) + l * DM, inp(p, 21) + l * DM, modl, 5120, 64};
                  run_gemm_s<DFF, DFF, DFF>(lds, U + (size_t)NLAT * DFF, (const bf16*)(ws + WS_W2), NCTX, DM, S, E2); }
            }
        } break;
        case 12: {
            EpiRes E{XRES, XRES, (const float*)(ws + WS_ST), inp(p, 20) + l * DM, inp(p, 21) + l * DM, modl, 5120, 0};
            if (last || G == 256) run_gemm<DFF, DFF, DFF, NLAT, DM>(lds, U, (const bf16*)(ws + WS_W2), G, bid, E);
            else run_gemm<DFF, DFF, DFF, MTOK, DM>(lds, U, (const bf16*)(ws + WS_W2), G, bid, E);
        } break;
        }
        __syncthreads();
    }
}

#ifndef MK_SPLIT
#define MK_SPLIT 0
#endif
extern "C" void kernel_launch(void* const* d_in, const int* in_sizes, int n_in, void* d_out, int out_size, void* d_ws, size_t ws_size, hipStream_t stream) {
    static int grid = 0;
    if (grid == 0) {
        if (n_in != 27 || out_size != NLAT * DM || ws_size < WS_END) { fprintf(stderr, "kernel_launch: unexpected shapes / workspace (%d inputs, out %d, ws %zu < %zu)\n", n_in, out_size, ws_size, (size_t)WS_END); grid = -1; return; }
        int dev = 0, cus = 0, per_cu = 0;
        hipGetDevice(&dev);
        hipDeviceGetAttribute(&cus, hipDeviceAttributeMultiprocessorCount, dev);
        hipFuncSetAttribute((const void*)mk_fwd, hipFuncAttributeMaxDynamicSharedMemorySize, LDS_BYTES);
        hipOccupancyMaxActiveBlocksPerMultiprocessor(&per_cu, (const void*)mk_fwd, 512, LDS_BYTES);
        if (per_cu < 1) { fprintf(stderr, "kernel_launch: occupancy query reports %d blocks per CU\n", per_cu); per_cu = 1; }
        grid = cus >= 256 ? 256 : cus;
        (void)hipGetLastError();
    }
    if (grid < 0) return;
    if (hipMemsetAsync((char*)d_ws + WS_CTL, 0, CTL_BYTES, stream) != hipSuccess) { fprintf(stderr, "kernel_launch: memset failed\n"); return; }
    Params p{};
    for (int i = 0; i < 27; ++i) p.in[i] = (const float*)d_in[i];
    p.out = (float*)d_out; p.ws = (unsigned char*)d_ws;
#if MK_SPLIT
    for (int ph = 0; ph < NSTEP; ++ph) {
        p.ph_lo = ph; p.ph_hi = ph + 1;
        void* args[] = {&p};
        hipError_t e = hipLaunchCooperativeKernel((const void*)mk_fwd, dim3(grid), dim3(512), args, LDS_BYTES, stream);
        if (e != hipSuccess) { fprintf(stderr, "cooperative launch failed: %s\n", hipGetErrorString(e)); return; }
    }
#else
    p.ph_lo = 0; p.ph_hi = NSTEP;
    void* args[] = {&p};
    hipError_t e = hipLaunchCooperativeKernel((const void*)mk_fwd, dim3(grid), dim3(512), args, LDS_BYTES, stream);
    if (e != hipSuccess) fprintf(stderr, "cooperative launch failed: %s (grid %d)\n", hipGetErrorString(e), grid);
#endif
}
```

```cpp
#include <hip/hip_runtime.h>
#include <hip/hip_cooperative_groups.h>
#include <cstdio>
#include <cstdint>
namespace cg = cooperative_groups;
__device__ __forceinline__ int otid() { int t = threadIdx.x; asm volatile("" : "+v"(t)); return t; }
namespace pg8 {
#define PG8_LAS __attribute__((address_space(3)))
typedef unsigned short bf16_t;
typedef short bf16x8 __attribute__((ext_vector_type(8)));
typedef float f32x4 __attribute__((ext_vector_type(4)));
typedef unsigned u32x4 __attribute__((ext_vector_type(4)));
constexpr int BM = 256, BK = 64, HALF = 128, HTB = HALF * BK * 2  , STAGE_BYTES = 8 * HTB, NXCD = 8, WGM = 8;

__host__ __device__ __forceinline__ int lds_byte(int r, int c) { const int st = (r >> 4) * 2 + (c >> 5), rr = r & 15, cc = c & 31, ob = rr * 64 + cc * 2; return st * 1024 + (ob ^ (((ob >> 9) & 1) << 5)); }
__host__ __device__ __forceinline__ void stage_rc(int b, int& R, int& C) { const int st = b / 1024, sb = b % 1024, swz = sb ^ (((sb >> 9) & 1) << 5); R = (st >> 1) * 16 + swz / 64; C = (st & 1) * 32 + (swz % 64) / 2; }
__host__ __device__ __forceinline__ int perm32(int rho) { const int n = rho >> 4, i = rho & 15; return 8 * (i >> 2) + 4 * n + (i & 3); }

struct Unit { int pm, pn; };
struct Gemm { const bf16_t* A; const bf16_t* Bt; int M, N; };

struct StaticOrder {
    int nM, nN, nwg, G, c;
    __host__ __device__ void init(int M, int N, int G_, int c_) { nM = M / BM; nN = N / BM; nwg = nM * nN; G = G_; c = c_; }
    __host__ __device__ bool next(int i, Unit& u) const {
        const long L = (long)i * G + c; if (L >= nwg) return false;
        int wgid = (int)L; { const int q = nwg / NXCD, r = nwg % NXCD, xcd = wgid % NXCD, off = wgid / NXCD; wgid = (xcd < r ? xcd * (q + 1) : r * (q + 1) + (xcd - r) * q) + off; }
        const int nig = WGM * nN, gid = wgid / nig, fm = gid * WGM, gsz = (nM - fm) < WGM ? (nM - fm) : WGM;
        u.pm = fm + ((wgid % nig) % gsz); u.pn = (wgid % nig) / gsz; return true;
    }
    __device__ __forceinline__ void a_ready(const Unit&) const {}
    __device__ __forceinline__ void done(const Unit&) const {}
};


template <class Epi, class Sched, bool ALIGN_EPI, bool SP2, int LDA, int LDB, int KDIM>
__device__ __forceinline__ void gemm_phase(PG8_LAS unsigned char* lds, const Gemm g, const Sched& S, const Epi& E) {
    const int tid = otid(), wid = __builtin_amdgcn_readfirstlane(tid >> 6), lane = tid & 63, wr = wid >> 2, wc = wid & 3, fr = lane & 15, fq = lane >> 4;
    constexpr int K = KDIM, nt = K / BK;
    unsigned voffA[2], voffB[2];
#pragma unroll
    for (int i = 0; i < 2; ++i) { int R, C; stage_rc(tid * 16 + i * 8192, R, C); const int Rb = Epi::PERM ? ((R & ~31) + perm32(R & 31)) : R;
        voffA[i] = (unsigned)(R * LDA + C) * 2u; voffB[i] = (unsigned)(Rb * LDB + C) * 2u; }
    constexpr size_t kstep = (size_t)(BK * 2);
    constexpr size_t hstepA = (size_t)HALF * LDA * 2, hstepB = (size_t)HALF * LDB * 2;
    constexpr size_t tstepA = 2 * hstepA, tstepB = 2 * hstepB;
    const unsigned ldsw = (unsigned)wid * 1024u;
    const int aoff = lds_byte(wr * 64 + fr, fq * 8), boff = lds_byte(wc * 32 + fr, fq * 8);
#define PG8_SA(b, h) (((b) * 2 + (h)) * HTB)
#define PG8_SB(b, h) ((4 + (b) * 2 + (h)) * HTB)
#define PG8_STAGE(bufoff, gbase, voff) do { _Pragma("unroll") for (int _i = 0; _i < 2; ++_i) \
        __builtin_amdgcn_global_load_lds((const unsigned*)((const char*)(gbase) + (voff)[_i]), (PG8_LAS unsigned*)(lds + (bufoff) + ldsw + _i * 8192), 16, 0, 0); } while (0)
#define PG8_LDA(dst, b, h) do { _Pragma("unroll") for (int m = 0; m < 4; ++m) _Pragma("unroll") for (int k = 0; k < 2; ++k) dst[m][k] = *(const PG8_LAS bf16x8*)(lds + PG8_SA(b, h) + aoff + m * 2048 + k * 1024); } while (0)
#define PG8_LDB(dst, b, h) do { _Pragma("unroll") for (int n = 0; n < 2; ++n) _Pragma("unroll") for (int k = 0; k < 2; ++k) dst[n][k] = *(const PG8_LAS bf16x8*)(lds + PG8_SB(b, h) + boff + n * 2048 + k * 1024); } while (0)
#define PG8_MMA(ai, bj, At, Bt) do { __builtin_amdgcn_s_setprio(1); _Pragma("unroll") for (int m = 0; m < 4; ++m) _Pragma("unroll") for (int n = 0; n < 2; ++n) _Pragma("unroll") for (int k = 0; k < 2; ++k) \
        acc[ai][bj][m][n] = __builtin_amdgcn_mfma_f32_16x16x32_bf16(Bt[n][k], At[m][k], acc[ai][bj][m][n], 0, 0, 0); __builtin_amdgcn_s_setprio(0); } while (0)
#define PG8_WAIT_V(n) asm volatile("s_waitcnt vmcnt(" #n ")" ::: "memory")
#define PG8_WAIT_L(n) asm volatile("s_waitcnt lgkmcnt(" #n ")" ::: "memory")
#define PG8_BAR __builtin_amdgcn_s_barrier()
#define PG8_SCHED __builtin_amdgcn_sched_barrier(0)
    Unit cur, nxt; int ui = 0;
    if (!S.next(0, cur)) return;
    float zf = 0.f; asm volatile("" : "+v"(zf));
    f32x4 acc[2][2][4][2];
#pragma unroll
    for (int a = 0; a < 2; ++a)
#pragma unroll
        for (int b = 0; b < 2; ++b)
#pragma unroll
            for (int m = 0; m < 4; ++m)
#pragma unroll
                for (int n = 0; n < 2; ++n) acc[a][b][m][n] = (f32x4){zf, zf, zf, zf};
    bf16x8 At[4][2], B0[2][2], B1[2][2];
    const char* cA = (const char*)g.A + (size_t)cur.pm * tstepA; const char* cB = (const char*)g.Bt + (size_t)cur.pn * tstepB;
    S.a_ready(cur);
    if constexpr (SP2) {
        PG8_STAGE(PG8_SB(0, 0), cB, voffB); PG8_STAGE(PG8_SB(0, 1), cB + hstepB, voffB); PG8_STAGE(PG8_SA(0, 0), cA, voffA); PG8_STAGE(PG8_SA(0, 1), cA + hstepA, voffA);
        if (wr == 1) PG8_BAR;
        PG8_WAIT_V(2); PG8_BAR;
        PG8_STAGE(PG8_SB(1, 0), cB + kstep, voffB); PG8_STAGE(PG8_SA(1, 0), cA + kstep, voffA); PG8_STAGE(PG8_SB(1, 1), cB + hstepB + kstep, voffB);
        PG8_WAIT_V(6); PG8_BAR;
    } else {
        PG8_STAGE(PG8_SB(0, 0), cB, voffB); PG8_STAGE(PG8_SA(0, 0), cA, voffA); PG8_STAGE(PG8_SB(0, 1), cB + hstepB, voffB); PG8_STAGE(PG8_SA(0, 1), cA + hstepA, voffA);
        if (wr == 1) PG8_BAR;
        PG8_WAIT_V(4); PG8_BAR;
        PG8_STAGE(PG8_SB(1, 0), cB + kstep, voffB); PG8_STAGE(PG8_SA(1, 0), cA + kstep, voffA); PG8_STAGE(PG8_SB(1, 1), cB + hstepB + kstep, voffB);
        PG8_WAIT_V(6); PG8_BAR;
    }
    for (;;) {
        const bool has_next = S.next(ui + 1, nxt);
        const char* nA = has_next ? (const char*)g.A + (size_t)nxt.pm * tstepA : cA; const char* nB = has_next ? (const char*)g.Bt + (size_t)nxt.pn * tstepB : cB;
#pragma nounroll
        for (int t = 0; t < nt; t += 2) {
            const bool last = (t == nt - 2);
            const char* a1 = cA + (size_t)(t + 1) * kstep;
            const char* a2 = last ? nA : cA + (size_t)(t + 2) * kstep; const char* b2 = last ? nB : cB + (size_t)(t + 2) * kstep;
            const char* a3 = a2 + kstep; const char* b3 = b2 + kstep;
            if (last && has_next) S.a_ready(nxt);
            if constexpr (SP2) {
            PG8_LDB(B0, 0, 0); PG8_LDB(B1, 0, 1); PG8_SCHED; PG8_LDA(At, 0, 0); PG8_STAGE(PG8_SA(1, 1), a1 + hstepA, voffA);
            PG8_WAIT_V(8); PG8_WAIT_L(0); PG8_BAR; PG8_MMA(0, 0, At, B0); PG8_MMA(0, 1, At, B1); PG8_BAR; PG8_SCHED;
            PG8_LDA(At, 0, 1); PG8_STAGE(PG8_SB(0, 0), b2, voffB); PG8_STAGE(PG8_SB(0, 1), b2 + hstepB, voffB); PG8_STAGE(PG8_SA(0, 0), a2, voffA);
            PG8_WAIT_V(8); PG8_WAIT_L(0); PG8_BAR; PG8_MMA(1, 0, At, B0); PG8_MMA(1, 1, At, B1); PG8_BAR; PG8_SCHED;
            PG8_LDB(B0, 1, 0); PG8_LDB(B1, 1, 1); PG8_SCHED; PG8_LDA(At, 1, 0); PG8_STAGE(PG8_SA(0, 1), a2 + hstepA, voffA);
            PG8_WAIT_V(8); PG8_WAIT_L(0); PG8_BAR; PG8_MMA(0, 0, At, B0); PG8_MMA(0, 1, At, B1); PG8_BAR; PG8_SCHED;
            PG8_LDA(At, 1, 1); PG8_STAGE(PG8_SB(1, 0), b3, voffB); PG8_STAGE(PG8_SB(1, 1), b3 + hstepB, voffB); PG8_STAGE(PG8_SA(1, 0), a3, voffA);
            PG8_WAIT_V(8); PG8_WAIT_L(0); PG8_BAR; PG8_MMA(1, 0, At, B0); PG8_MMA(1, 1, At, B1); PG8_BAR; PG8_SCHED;
            } else {
            PG8_LDB(B0, 0, 0); PG8_SCHED; PG8_LDA(At, 0, 0); PG8_STAGE(PG8_SA(1, 1), a1 + hstepA, voffA);
            PG8_WAIT_L(8); PG8_BAR; PG8_WAIT_L(0); PG8_MMA(0, 0, At, B0); PG8_BAR; PG8_SCHED;
            PG8_LDB(B1, 0, 1); PG8_STAGE(PG8_SB(0, 0), b2, voffB);
            PG8_BAR; PG8_WAIT_L(0); PG8_MMA(0, 1, At, B1); PG8_BAR;
            PG8_LDA(At, 0, 1); PG8_STAGE(PG8_SA(0, 0), a2, voffA);
            PG8_BAR; PG8_WAIT_L(0); PG8_MMA(1, 0, At, B0); PG8_BAR; PG8_SCHED;
            PG8_STAGE(PG8_SB(0, 1), b2 + hstepB, voffB);
            PG8_WAIT_V(6); PG8_BAR; PG8_MMA(1, 1, At, B1); PG8_BAR;
            PG8_LDB(B0, 1, 0); PG8_SCHED; PG8_LDA(At, 1, 0); PG8_STAGE(PG8_SA(0, 1), a2 + hstepA, voffA);
            PG8_WAIT_L(8); PG8_BAR; PG8_WAIT_L(0); PG8_MMA(0, 0, At, B0); PG8_BAR; PG8_SCHED;
            PG8_LDB(B1, 1, 1); PG8_STAGE(PG8_SB(1, 0), b3, voffB);
            PG8_BAR; PG8_WAIT_L(0); PG8_MMA(0, 1, At, B1); PG8_BAR;
            PG8_LDA(At, 1, 1); PG8_STAGE(PG8_SA(1, 0), a3, voffA);
            PG8_BAR; PG8_WAIT_L(0); PG8_MMA(1, 0, At, B0); PG8_BAR; PG8_SCHED;
            PG8_STAGE(PG8_SB(1, 1), b3 + hstepB, voffB);
            PG8_WAIT_V(6); PG8_BAR; PG8_MMA(1, 1, At, B1); PG8_BAR;
            }
        }
        if constexpr (ALIGN_EPI) { if (wr == 0) PG8_BAR; }
        if constexpr (!Epi::AFTER_DRAIN) { int fr2 = fr, fq2 = fq; asm volatile("" : "+v"(fr2), "+v"(fq2));
            E(acc, cur, wr, wc, fr2, fq2); S.done(cur); }
        if (!has_next) break;
#pragma unroll
        for (int a = 0; a < 2; ++a)
#pragma unroll
            for (int b = 0; b < 2; ++b)
#pragma unroll
                for (int m = 0; m < 4; ++m)
#pragma unroll
                    for (int n = 0; n < 2; ++n) acc[a][b][m][n] = (f32x4){zf, zf, zf, zf};
        cur = nxt; cA = nA; cB = nB; ++ui;
        if constexpr (ALIGN_EPI) { if (wr == 1) PG8_BAR; }
    }
    PG8_WAIT_V(0);
    if constexpr (!ALIGN_EPI) { if (wr == 0) PG8_BAR; }
    PG8_BAR;
    if constexpr (Epi::AFTER_DRAIN) { E.fused(acc, cur, wr, wc, fr, fq, lds, wid, lane); S.done(cur); }
#undef PG8_SA
#undef PG8_SB
#undef PG8_STAGE
#undef PG8_LDA
#undef PG8_LDB
#undef PG8_MMA
#undef PG8_WAIT_V
#undef PG8_WAIT_L
#undef PG8_BAR
#undef PG8_SCHED
}
}

#define LAS __attribute__((address_space(3)))
typedef unsigned short bf16;
typedef float f32x2 __attribute__((ext_vector_type(2)));
typedef float f32x4 __attribute__((ext_vector_type(4)));
typedef float f32x16 __attribute__((ext_vector_type(16)));
typedef short bf16x8 __attribute__((ext_vector_type(8)));
typedef unsigned u32x4 __attribute__((ext_vector_type(4)));
typedef unsigned u32x2 __attribute__((ext_vector_type(2)));
typedef __bf16 bf16x2_t __attribute__((ext_vector_type(2)));
#define DI __device__ __forceinline__

DI unsigned pk2(float lo, float hi) { f32x2 v = {lo, hi}; bf16x2_t b = __builtin_convertvector(v, bf16x2_t); return __builtin_bit_cast(unsigned, b); }
DI float bflo(unsigned u) { return __uint_as_float(u << 16); }
DI float bfhi(unsigned u) { return __uint_as_float(u & 0xffff0000u); }
DI u32x4 pack8(f32x4 a, f32x4 b) { u32x4 w; w.x = pk2(a[0], a[1]); w.y = pk2(a[2], a[3]); w.z = pk2(b[0], b[1]); w.w = pk2(b[2], b[3]); return w; }
DI float shx(float v, int m) { const int l = (otid() & 63) ^ m; return __builtin_bit_cast(float, __builtin_amdgcn_ds_bpermute(l << 2, __builtin_bit_cast(int, v))); }
DI float wave_sum(float v) {
#pragma unroll
    for (int o = 1; o < 64; o <<= 1) v += shx(v, o);
    return v;
}
DI float ozero() { float z = 0.f; asm volatile("" : "+v"(z)); return z; }
DI float cos_turn(float t) { return __builtin_amdgcn_cosf(t); }
DI float sin_turn(float t) { return __builtin_amdgcn_sinf(t); }
DI float fexp2(float x) { return __builtin_amdgcn_exp2f(x); }
DI float frcp(float x) { return __builtin_amdgcn_rcpf(x); }
#define LDS_WAIT() asm volatile("s_waitcnt lgkmcnt(0)" ::: "memory")

constexpr int DM = 1024, NB = 8, SEQ = 2048, DEPTH = 4, CTXL = 256;
constexpr int NLAT = NB * SEQ, NCTX = NB * CTXL, MTOK = NLAT + NCTX;
constexpr int NPROJ = 1536, DFF = 2816, MIXD = 1280, NKEY = SEQ + CTXL;
constexpr int PO_KR = 384, PO_SU = 416, PO_SV = 672, PO_POOL = 928, PO_F = 1184, IN_DIM = 1440;
constexpr float LN_EPS = 1e-6f;
constexpr float ALPHA = 1.6817928305074290f;
constexpr float QSCALE = 0.10206207261596575f * 1.4426950408889634f;

constexpr size_t WS_XRES = 0;
constexpr size_t WS_HA   = WS_XRES + (size_t)MTOK * DM * 4;
constexpr size_t WS_PROJ = WS_HA + (size_t)MTOK * DM * 2;
constexpr size_t WS_QLAT = WS_PROJ + (size_t)MTOK * NPROJ * 2;
constexpr size_t WS_QCTX = WS_QLAT + (size_t)64 * SEQ * 96 * 2;
constexpr size_t WS_K    = WS_QCTX + (size_t)64 * CTXL * 96 * 2;
constexpr size_t WS_VT   = WS_K + (size_t)64 * NKEY * 96 * 2;
constexpr size_t WS_U    = WS_PROJ;
static_assert((size_t)MTOK * DFF * 2 <= WS_VT - WS_PROJ, "U overlay");
constexpr size_t WS_GTL  = WS_VT + (size_t)64 * 64 * NKEY * 2;
constexpr size_t WS_GTC  = WS_GTL + (size_t)2048 * 4096 * 2;
constexpr size_t WS_MIX  = WS_GTC + (size_t)2048 * 512 * 2;
constexpr size_t WS_WIN  = WS_MIX + (size_t)MTOK * MIXD * 2;
constexpr size_t WS_WQK  = WS_WIN + (size_t)1536 * 1024 * 2;
constexpr size_t WS_WV   = WS_WQK + (size_t)1280 * 384 * 2;
constexpr size_t WS_WF   = WS_WV + (size_t)512 * 384 * 2;
constexpr size_t WS_WOUT = WS_WF + (size_t)512 * 256 * 2;
constexpr size_t WS_W13  = WS_WOUT + (size_t)1024 * 1280 * 2;
constexpr size_t WS_W2   = WS_W13 + (size_t)5632 * 1024 * 2;
constexpr size_t WS_WPOOL= WS_W2 + (size_t)1024 * 2816 * 2;
constexpr size_t WS_WS   = WS_WPOOL + (size_t)4 * 64 * 64 * 2;
constexpr size_t WS_CSL  = WS_WS + (size_t)4 * 128 * 128 * 2;
constexpr size_t WS_CSC  = WS_CSL + (size_t)2048 * 4096 * 2;
constexpr size_t WS_MOD  = WS_CSC + (size_t)256 * 512 * 2;
constexpr size_t WS_ROPE = WS_MOD + (size_t)4 * 9 * 6144 * 4;
constexpr size_t WS_STQ  = WS_ROPE + (size_t)2048 * 32 * 4;
constexpr size_t WS_STKV = WS_STQ + (size_t)MTOK * 4 * 4;
constexpr size_t WS_ST   = WS_STKV + (size_t)MTOK * 4 * 4;
constexpr size_t WS_CTL  = WS_ST + (size_t)MTOK * 2 * 4;
constexpr size_t CTL_BYTES = 16384;
constexpr size_t WS_END  = WS_CTL + CTL_BYTES;
constexpr int MISC_OFF = 139264;

constexpr int LDS_BYTES = 147456;

struct Params { const float* in[27]; float* out; unsigned char* ws; int ph_lo, ph_hi; };
DI const float* inp(const Params& p, int i) { asm volatile("" : "+s"(i)); return p.in[i]; }
DI unsigned char* wsp(const Params& p) { unsigned char* w = p.ws; asm volatile("" : "+s"(w)); return w; }

#define XB_TMO      128
#define XB_XCNT(j)  (256  + 64 * (j))
#define XB_XSUB(j)  (1280 + 64 * (j))
#define XB_XGEN(j)  (2304 + 64 * (j))
#define XB_TOP      3328
#define XB_TOPGEN   3392
#define XCD_BAR_WORDS 3456
#define XB_SPIN_CAP (1u << 18)

__device__ __forceinline__ unsigned xb_ld(unsigned* p)              { return __hip_atomic_load(p, __ATOMIC_RELAXED, __HIP_MEMORY_SCOPE_AGENT); }
__device__ __forceinline__ unsigned xb_add(unsigned* p, unsigned v) { return __hip_atomic_fetch_add(p, v, __ATOMIC_RELAXED, __HIP_MEMORY_SCOPE_AGENT); }
__device__ __forceinline__ unsigned xb_xcc_id() { return (unsigned)__builtin_amdgcn_s_getreg((3 << 11) | 20) & 0xFu; }
#define XB_SPIN(cond, bar) do { unsigned _sp = 0; while (cond) { __builtin_amdgcn_s_sleep(1); \
    if ((++_sp & 255u) == 0u) { if (xb_ld(&(bar)[XB_TMO])) break; if (_sp > XB_SPIN_CAP) { atomicAdd(&(bar)[XB_TMO], 1u); break; } } } } while (0)

struct XcdBarrier {
    unsigned* bar; unsigned x;
    volatile LAS unsigned* st;
};

__device__ __forceinline__ XcdBarrier xcd_barrier_post(unsigned* bar, volatile LAS unsigned* st) {
    XcdBarrier b; b.bar = bar; b.x = xb_xcc_id(); b.st = st;
    if (threadIdx.x == 0) (void)xb_add(&bar[XB_XCNT(b.x)], 1u);
    return b;
}
__device__ __forceinline__ void xcd_barrier_complete(unsigned* bar, unsigned x, unsigned& nloc, unsigned& nx) {
    const unsigned G = gridDim.x * gridDim.y * gridDim.z;
    unsigned sum, cnt, mine, sp = 0u;
    for (;;) {
        sum = 0u; cnt = 0u; mine = 0u;
#pragma unroll
        for (unsigned j = 0; j < 16; ++j) { const unsigned c = xb_ld(&bar[XB_XCNT(j)]); sum += c; cnt += (c > 0u) ? 1u : 0u; mine = (j == x) ? c : mine; }
        if (sum == G) break;
        __builtin_amdgcn_s_sleep(1);
        if ((++sp & 255u) == 0u) { if (xb_ld(&bar[XB_TMO])) break; if (sp > XB_SPIN_CAP) { atomicAdd(&bar[XB_TMO], 1u); break; } }
    }
    nloc = mine > 0u ? mine : 1u; nx = cnt > 0u ? cnt : 1u;
}

__device__ __forceinline__ void xcd_barrier(const XcdBarrier& b) {
    asm volatile("s_waitcnt vmcnt(0)" ::: "memory");
    __syncthreads();
    if (threadIdx.x == 0) {
        unsigned* bar = b.bar;
        __builtin_amdgcn_s_waitcnt(0);
        unsigned nloc = b.st[0], nx = b.st[1];
        if (nloc == 0u) { xcd_barrier_complete(bar, b.x, nloc, nx); b.st[0] = nloc; b.st[1] = nx; }
        const unsigned old = xb_add(&bar[XB_XSUB(b.x)], 1u);
        const unsigned gen = old / nloc;
        if (old + 1u == (gen + 1u) * nloc) {
            __builtin_amdgcn_fence(__ATOMIC_RELEASE, "agent");
            asm volatile("s_waitcnt vmcnt(0)" ::: "memory");
            const unsigned og = xb_add(&bar[XB_TOP], 1u);
            const unsigned tg = og / nx;
            if (og + 1u == (tg + 1u) * nx) xb_add(&bar[XB_TOPGEN], 1u);
            else XB_SPIN(xb_ld(&bar[XB_TOPGEN]) == tg, bar);
            __builtin_amdgcn_fence(__ATOMIC_ACQUIRE, "agent");
            xb_add(&bar[XB_XGEN(b.x)], 1u);
            asm volatile("s_waitcnt vmcnt(0)" ::: "memory");
        } else {
            XB_SPIN(xb_ld(&bar[XB_XGEN(b.x)]) == gen, bar);
            __builtin_amdgcn_fence(__ATOMIC_ACQUIRE, "agent");
            asm volatile("s_waitcnt vmcnt(0)" ::: "memory");
        }
    }
    __syncthreads();
}

typedef pg8::f32x4 A4;
DI void row_info(int row, int& b, int& pos, bool& lat) { lat = row < NLAT; if (lat) { b = row >> 11; pos = row & 2047; } else { b = (row - NLAT) >> 8; pos = (row - NLAT) & 255; } }

struct EpiProj {
    static constexpr bool PERM = true, AFTER_DRAIN = false;
    bf16* O; float* statq; float* statkv;
    DI void operator()(const A4 (&acc)[2][2][4][2], const pg8::Unit& u, int wr, int wc, int fr, int fq) const {
        const int row0 = u.pm * 256 + wr * 64 + fr, col0 = u.pn * 256 + wc * 32 + 8 * fq;
#pragma unroll
        for (int ai = 0; ai < 2; ++ai)
#pragma unroll
            for (int m = 0; m < 4; ++m) {
                const int row = row0 + ai * 128 + m * 16;
                bf16* rowp = O + (size_t)row * NPROJ + col0;
#pragma unroll
                for (int bj = 0; bj < 2; ++bj) *(u32x4*)(rowp + bj * 128) = pack8(acc[ai][bj][m][0], acc[ai][bj][m][1]);
                if (u.pn <= 1) {
                    float s = 0.f;
#pragma unroll
                    for (int bj = 0; bj < 2; ++bj) {
                        if (u.pn == 1 && bj == 1) continue;
#pragma unroll
                        for (int n = 0; n < 2; ++n) { const A4 x = acc[ai][bj][m][n]; s += (x[0] * x[0] + x[1] * x[1]) + (x[2] * x[2] + x[3] * x[3]); }
                    }
                    s += shx(s, 16); s += shx(s, 32);
                    if (fq == 0) { if (u.pn == 0) statq[row * 4 + wc] = s; else statkv[row * 4 + wc] = s; }
                }
            }
    }
};

struct EpiQK {
    static constexpr bool PERM = true, AFTER_DRAIN = false;
    bf16* Ql; bf16* Qc; bf16* Kb; const float* statq; const float* statkv; const float* rope;
    DI void operator()(const A4 (&acc)[2][2][4][2], const pg8::Unit& u, int wr, int wc, int fr, int fq) const {
        const int row0 = u.pm * 256 + wr * 64 + fr, col0 = u.pn * 256 + wc * 32 + 8 * fq;
        const bool isq = u.pn < 3;
#pragma unroll
        for (int ai = 0; ai < 2; ++ai)
#pragma unroll
            for (int m = 0; m < 4; ++m) {
                const int row = row0 + ai * 128 + m * 16;
                int b, pos; bool lat; row_info(row, b, pos, lat);
                const f32x4 st = *(const f32x4*)((isq ? statq : statkv) + row * 4);
                const float ss = (st[0] + st[1]) + (st[2] + st[3]);
                const float rs = isq ? rsqrtf(ss * (1.f / 256.f) + LN_EPS) * QSCALE : rsqrtf(ss * (1.f / 128.f) + LN_EPS);
#pragma unroll
                for (int bj = 0; bj < 2; ++bj) {
                    const int c = col0 + bj * 128;
                    A4 v0 = acc[ai][bj][m][0] * rs, v1 = acc[ai][bj][m][1] * rs;
                    if (isq) {
                        const int g32 = c >> 5, head = g32 / 3, part = g32 - head * 3, d0 = part * 32 + 8 * fq;
                        if (part == 2 && lat) {
                            A4 p0, p1;
#pragma unroll
                            for (int j = 0; j < 4; ++j) { p0[j] = shx(v0[j], 16); p1[j] = shx(v1[j], 16); }
                            const float* rp = rope + pos * 32 + (fq >> 1) * 8;
                            const f32x4 c0 = *(const f32x4*)rp, c1 = *(const f32x4*)(rp + 4), s0 = *(const f32x4*)(rp + 16), s1 = *(const f32x4*)(rp + 20);
                            if (fq & 1) { v0 = p0 * s0 + v0 * c0; v1 = p1 * s1 + v1 * c1; }
                            else        { v0 = v0 * c0 - p0 * s0; v1 = v1 * c1 - p1 * s1; }
                        }
                        bf16* dst = lat ? Ql + ((size_t)(b * 8 + head) * SEQ + pos) * 96 + d0 : Qc + ((size_t)(b * 8 + head) * CTXL + pos) * 96 + d0;
                        *(u32x4*)dst = pack8(v0, v1);
                    } else {
                        const int cc = c - 768, head = cc >> 6, d0 = cc & 63;
                        bf16* dst = Kb + ((size_t)(b * 8 + head) * NKEY + (lat ? CTXL + pos : pos)) * 96 + d0;
                        *(u32x4*)dst = pack8(v0, v1);
                    }
                }
            }
    }
};

DI float rstd_kv_tok(const float* statkv, int t) { const f32x4 st = *(const f32x4*)(statkv + t * 4); return rsqrtf(((st[0] + st[1]) + (st[2] + st[3])) * (1.f / 128.f) + LN_EPS); }

struct EpiVt {
    static constexpr bool PERM = true, AFTER_DRAIN = false;
    bf16* Vt; const float* statkv;
    DI void operator()(const A4 (&acc)[2][2][4][2], const pg8::Unit& u, int wr, int wc, int fr, int fq) const {
        const int row0 = u.pm * 256 + wr * 64 + fr, col0 = u.pn * 256 + wc * 32 + 8 * fq;
#pragma unroll
        for (int bj = 0; bj < 2; ++bj) {
            const int t0 = col0 + bj * 128;
            int b, pos; bool lat; row_info(t0, b, pos, lat);
            A4 r0, r1;
#pragma unroll
            for (int j = 0; j < 4; ++j) { r0[j] = rstd_kv_tok(statkv, t0 + j); r1[j] = rstd_kv_tok(statkv, t0 + 4 + j); }
#pragma unroll
            for (int ai = 0; ai < 2; ++ai)
#pragma unroll
                for (int m = 0; m < 4; ++m) {
                    const int row = row0 + ai * 128 + m * 16, head = row >> 6, dv = row & 63;
                    bf16* dst = Vt + ((size_t)(b * 8 + head) * 64 + dv) * NKEY + (lat ? CTXL + pos : pos);
                    *(u32x4*)dst = pack8(acc[ai][bj][m][0] * r0, acc[ai][bj][m][1] * r1);
                }
        }
    }
};

struct EpiGt {
    static constexpr bool PERM = true, AFTER_DRAIN = false;
    bf16* Gl; bf16* Gc;
    DI void operator()(const A4 (&acc)[2][2][4][2], const pg8::Unit& u, int wr, int wc, int fr, int fq) const {
        const int row0 = u.pm * 256 + wr * 64 + fr, col0 = u.pn * 256 + wc * 32 + 8 * fq;
#pragma unroll
        for (int bj = 0; bj < 2; ++bj) {
            const int t0 = col0 + bj * 128;
            int b, pos; bool lat; row_info(t0, b, pos, lat);
#pragma unroll
            for (int ai = 0; ai < 2; ++ai)
#pragma unroll
                for (int m = 0; m < 4; ++m) {
                    const int row = row0 + ai * 128 + m * 16, n = row & 255, half = row >> 8;
                    bf16* dst = lat ? Gl + (size_t)(b * 256 + n) * 4096 + half * 2048 + pos : Gc + (size_t)(b * 256 + n) * 512 + half * 256 + pos;
                    *(u32x4*)dst = pack8(acc[ai][bj][m][0], acc[ai][bj][m][1]);
                }
        }
    }
};

struct EpiDft {
    static constexpr bool PERM = true, AFTER_DRAIN = false;
    bf16* mix; int row_base, rows_per_b;
    DI void operator()(const A4 (&acc)[2][2][4][2], const pg8::Unit& u, int wr, int wc, int fr, int fq) const {
        const int row0 = u.pm * 256 + wr * 64 + fr, n0 = wc * 32 + 8 * fq;
#pragma unroll
        for (int ai = 0; ai < 2; ++ai)
#pragma unroll
            for (int m = 0; m < 4; ++m) {
                const int k = row0 + ai * 128 + m * 16;
                bf16* rowp = mix + (size_t)(row_base + u.pn * rows_per_b + k) * MIXD + 1024 + n0;
#pragma unroll
                for (int bj = 0; bj < 2; ++bj) *(u32x4*)(rowp + bj * 128) = pack8(acc[ai][bj][m][0], acc[ai][bj][m][1]);
            }
    }
};

struct EpiRes {
    static constexpr bool PERM = true, AFTER_DRAIN = false;
    const float* Xin; float* Xout; const float* ST; const float* lg; const float* lb; const float* modl; int goff; int pm_off;
    DI void operator()(const A4 (&acc)[2][2][4][2], const pg8::Unit& u, int wr, int wc, int fr, int fq) const {
        const int row0 = u.pm * 256 + wr * 64 + fr, col0 = u.pn * 256 + wc * 32 + 8 * fq;
        const int bidx = (u.pm + pm_off < 64) ? ((u.pm + pm_off) >> 3) : 8;
        const float* gp = modl + bidx * 6144 + goff + col0;
        const bool has_ln = lg != nullptr;
#pragma unroll
        for (int bj = 0; bj < 2; ++bj) {
            const f32x4 g0 = *(const f32x4*)(gp + bj * 128), g1 = *(const f32x4*)(gp + bj * 128 + 4);
            f32x4 ga0 = (f32x4){ALPHA, ALPHA, ALPHA, ALPHA}, ga1 = ga0, be0 = (f32x4){0.f, 0.f, 0.f, 0.f}, be1 = be0;
            if (has_ln) { ga0 = *(const f32x4*)(lg + col0 + bj * 128) * ALPHA; ga1 = *(const f32x4*)(lg + col0 + bj * 128 + 4) * ALPHA;
                          be0 = *(const f32x4*)(lb + col0 + bj * 128) * ALPHA; be1 = *(const f32x4*)(lb + col0 + bj * 128 + 4) * ALPHA; }
            f32x4 x0[8], x1[8]; f32x2 st[8];
#define EPR_ROW(q) (row0 + ((q) >> 2) * 128 + ((q) & 3) * 16)
#define EPR_LOAD(q) do { const float* rin = Xin + (size_t)EPR_ROW(q) * DM + col0 + bj * 128; x0[q] = *(const f32x4*)rin; x1[q] = *(const f32x4*)(rin + 4); \
                         st[q] = has_ln ? *(const f32x2*)(ST + 2 * EPR_ROW(q)) : (f32x2){0.f, 1.f}; } while (0)
            EPR_LOAD(0); EPR_LOAD(1);
#pragma unroll
            for (int q = 0; q < 8; ++q) {
                if (q + 2 < 8) EPR_LOAD(q + 2);
                float* rout = Xout + (size_t)EPR_ROW(q) * DM + col0 + bj * 128;
                *(f32x4*)rout = (x0[q] - st[q][0]) * st[q][1] * ga0 + be0 + g0 * acc[q >> 2][bj][q & 3][0];
                *(f32x4*)(rout + 4) = (x1[q] - st[q][0]) * st[q][1] * ga1 + be1 + g1 * acc[q >> 2][bj][q & 3][1];
                __builtin_amdgcn_sched_barrier(0);
            }
#undef EPR_LOAD
#undef EPR_ROW
        }
    }
};

DI f32x4 silu4(f32x4 a) { f32x4 r; for (int j = 0; j < 4; ++j) r[j] = a[j] * frcp(1.f + fexp2(-1.4426950408889634f * a[j])); return r; }
struct EpiSwiglu {
    static constexpr bool PERM = true, AFTER_DRAIN = false;
    bf16* U;
    DI void operator()(const A4 (&acc)[2][2][4][2], const pg8::Unit& u, int wr, int wc, int fr, int fq) const {
        const int row0 = u.pm * 256 + wr * 64 + fr, col0 = u.pn * 128 + wc * 32 + 8 * fq;
#pragma unroll
        for (int ai = 0; ai < 2; ++ai)
#pragma unroll
            for (int m = 0; m < 4; ++m) {
                const f32x4 h0 = silu4(acc[ai][0][m][0]) * acc[ai][1][m][0], h1 = silu4(acc[ai][0][m][1]) * acc[ai][1][m][1];
                *(u32x4*)(U + (size_t)(row0 + ai * 128 + m * 16) * DFF + col0) = pack8(h0, h1);
            }
    }
};

template <int M, int N> struct StaticOrderT {
    static constexpr int nM = M / 256, nN = N / 256, nwg = nM * nN;
    int G, c;
    static DI void map(int L, pg8::Unit& u) {
        int wgid = L; { constexpr int q = nwg / 8, r = nwg % 8; const int xcd = wgid % 8, off = wgid / 8; wgid = (xcd < r ? xcd * (q + 1) : r * (q + 1) + (xcd - r) * q) + off; }
        constexpr int nig = 8 * nN; const int gid = wgid / nig, fm = gid * 8, gsz = (nM - fm) < 8 ? (nM - fm) : 8;
        if constexpr (nM % 8 == 0) { u.pm = fm + ((wgid % nig) & 7); u.pn = (wgid % nig) >> 3; }
        else { u.pm = fm + ((wgid % nig) % gsz); u.pn = (wgid % nig) / gsz; }
    }
    DI bool next(int i, pg8::Unit& u) const { const int L = i * G + c; if (L >= nwg) return false; map(L, u); return true; }
    DI void a_ready(const pg8::Unit&) const {}
    DI void done(const pg8::Unit&) const {}
};
constexpr int CW_GCTX = 3584;
struct SchedG {
    int c; unsigned* cnt;
    DI bool next(int i, pg8::Unit& u) const {
        int L;
        if (c < 224) { L = c + 224 * i; if (L >= 1456) return false; }
        else { if (i >= 4) return false; L = 1456 + (c - 224) + 32 * i; }
        if (L < 176) { u.pm = 64 + (L & 7); u.pn = L >> 3; }
        else StaticOrderT<NLAT, 2 * DFF>::map(L - 176, u);
        return true;
    }
    DI void a_ready(const pg8::Unit&) const {}
    DI void done(const pg8::Unit& u) const {
        if (u.pm >= 64) {
            asm volatile("s_waitcnt vmcnt(0)" ::: "memory");
            __syncthreads();
            if (otid() == 0) { __builtin_amdgcn_fence(__ATOMIC_RELEASE, "agent"); asm volatile("s_waitcnt vmcnt(0)" ::: "memory"); (void)xb_add(cnt, 1u); }
        }
    }
};
constexpr int CW_ECTX = 3648;
DI void publish_block(unsigned* cnt) {
    asm volatile("s_waitcnt vmcnt(0)" ::: "memory");
    __syncthreads();
    if (otid() == 0) { __builtin_amdgcn_fence(__ATOMIC_RELEASE, "agent"); asm volatile("s_waitcnt vmcnt(0)" ::: "memory"); (void)xb_add(cnt, 1u); }
}
template <int M, int N> struct StaticOrderSig {
    int G, c; unsigned* cnt;
    DI bool next(int i, pg8::Unit& u) const { const int L = i * G + c; if (L >= StaticOrderT<M, N>::nwg) return false; StaticOrderT<M, N>::map(L, u); return true; }
    DI void a_ready(const pg8::Unit&) const {}
    DI void done(const pg8::Unit&) const { publish_block(cnt); }
};
struct SchedHC {
    int c; unsigned* cnt; unsigned target;
    DI bool next(int i, pg8::Unit& u) const { if (i > 0 || c < 224 || c >= 256) return false; const int k = c - 224; u.pm = k & 7; u.pn = k >> 3; return true; }
    DI void a_ready(const pg8::Unit&) const {
        if (otid() == 0) { unsigned sp = 0; while (xb_ld(cnt) < target) { __builtin_amdgcn_s_sleep(1); if (++sp > (1u << 22)) break; }
            __builtin_amdgcn_fence(__ATOMIC_ACQUIRE, "agent"); asm volatile("s_waitcnt vmcnt(0)" ::: "memory"); }
        __syncthreads();
    }
    DI void done(const pg8::Unit&) const {}
};
template <int LDA, int LDB, int KDIM, class Sched, class Epi> DI void run_gemm_s(LAS unsigned char* lds, const bf16* A, const bf16* Bt, int M, int N, const Sched& S, const Epi& E) {
    pg8::Gemm g{A, Bt, M, N};
    pg8::gemm_phase<Epi, Sched, true, true, LDA, LDB, KDIM>(lds, g, S, E);
    __syncthreads();
}
template <int LDA, int LDB, int KDIM, int M, int N, class Epi> DI void run_gemm(LAS unsigned char* lds, const bf16* A, const bf16* Bt, int G, int c, const Epi& E) {
    pg8::Gemm g{A, Bt, M, N};
    StaticOrderT<M, N> S; S.G = G; S.c = c;
    pg8::gemm_phase<Epi, StaticOrderT<M, N>, true, true, LDA, LDB, KDIM>(lds, g, S, E);
    __syncthreads();
}

template <int NR> DI void row_pass_n(const float* const (&src)[NR], const float* lg, const float* lb, float* const (&dstx)[NR], bf16* const (&dsth)[NR],
                                     const float* const (&sc)[NR], const float* const (&sh)[NR], float* const (&stat)[NR], bool has_stat, bool has_x, bool has_h, int lane) {
    f32x4 v[NR][4]; float s[NR];
#pragma unroll
    for (int r = 0; r < NR; ++r) { const f32x4* xr = (const f32x4*)src[r] + lane; s[r] = 0.f;
#pragma unroll
        for (int j = 0; j < 4; ++j) { v[r][j] = xr[64 * j]; } }
    if (lg) {
#pragma unroll
        for (int r = 0; r < NR; ++r)
#pragma unroll
            for (int j = 0; j < 4; ++j) s[r] += (v[r][j][0] + v[r][j][1]) + (v[r][j][2] + v[r][j][3]);
#pragma unroll
        for (int o = 1; o < 64; o <<= 1)
#pragma unroll
            for (int r = 0; r < NR; ++r) s[r] += shx(s[r], o);
        float s2[NR];
#pragma unroll
        for (int r = 0; r < NR; ++r) { const float mean = s[r] * (1.f / DM); s2[r] = 0.f;
#pragma unroll
            for (int j = 0; j < 4; ++j) { v[r][j] = v[r][j] - mean; s2[r] += (v[r][j][0] * v[r][j][0] + v[r][j][1] * v[r][j][1]) + (v[r][j][2] * v[r][j][2] + v[r][j][3] * v[r][j][3]); } }
#pragma unroll
        for (int o = 1; o < 64; o <<= 1)
#pragma unroll
            for (int r = 0; r < NR; ++r) s2[r] += shx(s2[r], o);
#pragma unroll
        for (int j = 0; j < 4; ++j) { const f32x4 gg = ((const f32x4*)lg)[lane + 64 * j], bb = ((const f32x4*)lb)[lane + 64 * j];
#pragma unroll
            for (int r = 0; r < NR; ++r) { const float rstd = rsqrtf(s2[r] * (1.f / DM) + LN_EPS); v[r][j] = v[r][j] * rstd * gg + bb; } }
        if (has_stat) {
#pragma unroll
            for (int r = 0; r < NR; ++r) if (lane == 0) { f32x2 st2; st2[0] = s[r] * (1.f / DM); st2[1] = rsqrtf(s2[r] * (1.f / DM) + LN_EPS); *(f32x2*)stat[r] = st2; }
        }
    }
    if (has_x) {
#pragma unroll
        for (int r = 0; r < NR; ++r)
#pragma unroll
            for (int j = 0; j < 4; ++j) ((f32x4*)dstx[r])[lane + 64 * j] = v[r][j];
    }
    if (has_h) {
#pragma unroll
        for (int r = 0; r < NR; ++r)
#pragma unroll
            for (int j = 0; j < 4; ++j) {
                const f32x4 a = ((const f32x4*)sc[r])[lane + 64 * j], d = ((const f32x4*)sh[r])[lane + 64 * j];
                const f32x4 h = v[r][j] * (a + 1.f) + d;
                u32x2 w; w.x = pk2(h[0], h[1]); w.y = pk2(h[2], h[3]);
                ((u32x2*)dsth[r])[lane + 64 * j] = w;
            }
    }
}
DI void rows_phase(const Params& p, int mode, int nrows, const float* lg, const float* lb, const float* modl, int sc_off, int sh_off, int gw, int ngw, int lane) {
    float* XRES = (float*)(wsp(p) + WS_XRES); bf16* HA = (bf16*)(wsp(p) + WS_HA); float* STA = (float*)(wsp(p) + WS_ST);
    constexpr int NR = 3;
    for (int row0 = gw; row0 < nrows; row0 += NR * ngw) {
        const float* src[NR]; float* dx[NR]; bf16* dh[NR]; const float* sc[NR]; const float* sh[NR]; float* stp[NR];
#pragma unroll
        for (int r = 0; r < NR; ++r) {
            int row = row0 + r * ngw; if (row >= nrows) row = row0;
            const int bidx = row < NLAT ? (row >> 11) : 8;
            src[r] = (mode == 0) ? (row < NLAT ? inp(p, 0) + (size_t)row * DM : inp(p, 2) + (size_t)(row - NLAT) * DM) : XRES + (size_t)row * DM;
            dx[r] = p.out + (size_t)(row < NLAT ? row : 0) * DM; dh[r] = HA + (size_t)row * DM; stp[r] = STA + 2 * row;
            sc[r] = modl + bidx * 6144 + sc_off; sh[r] = modl + bidx * 6144 + sh_off;
        }
        row_pass_n<NR>(src, lg, lb, dx, dh, sc, sh, stp, mode == 1, mode == 2, mode != 2, lane);
    }
}

template <class RM> DI void tr_item(const float* W, int ldsrc, int k0, int n0, bf16* dst, int lddst, int coloff, const float* kscale, RM rm, LAS float* scr, int lane) {
    {
        const int kq = lane >> 3, nq = lane & 7;
        f32x4 wv[8];
#pragma unroll
        for (int i = 0; i < 8; ++i) wv[i] = *(const f32x4*)(W + (size_t)(k0 + 8 * i + kq) * ldsrc + n0 + 4 * nq);
#pragma unroll
        for (int i = 0; i < 8; ++i) { const int kk = 8 * i + kq; f32x4 w = wv[i]; if (kscale) w = w * kscale[k0 + kk];
            LAS float* d = scr + kk * 33 + 4 * nq; d[0] = w[0]; d[1] = w[1]; d[2] = w[2]; d[3] = w[3]; }
    }
    LDS_WAIT(); asm volatile("" ::: "memory");
    const int c = lane & 7;
#pragma unroll
    for (int j = 0; j < 4; ++j) { const int n = (lane >> 3) + 8 * j; const LAS float* s = scr + (8 * c) * 33 + n;
        u32x4 o; o.x = pk2(s[0 * 33], s[1 * 33]); o.y = pk2(s[2 * 33], s[3 * 33]); o.z = pk2(s[4 * 33], s[5 * 33]); o.w = pk2(s[6 * 33], s[7 * 33]);
        *(u32x4*)(dst + (size_t)rm(n0 + n) * lddst + coloff + k0 + 8 * c) = o; }
    LDS_WAIT(); asm volatile("" ::: "memory");
}
struct RmId { int off; DI int operator()(int n) const { return n + off; } };
struct RmFfn { int off; DI int operator()(int n) const { return 256 * (n >> 7) + (n & 127) + off; } };

DI void zero_rect(bf16* dst, int ld, int row0, int nrows, int col0, int ncols, int gtid, int gthreads) {
    const int cpr = ncols >> 3, total = nrows * cpr; const unsigned zu = __float_as_uint(ozero());
    for (int e = gtid; e < total; e += gthreads) { const int r = e / cpr, cc = e - r * cpr; *(u32x4*)(dst + (size_t)(row0 + r) * ld + col0 + cc * 8) = (u32x4){zu, zu, zu, zu}; }
}

DI void phase_convert(const Params& p, int l, LAS unsigned char* lds, int gw, int ngw, int lane, int gtid, int gthreads) {
    unsigned char* ws = wsp(p);
    LAS float* scr = (LAS float*)(lds + (otid() >> 6) * 16384);
    bf16* Wtin = (bf16*)(ws + WS_WIN); bf16* Wtqk = (bf16*)(ws + WS_WQK); bf16* Wtv = (bf16*)(ws + WS_WV); bf16* Wtf = (bf16*)(ws + WS_WF);
    bf16* Wtout = (bf16*)(ws + WS_WOUT); bf16* Wt13 = (bf16*)(ws + WS_W13); bf16* Wt2 = (bf16*)(ws + WS_W2); bf16* Wtpool = (bf16*)(ws + WS_WPOOL); bf16* Wsb = (bf16*)(ws + WS_WS);
    const float* w_in = inp(p, 6) + (size_t)l * 1024 * 1440; const float* qn = inp(p, 7) + l * 256; const float* w_uq = inp(p, 8) + (size_t)l * 256 * 768;
    const float* kvn = inp(p, 9) + l * 128; const float* w_uk = inp(p, 10) + (size_t)l * 128 * 512; const float* w_uv = inp(p, 11) + (size_t)l * 128 * 512;
    const float* w_sp = inp(p, 14) + (size_t)l * 4 * 128 * 128; const float* w_pool = inp(p, 16) + (size_t)l * 4 * 64 * 64; const float* w_f = inp(p, 18) + (size_t)l * 256 * 256;
    const float* w_out = inp(p, 19) + (size_t)l * 1280 * 1024; const float* w1 = inp(p, 22) + (size_t)l * 1024 * DFF; const float* w3 = inp(p, 23) + (size_t)l * 1024 * DFF; const float* w2 = inp(p, 24) + (size_t)l * DFF * 1024;
    constexpr int I_IN = 16 * 45, I_UQ = 4 * 24, I_UK = 2 * 16, I_UV = 2 * 16, I_OUT = 20 * 32, I_F1 = 16 * 88, I_F3 = 16 * 88, I_F2 = 44 * 32, I_POOL = 8;
    constexpr int NITEMS = I_IN + I_UQ + I_UK + I_UV + I_OUT + I_F1 + I_F3 + I_F2 + I_POOL;
    for (int it = gw; it < NITEMS; it += ngw) {
        int r = it;
        if (r < I_IN) { tr_item(w_in, 1440, 64 * (r / 45), 32 * (r % 45), Wtin, 1024, 0, nullptr, RmId{0}, scr, lane); continue; } r -= I_IN;
        if (r < I_UQ) { tr_item(w_uq, 768, 64 * (r / 24), 32 * (r % 24), Wtqk, 384, 0, qn, RmId{0}, scr, lane); continue; } r -= I_UQ;
        if (r < I_UK) { tr_item(w_uk, 512, 64 * (r / 16), 32 * (r % 16), Wtqk, 384, 256, kvn, RmId{768}, scr, lane); continue; } r -= I_UK;
        if (r < I_UV) { tr_item(w_uv, 512, 64 * (r / 16), 32 * (r % 16), Wtv, 384, 256, kvn, RmId{0}, scr, lane); continue; } r -= I_UV;
        if (r < I_OUT) { tr_item(w_out, 1024, 64 * (r / 32), 32 * (r % 32), Wtout, 1280, 0, nullptr, RmId{0}, scr, lane); continue; } r -= I_OUT;
        if (r < I_F1) { tr_item(w1, DFF, 64 * (r / 88), 32 * (r % 88), Wt13, 1024, 0, nullptr, RmFfn{0}, scr, lane); continue; } r -= I_F1;
        if (r < I_F3) { tr_item(w3, DFF, 64 * (r / 88), 32 * (r % 88), Wt13, 1024, 0, nullptr, RmFfn{128}, scr, lane); continue; } r -= I_F3;
        if (r < I_F2) { tr_item(w2, 1024, 64 * (r / 32), 32 * (r % 32), Wt2, DFF, 0, nullptr, RmId{0}, scr, lane); continue; } r -= I_F2;
        { const int gi = r >> 1; tr_item(w_pool + gi * 4096, 64, 0, 32 * (r & 1), Wtpool + gi * 4096, 64, 0, nullptr, RmId{0}, scr, lane); }
    }
    zero_rect(Wtin, 1024, 1440, 96, 0, 1024, gtid, gthreads);
    zero_rect(Wtqk, 384, 0, 768, 256, 128, gtid, gthreads);
    zero_rect(Wtqk, 384, 768, 512, 0, 256, gtid, gthreads);
    zero_rect(Wtv, 384, 0, 512, 0, 256, gtid, gthreads);
    for (int e = gtid; e < 4 * 128 * 128 / 4; e += gthreads) { const f32x4 v = ((const f32x4*)w_sp)[e]; u32x2 w; w.x = pk2(v[0], v[1]); w.y = pk2(v[2], v[3]); ((u32x2*)Wsb)[e] = w; }
    for (int e = gtid; e < 256 * 256; e += gthreads) {
        const int n = e & 255, gc = e >> 8, g = gc >> 6, c = gc & 63;
        float sc_ = 0.f, ss_ = 0.f;
        for (int m = 0; m < 64; ++m) { const float w = w_f[(size_t)(g * 64 + m) * 256 + n]; const float a = (float)((m * c) & 63) * (1.f / 64.f); sc_ += cos_turn(a) * w; ss_ += sin_turn(a) * w; }
        Wtf[(size_t)n * 256 + gc] = (bf16)(pk2(sc_, 0.f) & 0xffffu); Wtf[(size_t)(256 + n) * 256 + gc] = (bf16)(pk2(-ss_, 0.f) & 0xffffu);
    }
}

DI void phase_prologue(const Params& p, LAS unsigned char* lds, int G, int bid) {
    const int tid = otid();
    LAS float* S = (LAS float*)lds;
    LAS float* red = (LAS float*)(lds + 40960);
    const float* cvec = inp(p, 1); const float* ccv = inp(p, 3); const float* w_mod = inp(p, 4); const float* b_mod = inp(p, 5);
    float* MOD = (float*)(wsp(p) + WS_MOD);
    for (int i = tid; i < 9 * 1024; i += 512) { const float v = i < 8192 ? cvec[i] : ccv[i - 8192]; S[i] = v * frcp(1.f + fexp2(-1.4426950408889634f * v)); }
    __syncthreads();
    for (int item = bid; item < 4 * 48; item += G) {
        const int l = item / 48, n0 = (item - l * 48) * 128, lane = tid & 63, ks = tid >> 6, kp = lane >> 5, c4 = (lane & 31) * 4;
        const float* W = w_mod + (size_t)l * 1024 * 6144 + n0 + c4;
        f32x4 acc[9];
#pragma unroll
        for (int r = 0; r < 9; ++r) acc[r] = (f32x4){0.f, 0.f, 0.f, 0.f};
#pragma unroll 16
        for (int i = 0; i < 64; ++i) {
            const int k = ks * 128 + 2 * i + kp;
            const f32x4 w = *(const f32x4*)(W + (size_t)k * 6144);
#pragma unroll
            for (int r = 0; r < 9; ++r) acc[r] = acc[r] + w * S[r * 1024 + k];
        }
        LAS float* rr = red + ((ks * 2 + kp) * 9) * 128 + c4;
#pragma unroll
        for (int r = 0; r < 9; ++r) { rr[r * 128 + 0] = acc[r][0]; rr[r * 128 + 1] = acc[r][1]; rr[r * 128 + 2] = acc[r][2]; rr[r * 128 + 3] = acc[r][3]; }
        __syncthreads();
        for (int o = tid; o < 9 * 128; o += 512) {
            const int r = o >> 7, jj = o & 127; float s = b_mod[l * 6144 + n0 + jj];
#pragma unroll
            for (int k2 = 0; k2 < 16; ++k2) s += red[k2 * 1152 + o];
            MOD[(size_t)(l * 9 + r) * 6144 + n0 + jj] = s;
        }
        __syncthreads();
    }
    const int gtid = bid * 512 + tid, gthreads = G * 512;
    bf16* CSL = (bf16*)(wsp(p) + WS_CSL); bf16* CSC = (bf16*)(wsp(p) + WS_CSC);
    for (int ch = gtid; ch < 1048576 + 16384; ch += gthreads) {
        float v[8];
        if (ch < 1048576) {
            const int k = ch >> 9, l0 = (ch & 511) * 8, half = l0 >> 11, lb = l0 & 2047; const float scale = 0.00276213586400995f;
#pragma unroll
            for (int j = 0; j < 8; ++j) { const float a = (float)((k * (lb + j)) & 2047) * (1.f / 2048.f); v[j] = (half ? sin_turn(a) : cos_turn(a)) * scale; }
            u32x4 w; w.x = pk2(v[0], v[1]); w.y = pk2(v[2], v[3]); w.z = pk2(v[4], v[5]); w.w = pk2(v[6], v[7]);
            *(u32x4*)(CSL + (size_t)k * 4096 + l0) = w;
        } else {
            const int c2 = ch - 1048576, k = c2 >> 6, l0 = (c2 & 63) * 8, half = l0 >> 8, lb = l0 & 255; const float scale = 1.f / 128.f;
#pragma unroll
            for (int j = 0; j < 8; ++j) { const float a = (float)((k * (lb + j)) & 255) * (1.f / 256.f); v[j] = (half ? sin_turn(a) : cos_turn(a)) * scale; }
            u32x4 w; w.x = pk2(v[0], v[1]); w.y = pk2(v[2], v[3]); w.z = pk2(v[4], v[5]); w.w = pk2(v[6], v[7]);
            *(u32x4*)(CSC + (size_t)k * 512 + l0) = w;
        }
    }
    float* ROPE = (float*)(wsp(p) + WS_ROPE);
    for (int e = gtid; e < 2048 * 16; e += gthreads) {
        const int pos = e >> 4, f = e & 15, axis = f >> 3, fi = f & 7;
        const float coord = (float)(axis ? (pos & 63) : (pos >> 6));
        const float inv = fexp2(-(float)fi * (13.287712379549449f / 8.f));
        const float ang = coord * inv * 0.15915494309189535f;
        ROPE[pos * 32 + f] = cos_turn(ang); ROPE[pos * 32 + 16 + f] = sin_turn(ang);
    }
}

DI f32x4 mfma16(bf16x8 a, bf16x8 b, f32x4 c) { return __builtin_amdgcn_mfma_f32_16x16x32_bf16(a, b, c, 0, 0, 0); }
DI f32x16 mfma32(bf16x8 a, bf16x8 b, f32x16 c) { return __builtin_amdgcn_mfma_f32_32x32x16_bf16(a, b, c, 0, 0, 0); }

DI void sgu_item(const Params& p, int l, int ci, int g, LAS unsigned char* lds) {
    const int tid = otid(), lane = tid & 63, w = tid >> 6;
    const bf16* proj = (const bf16*)(wsp(p) + WS_PROJ); bf16* mix = (bf16*)(wsp(p) + WS_MIX); const bf16* Wsb = (const bf16*)(wsp(p) + WS_WS);
    const float* gam = inp(p, 12) + l * 256; const float* bet = inp(p, 13) + l * 256; const float* bsp = inp(p, 15) + l * 512;
    constexpr int PITCH = 136;
    LAS bf16* vnT = (LAS bf16*)lds;
    const int r0 = ci * 128;
    const int fr = lane & 15, fq = lane >> 4, pp = 16 * w + fr, tok = r0 + pp;
    bf16x8 wfr[4]; u32x2 uu[4];
#pragma unroll
    for (int ks = 0; ks < 4; ++ks) wfr[ks] = *(const bf16x8*)(Wsb + (size_t)(g * 128 + pp) * 128 + ks * 32 + fq * 8);
#pragma unroll
    for (int ct = 0; ct < 4; ++ct) uu[ct] = *(const u32x2*)(proj + (size_t)tok * NPROJ + PO_SU + g * 64 + ct * 16 + fq * 4);
    const float bs = bsp[g * 128 + pp];
    {
        const int q = tid >> 2, j = tid & 3;
        const u32x4* src = (const u32x4*)(proj + (size_t)(r0 + q) * NPROJ + PO_SV + j * 64);
        float v[64]; float s = 0.f;
#pragma unroll
        for (int i = 0; i < 8; ++i) { const u32x4 x = src[i];
            v[8 * i + 0] = bflo(x.x); v[8 * i + 1] = bfhi(x.x); v[8 * i + 2] = bflo(x.y); v[8 * i + 3] = bfhi(x.y);
            v[8 * i + 4] = bflo(x.z); v[8 * i + 5] = bfhi(x.z); v[8 * i + 6] = bflo(x.w); v[8 * i + 7] = bfhi(x.w); }
#pragma unroll
        for (int i = 0; i < 64; ++i) s += v[i];
        s += shx(s, 1); s += shx(s, 2);
        const float mean = s * (1.f / 256.f); float s2 = 0.f;
#pragma unroll
        for (int i = 0; i < 64; ++i) { v[i] -= mean; s2 += v[i] * v[i]; }
        s2 += shx(s2, 1); s2 += shx(s2, 2);
        const float rstd = rsqrtf(s2 * (1.f / 256.f) + LN_EPS);
        if (j == g) {
#pragma unroll
            for (int c = 0; c < 64; ++c) { const float vn = v[c] * rstd * gam[g * 64 + c] + bet[g * 64 + c]; vnT[c * PITCH + q] = (bf16)(pk2(vn, 0.f) & 0xffffu); }
        }
    }
    __syncthreads();
    {
        f32x4 acc[4]; const float zf = ozero();
#pragma unroll
        for (int ct = 0; ct < 4; ++ct) acc[ct] = (f32x4){zf, zf, zf, zf};
#pragma unroll
        for (int ks = 0; ks < 4; ++ks) {
            const bf16x8 bfr = wfr[ks];
#pragma unroll
            for (int ct = 0; ct < 4; ++ct) { const bf16x8 afr = *(const LAS bf16x8*)(vnT + (ct * 16 + fr) * PITCH + ks * 32 + fq * 8); acc[ct] = mfma16(afr, bfr, acc[ct]); }
        }
#pragma unroll
        for (int ct = 0; ct < 4; ++ct) {
            const int c0 = g * 64 + ct * 16 + fq * 4;
            u32x2 o; o.x = pk2(bflo(uu[ct].x) * (acc[ct][0] + bs), bfhi(uu[ct].x) * (acc[ct][1] + bs)); o.y = pk2(bflo(uu[ct].y) * (acc[ct][2] + bs), bfhi(uu[ct].y) * (acc[ct][3] + bs));
            *(u32x2*)(mix + (size_t)tok * MIXD + 512 + c0) = o;
        }
    }
    __syncthreads();
}

DI void pool_item(const Params& p, int l, int ti, int gi, LAS unsigned char* lds) {
    const int tid = otid(), lane = tid & 63, w = tid >> 6;
    const bf16* proj = (const bf16*)(wsp(p) + WS_PROJ); bf16* mix = (bf16*)(wsp(p) + WS_MIX); const bf16* Wtp = (const bf16*)(wsp(p) + WS_WPOOL) + gi * 4096;
    const float* pscale = inp(p, 17) + l * 256 + gi * 64;
    LAS float* Pl = (LAS float*)lds;
    LAS bf16* Dl = (LAS bf16*)(lds + 40960);
    const int r0 = ti * 128, half = 1 << gi;
    int sb, se; if (r0 < NLAT) { sb = r0 & ~2047; se = sb + 2048; } else { sb = NLAT + ((r0 - NLAT) & ~255); se = sb + 256; }
    const unsigned zu = __float_as_uint(ozero());
    const int fr = lane & 15, fq = lane >> 4;
    bf16x8 wfr[2][4]; f32x4 psc[4];
#pragma unroll
    for (int ks = 0; ks < 2; ++ks)
#pragma unroll
        for (int nt = 0; nt < 4; ++nt) wfr[ks][nt] = *(const bf16x8*)(Wtp + (nt * 16 + fr) * 64 + ks * 32 + fq * 8);
#pragma unroll
    for (int nt = 0; nt < 4; ++nt) psc[nt] = *(const f32x4*)(pscale + nt * 16 + fq * 4);
    for (int e = tid; e < 144 * 8; e += 512) {
        const int rr = e >> 3, c8 = (e & 7) * 8, r = r0 - 8 + rr;
        u32x4 x = (u32x4){zu, zu, zu, zu};
        if (r >= sb && r < se) x = *(const u32x4*)(proj + (size_t)r * NPROJ + PO_POOL + gi * 64 + c8);
        LAS float* d = Pl + rr * 65 + c8;
        d[0] = bflo(x.x); d[1] = bfhi(x.x); d[2] = bflo(x.y); d[3] = bfhi(x.y); d[4] = bflo(x.z); d[5] = bfhi(x.z); d[6] = bflo(x.w); d[7] = bfhi(x.w);
    }
    __syncthreads();
    {
        const int c = tid & 63, t0 = (tid >> 6) * 16;
        float s = 0.f;
        for (int rr = t0 + 8 - half; rr < t0 + 8 + half; ++rr) s += Pl[rr * 65 + c];
        float add[15], sub[15], ctr[16];
#pragma unroll
        for (int i = 0; i < 15; ++i) { add[i] = Pl[(t0 + i + 8 + half) * 65 + c]; sub[i] = Pl[(t0 + i + 8 - half) * 65 + c]; }
#pragma unroll
        for (int i = 0; i < 16; ++i) ctr[i] = Pl[(t0 + i + 8) * 65 + c];
#pragma unroll
        for (int i = 0; i < 16; ++i) {
            const int r = r0 + t0 + i;
            const int lo = max(r - half, sb), hi = min(r + half, se);
            const float d = s * frcp((float)(hi - lo)) - ctr[i];
            Dl[(t0 + i) * 72 + c] = (bf16)(pk2(d, 0.f) & 0xffffu);
            if (i < 15) s += add[i] - sub[i];
        }
    }
    __syncthreads();
    {
        const int t = 16 * w + fr;
        f32x4 acc[4]; const float zf = ozero();
#pragma unroll
        for (int nt = 0; nt < 4; ++nt) acc[nt] = (f32x4){zf, zf, zf, zf};
#pragma unroll
        for (int ks = 0; ks < 2; ++ks) {
            const bf16x8 bfr = *(const LAS bf16x8*)(Dl + t * 72 + ks * 32 + fq * 8);
#pragma unroll
            for (int nt = 0; nt < 4; ++nt) acc[nt] = mfma16(wfr[ks][nt], bfr, acc[nt]);
        }
#pragma unroll
        for (int nt = 0; nt < 4; ++nt) {
            const int n0 = nt * 16 + fq * 4; const f32x4 sc = psc[nt];
            u32x2 o; o.x = pk2(acc[nt][0] * sc[0], acc[nt][1] * sc[1]); o.y = pk2(acc[nt][2] * sc[2], acc[nt][3] * sc[3]);
            *(u32x2*)(mix + (size_t)(r0 + t) * MIXD + 768 + gi * 64 + n0) = o;
        }
    }
    __syncthreads();
}

DI void krope_items(const Params& p, int gtid, int gthreads) {
    const bf16* proj = (const bf16*)(wsp(p) + WS_PROJ); bf16* Kb = (bf16*)(wsp(p) + WS_K); const float* rope = (const float*)(wsp(p) + WS_ROPE);
    for (int e = gtid; e < MTOK * 2; e += gthreads) {
        const int row = e >> 1, axis = e & 1;
        int b, pos; bool lat; row_info(row, b, pos, lat);
        const u32x4 x1 = *(const u32x4*)(proj + (size_t)row * NPROJ + PO_KR + axis * 16), x2 = *(const u32x4*)(proj + (size_t)row * NPROJ + PO_KR + axis * 16 + 8);
        u32x4 o1 = x1, o2 = x2;
        if (lat) {
            const float* rp = rope + pos * 32 + axis * 8;
            float a[8], c[8], cs[8], sn[8];
            a[0] = bflo(x1.x); a[1] = bfhi(x1.x); a[2] = bflo(x1.y); a[3] = bfhi(x1.y); a[4] = bflo(x1.z); a[5] = bfhi(x1.z); a[6] = bflo(x1.w); a[7] = bfhi(x1.w);
            c[0] = bflo(x2.x); c[1] = bfhi(x2.x); c[2] = bflo(x2.y); c[3] = bfhi(x2.y); c[4] = bflo(x2.z); c[5] = bfhi(x2.z); c[6] = bflo(x2.w); c[7] = bfhi(x2.w);
#pragma unroll
            for (int j = 0; j < 8; ++j) { cs[j] = rp[j]; sn[j] = rp[16 + j]; }
            float y1[8], y2[8];
#pragma unroll
            for (int j = 0; j < 8; ++j) { y1[j] = a[j] * cs[j] - c[j] * sn[j]; y2[j] = a[j] * sn[j] + c[j] * cs[j]; }
            o1.x = pk2(y1[0], y1[1]); o1.y = pk2(y1[2], y1[3]); o1.z = pk2(y1[4], y1[5]); o1.w = pk2(y1[6], y1[7]);
            o2.x = pk2(y2[0], y2[1]); o2.y = pk2(y2[2], y2[3]); o2.z = pk2(y2[4], y2[5]); o2.w = pk2(y2[6], y2[7]);
        }
        const int key = lat ? CTXL + pos : pos;
#pragma unroll
        for (int h = 0; h < 8; ++h) { bf16* dst = Kb + ((size_t)(b * 8 + h) * NKEY + key) * 96 + 64 + axis * 16; *(u32x4*)dst = o1; *(u32x4*)(dst + 8) = o2; }
    }
}

DI int swap23(int r) { return (r & ~12) | ((r & 4) << 1) | ((r & 8) >> 1); }
DI void attn_item(const bf16* Qp, const bf16* Kp, const bf16* Vtp, int nkeys, bf16* outp  , LAS unsigned char* lds) {
    const int tid = otid(), lane = tid & 63, w = tid >> 6, r = lane & 31, hh = lane >> 5, gk = w >> 2, wq = w & 3;
    constexpr int KP = 208, VP = 144, KT = 64 * KP, VT = 64 * VP;
    LAS unsigned char* Kl = lds; LAS unsigned char* Vl = lds + 4 * KT;
    bf16x8 qf[6];
#pragma unroll
    for (int kk = 0; kk < 6; ++kk) qf[kk] = *(const bf16x8*)(Qp + (size_t)(32 * wq + r) * 96 + kk * 16 + hh * 8);
    const float zf = ozero();
    f32x16 o0, o1;
#pragma unroll
    for (int i = 0; i < 16; ++i) { o0[i] = zf; o1[i] = zf; }
    float mrun = -60.f, lrun = zf;
    unsigned kg[3], kl[3], vg[2], vl[2];
#pragma unroll
    for (int i = 0; i < 3; ++i) { const int c = tid + 512 * i, tile = c / 768, cc = c - tile * 768, row = cc / 12, col = cc - row * 12;
        kg[i] = (unsigned)((tile * 64 + row) * 96 + col * 8); kl[i] = (unsigned)(tile * KT + swap23(row) * KP + col * 16); }
#pragma unroll
    for (int i = 0; i < 2; ++i) { const int c = tid + 512 * i, tile = c >> 9, cc = c & 511, dv = cc >> 3, col = cc & 7;
        vg[i] = (unsigned)(dv * NKEY + tile * 64 + col * 8); vl[i] = (unsigned)(tile * VT + dv * VP + col * 16); }
    const int npairs = nkeys >> 7;
    u32x4 sk[3], sv[2];
#pragma unroll
    for (int i = 0; i < 3; ++i) sk[i] = *(const u32x4*)(Kp + kg[i]);
#pragma unroll
    for (int i = 0; i < 2; ++i) sv[i] = *(const u32x4*)(Vtp + vg[i]);
#pragma unroll
    for (int i = 0; i < 3; ++i) *(LAS u32x4*)(Kl + kl[i]) = sk[i];
#pragma unroll
    for (int i = 0; i < 2; ++i) *(LAS u32x4*)(Vl + vl[i]) = sv[i];
    __syncthreads();
    for (int kp = 0; kp < npairs; ++kp) {
        const int cur = kp & 1;
        if (kp + 1 < npairs) {
            const bf16* kgp = Kp + (size_t)(kp + 1) * 128 * 96; const bf16* vgp = Vtp + (kp + 1) * 128;
#pragma unroll
            for (int i = 0; i < 3; ++i) sk[i] = *(const u32x4*)(kgp + kg[i]);
#pragma unroll
            for (int i = 0; i < 2; ++i) sv[i] = *(const u32x4*)(vgp + vg[i]);
        }
        const LAS unsigned char* kb = Kl + (cur * 2 + gk) * KT; const LAS unsigned char* vb = Vl + (cur * 2 + gk) * VT;
        f32x16 s0, s1; const float negm = -mrun;
#pragma unroll
        for (int i = 0; i < 16; ++i) { s0[i] = negm; s1[i] = negm; }
#pragma unroll
        for (int kk = 0; kk < 6; ++kk) {
            const bf16x8 ka0 = *(const LAS bf16x8*)(kb + r * KP + kk * 32 + hh * 16);
            const bf16x8 ka1 = *(const LAS bf16x8*)(kb + (32 + r) * KP + kk * 32 + hh * 16);
            s0 = mfma32(ka0, qf[kk], s0); s1 = mfma32(ka1, qf[kk], s1);
        }
        float mx = s0[0];
#pragma unroll
        for (int i = 1; i < 16; ++i) mx = fmaxf(mx, s0[i]);
#pragma unroll
        for (int i = 0; i < 16; ++i) mx = fmaxf(mx, s1[i]);
        if (__builtin_amdgcn_ballot_w64(mx > 6.f) != 0ull) {
            mx = fmaxf(mx, shx(mx, 32));
            const float dm = fmaxf(mx, 0.f), alpha = fexp2(-dm);
            mrun += dm; lrun *= alpha;
#pragma unroll
            for (int i = 0; i < 16; ++i) { s0[i] -= dm; s1[i] -= dm; o0[i] *= alpha; o1[i] *= alpha; }
        }
        float ls = 0.f;
#pragma unroll
        for (int i = 0; i < 16; ++i) { s0[i] = fexp2(s0[i]); s1[i] = fexp2(s1[i]); ls += s0[i] + s1[i]; }
        lrun += ls;
        bf16x8 pf[2][2];
#pragma unroll
        for (int s2 = 0; s2 < 2; ++s2) {
            u32x4 a, b2;
            a.x = pk2(s0[8 * s2 + 0], s0[8 * s2 + 1]); a.y = pk2(s0[8 * s2 + 2], s0[8 * s2 + 3]); a.z = pk2(s0[8 * s2 + 4], s0[8 * s2 + 5]); a.w = pk2(s0[8 * s2 + 6], s0[8 * s2 + 7]);
            b2.x = pk2(s1[8 * s2 + 0], s1[8 * s2 + 1]); b2.y = pk2(s1[8 * s2 + 2], s1[8 * s2 + 3]); b2.z = pk2(s1[8 * s2 + 4], s1[8 * s2 + 5]); b2.w = pk2(s1[8 * s2 + 6], s1[8 * s2 + 7]);
            pf[0][s2] = __builtin_bit_cast(bf16x8, a); pf[1][s2] = __builtin_bit_cast(bf16x8, b2);
        }
#pragma unroll
        for (int d = 0; d < 2; ++d)
#pragma unroll
            for (int s2 = 0; s2 < 2; ++s2) {
                const bf16x8 v0 = *(const LAS bf16x8*)(vb + r * VP + (d * 32 + s2 * 16 + hh * 8) * 2);
                const bf16x8 v1 = *(const LAS bf16x8*)(vb + (32 + r) * VP + (d * 32 + s2 * 16 + hh * 8) * 2);
                o0 = mfma32(v0, pf[d][s2], o0); o1 = mfma32(v1, pf[d][s2], o1);
            }
        if (kp + 1 < npairs) {
            LAS unsigned char* kn = Kl + (cur ^ 1) * 2 * KT; LAS unsigned char* vn = Vl + (cur ^ 1) * 2 * VT;
#pragma unroll
            for (int i = 0; i < 3; ++i) *(LAS u32x4*)(kn + kl[i]) = sk[i];
#pragma unroll
            for (int i = 0; i < 2; ++i) *(LAS u32x4*)(vn + vl[i]) = sv[i];
        }
        __syncthreads();
    }
    lrun += shx(lrun, 32);
    LAS float* mg = (LAS float*)lds + wq * (34 * 64) + lane;
    if (gk == 1) {
#pragma unroll
        for (int i = 0; i < 16; ++i) { mg[i * 64] = o0[i]; mg[(16 + i) * 64] = o1[i]; }
        mg[32 * 64] = mrun; mg[33 * 64] = lrun;
    }
    __syncthreads();
    if (gk == 0) {
        const float m1 = mg[32 * 64], l1 = mg[33 * 64];
        const float m = fmaxf(mrun, m1), a0 = fexp2(mrun - m), a1 = fexp2(m1 - m);
        const float inv = frcp(lrun * a0 + l1 * a1), c0 = a0 * inv, c1 = a1 * inv;
        bf16* orow = outp + (size_t)(32 * wq + r) * MIXD;
#pragma unroll
        for (int i4 = 0; i4 < 4; ++i4) {
            u32x2 a, b2;
            a.x = pk2(o0[4 * i4] * c0 + mg[(4 * i4) * 64] * c1, o0[4 * i4 + 1] * c0 + mg[(4 * i4 + 1) * 64] * c1);
            a.y = pk2(o0[4 * i4 + 2] * c0 + mg[(4 * i4 + 2) * 64] * c1, o0[4 * i4 + 3] * c0 + mg[(4 * i4 + 3) * 64] * c1);
            b2.x = pk2(o1[4 * i4] * c0 + mg[(16 + 4 * i4) * 64] * c1, o1[4 * i4 + 1] * c0 + mg[(16 + 4 * i4 + 1) * 64] * c1);
            b2.y = pk2(o1[4 * i4 + 2] * c0 + mg[(16 + 4 * i4 + 2) * 64] * c1, o1[4 * i4 + 3] * c0 + mg[(16 + 4 * i4 + 3) * 64] * c1);
            *(u32x2*)(orow + 8 * i4 + 4 * hh) = a; *(u32x2*)(orow + 32 + 8 * i4 + 4 * hh) = b2;
        }
    }
    __syncthreads();
}

DI void attn_any(const Params& p, int item, LAS unsigned char* lds) {
    unsigned char* ws = wsp(p);
    const bool isl = item < 1024;
    const int bh = isl ? (item >> 4) : ((item - 1024) >> 1), qb = isl ? (item & 15) : ((item - 1024) & 1), b = bh >> 3, h = bh & 7;
    const bf16* Qp = isl ? (const bf16*)(ws + WS_QLAT) + ((size_t)bh * SEQ + qb * 128) * 96 : (const bf16*)(ws + WS_QCTX) + ((size_t)bh * CTXL + qb * 128) * 96;
    const bf16* Kp = (const bf16*)(ws + WS_K) + (size_t)bh * NKEY * 96;
    const bf16* Vtp = (const bf16*)(ws + WS_VT) + (size_t)bh * 64 * NKEY;
    bf16* outp = (bf16*)(ws + WS_MIX) + (size_t)(isl ? (b * SEQ + qb * 128) : (NLAT + b * CTXL + qb * 128)) * MIXD + h * 64;
    attn_item(Qp, Kp, Vtp, isl ? NKEY : CTXL, outp, lds);
    if (!isl) publish_block((unsigned*)(ws + WS_CTL) + CW_ECTX);
}

#ifndef PROBE_REP_SUB
#define PROBE_REP_SUB -1
#endif
#ifndef PROBE_SYNCS
#define PROBE_SYNCS 0
#endif
constexpr int NSUB = 13 + (PROBE_REP_SUB >= 0 ? 1 : 0), NSTEP = 2 + NSUB * DEPTH;
__global__ void __launch_bounds__(512, 2) mk_fwd(Params p) {
    extern __shared__ __attribute__((aligned(16))) unsigned char lds_raw[];
    LAS unsigned char* lds = (LAS unsigned char*)lds_raw;
    cg::grid_group grid = cg::this_grid();
    volatile LAS unsigned* MISC = (volatile LAS unsigned*)(lds + MISC_OFF);
    if (threadIdx.x < 4) MISC[threadIdx.x] = 0u;
    __syncthreads();
    const XcdBarrier xbar = xcd_barrier_post((unsigned*)(p.ws + WS_CTL), MISC);
    if (p.ph_lo < 0) grid.sync();
    for (int st = __builtin_amdgcn_readfirstlane(p.ph_lo); st < __builtin_amdgcn_readfirstlane(p.ph_hi); st = __builtin_amdgcn_readfirstlane(st + 1)) {
        int G = gridDim.x, bid = blockIdx.x; asm volatile("" : "+s"(G), "+s"(bid));
        const int vcu = (G % 8 == 0) ? (bid % 8) * (G / 8) + bid / 8 : bid;
        const int ngw = G * 8, gthreads = G * 512;
        const int tid = otid(), lane = tid & 63, wave = tid >> 6, gw = bid * 8 + wave, gtid = bid * 512 + tid;
        const int l = (st - 1) / NSUB, subx = (st - 1) - l * NSUB, sub = (st == 0) ? 100 : (st == NSTEP - 1) ? 101 : ((PROBE_REP_SUB >= 0 && subx > PROBE_REP_SUB) ? subx - 1 : subx);
        const bool need_sync = !(sub == 3 || sub == 4 || sub == 5 || sub == 7 || sub == 8 || sub == 100);
        if (st > __builtin_amdgcn_readfirstlane(p.ph_lo) && need_sync) xcd_barrier(xbar);
        unsigned char* ws = wsp(p);
        float* XRES = (float*)(ws + WS_XRES); bf16* HA = (bf16*)(ws + WS_HA); bf16* PROJ = (bf16*)(ws + WS_PROJ);
        bf16* MIX = (bf16*)(ws + WS_MIX); bf16* U = (bf16*)(ws + WS_U);
        const float* MOD = (const float*)(ws + WS_MOD);
        float* STQ = (float*)(ws + WS_STQ); float* STKV = (float*)(ws + WS_STKV);
        const bool last = (l == DEPTH - 1);
        const int Mtail = last ? NLAT : MTOK;
        const float* modl = MOD + (size_t)l * 9 * 6144;
        if (PROBE_SYNCS > 0 && sub == 101) { for (int i = 0; i < PROBE_SYNCS; ++i) xcd_barrier(xbar); }
        switch (sub) {
        case 100: phase_prologue(p, lds, G, bid); break;
        case 101: {
            rows_phase(p, 2, NLAT, inp(p, 25) + (DEPTH - 1) * DM, inp(p, 26) + (DEPTH - 1) * DM, modl, 0, 0, gw, ngw, lane);
        } break;
        case 0: {
            const float* lg = (l == 0) ? nullptr : inp(p, 25) + (l - 1) * DM; const float* lb = (l == 0) ? nullptr : inp(p, 26) + (l - 1) * DM;
            rows_phase(p, l == 0 ? 0 : 1, MTOK, lg, lb, modl, 1024, 0, gw, ngw, lane);
            phase_convert(p, l, lds, gw, ngw, lane, gtid, gthreads);
        } break;
        case 1: {
            EpiProj E{PROJ, STQ, STKV};
            run_gemm<DM, DM, DM, MTOK, NPROJ>(lds, HA, (const bf16*)(ws + WS_WIN), G, bid, E);
        } break;
        case 2: {
            EpiQK E{(bf16*)(ws + WS_QLAT), (bf16*)(ws + WS_QCTX), (bf16*)(ws + WS_K), STQ, STKV, (const float*)(ws + WS_ROPE)};
            run_gemm<NPROJ, 384, 384, MTOK, 1280>(lds, PROJ, (const bf16*)(ws + WS_WQK), G, bid, E);
        } break;
        case 3: {
            EpiVt E{(bf16*)(ws + WS_VT), STKV};
            run_gemm<384, NPROJ, 384, 512, MTOK>(lds, (const bf16*)(ws + WS_WV), PROJ, G, (bid + G - 104) % G, E);
        } break;
        case 4: {
            EpiGt E{(bf16*)(ws + WS_GTL), (bf16*)(ws + WS_GTC)};
            run_gemm<256, NPROJ, 256, 512, MTOK>(lds, (const bf16*)(ws + WS_WF), PROJ + PO_F, G, (bid + G - 104) % G, E);
        } break;
        case 5: {
            int first, cnt;
            if (G == 256) { if (bid < 104) { first = bid * 5; cnt = 5; } else if (bid < 248) { first = 520 + (bid - 104) * 4; cnt = 4; } else { first = 1096 + (bid - 248) * 7; cnt = 7; } }
            else { first = bid; cnt = (1152 - bid + G - 1) / G; }
            for (int k = 0; k < cnt; ++k) { const int it = (G == 256) ? first + k : first + k * G;
                if (it < 576) sgu_item(p, l, it >> 2, it & 3, lds); else pool_item(p, l, (it - 576) >> 2, (it - 576) & 3, lds); }
            krope_items(p, gtid, gthreads);
        } break;
        case 6: {
            EpiDft E{MIX, 0, SEQ};
            run_gemm<4096, 4096, 4096, 2048, 2048>(lds, (const bf16*)(ws + WS_CSL), (const bf16*)(ws + WS_GTL), G, vcu, E);
        } break;
        case 7: {
            if (!last) { EpiDft E{MIX, NLAT, CTXL};
              StaticOrderSig<256, 2048> S{G, (vcu + G - 64) % G, (unsigned*)(ws + WS_CTL) + CW_ECTX};
              run_gemm_s<512, 512, 512>(lds, (const bf16*)(ws + WS_CSC), (const bf16*)(ws + WS_GTC), 256, 2048, S, E); }
        } break;
        case 8: {
            if (G == 256) {
                int first, cnt, citem = -1;
                if (vcu < 64) { first = 2 * vcu; cnt = 2; } else if (vcu < 72) { first = 128 + 5 * (vcu - 64); cnt = 5; }
                else if (vcu < 104) { first = 168 + 3 * (vcu - 72); cnt = 3; } else { first = 264 + 5 * (vcu - 104); cnt = 5; if (!last && vcu < 232) citem = 1024 + (vcu - 104); }
                if (citem >= 0) attn_any(p, citem, lds);
                for (int k = 0; k < cnt; ++k) attn_any(p, first + k, lds);
                if (!last) {
                    SchedHC S{vcu + 152, (unsigned*)(ws + WS_CTL) + CW_ECTX, 136u * (unsigned)(l + 1)};
                    EpiRes E2{(l == 0) ? inp(p, 2) : XRES + (size_t)NLAT * DM, XRES + (size_t)NLAT * DM, (const float*)(ws + WS_ST) + 2 * NLAT, (l == 0) ? nullptr : inp(p, 25) + (l - 1) * DM, (l == 0) ? nullptr : inp(p, 26) + (l - 1) * DM, modl, 2048, 64};
                    run_gemm_s<MIXD, MIXD, MIXD>(lds, MIX + (size_t)NLAT * MIXD, (const bf16*)(ws + WS_WOUT), NCTX, DM, S, E2);
                }
            } else {
                for (int it = vcu; it < (last ? 1024 : 1152); it += G) attn_any(p, it, lds);
            }
        } break;
        case 9: {
            EpiRes E{(l == 0) ? inp(p, 0) : XRES, XRES, (const float*)(ws + WS_ST), (l == 0) ? nullptr : inp(p, 25) + (l - 1) * DM, (l == 0) ? nullptr : inp(p, 26) + (l - 1) * DM, modl, 2048, 0};
            if (last || G == 256) run_gemm<MIXD, MIXD, MIXD, NLAT, DM>(lds, MIX, (const bf16*)(ws + WS_WOUT), G, bid, E);
            else run_gemm<MIXD, MIXD, MIXD, MTOK, DM>(lds, MIX, (const bf16*)(ws + WS_WOUT), G, bid, E);
        } break;
        case 10: {
            rows_phase(p, 1, Mtail, inp(p, 20) + l * DM, inp(p, 21) + l * DM, modl, 4096, 3072, gw, ngw, lane);
        } break;
        case 11: {
            EpiSwiglu E{U};
            if (last || G != 256) {
                if (last) run_gemm<DM, DM, DM, NLAT, 2 * DFF>(lds, HA, (const bf16*)(ws + WS_W13), G, bid, E);
                else run_gemm<DM, DM, DM, MTOK, 2 * DFF>(lds, HA, (const bf16*)(ws + WS_W13), G, bid, E);
            } else {
                unsigned* cnt = (unsigned*)(ws + WS_CTL) + CW_GCTX;
                { SchedG S{bid, cnt}; run_gemm_s<DM, DM, DM>(lds, HA, (const bf16*)(ws + WS_W13), MTOK, 2 * DFF, S, E); }
                { SchedHC S{bid, cnt, 176u * (unsigned)(l + 1)}; EpiRes E2{XRES + (size_t)NLAT * DM, XRES + (size_t)NLAT * DM, (const float*)(ws + WS_ST) + 2 * NLAT, inp(p, 20) + l * DM, inp(p, 21) + l * DM, modl, 5120, 64};
                  run_gemm_s<DFF, DFF, DFF>(lds, U + (size_t)NLAT * DFF, (const bf16*)(ws + WS_W2), NCTX, DM, S, E2); }
            }
        } break;
        case 12: {
            EpiRes E{XRES, XRES, (const float*)(ws + WS_ST), inp(p, 20) + l * DM, inp(p, 21) + l * DM, modl, 5120, 0};
            if (last || G == 256) run_gemm<DFF, DFF, DFF, NLAT, DM>(lds, U, (const bf16*)(ws + WS_W2), G, bid, E);
            else run_gemm<DFF, DFF, DFF, MTOK, DM>(lds, U, (const bf16*)(ws + WS_W2), G, bid, E);
        } break;
        }
        __syncthreads();
    }
}

#ifndef MK_SPLIT
#define MK_SPLIT 0
#endif
extern "C" void kernel_launch(void* const* d_in, const int* in_sizes, int n_in, void* d_out, int out_size, void* d_ws, size_t ws_size, hipStream_t stream) {
    static int grid = 0;
    if (grid == 0) {
        if (n_in != 27 || out_size != NLAT * DM || ws_size < WS_END) { fprintf(stderr, "kernel_launch: unexpected shapes / workspace (%d inputs, out %d, ws %zu < %zu)\n", n_in, out_size, ws_size, (size_t)WS_END); grid = -1; return; }
        int dev = 0, cus = 0, per_cu = 0;
        hipGetDevice(&dev);
        hipDeviceGetAttribute(&cus, hipDeviceAttributeMultiprocessorCount, dev);
        hipFuncSetAttribute((const void*)mk_fwd, hipFuncAttributeMaxDynamicSharedMemorySize, LDS_BYTES);
        hipOccupancyMaxActiveBlocksPerMultiprocessor(&per_cu, (const void*)mk_fwd, 512, LDS_BYTES);
        if (per_cu < 1) { fprintf(stderr, "kernel_launch: occupancy query reports %d blocks per CU\n", per_cu); per_cu = 1; }
        grid = cus >= 256 ? 256 : cus;
        (void)hipGetLastError();
    }
    if (grid < 0) return;
    if (hipMemsetAsync((char*)d_ws + WS_CTL, 0, CTL_BYTES, stream) != hipSuccess) { fprintf(stderr, "kernel_launch: memset failed\n"); return; }
    Params p{};
    for (int i = 0; i < 27; ++i) p.in[i] = (const float*)d_in[i];
    p.out = (float*)d_out; p.ws = (unsigned char*)d_ws;
#if MK_SPLIT
    for (int ph = 0; ph < NSTEP; ++ph) {
        p.ph_lo = ph; p.ph_hi = ph + 1;
        void* args[] = {&p};
        hipError_t e = hipLaunchCooperativeKernel((const void*)mk_fwd, dim3(grid), dim3(512), args, LDS_BYTES, stream);
        if (e != hipSuccess) { fprintf(stderr, "cooperative launch failed: %s\n", hipGetErrorString(e)); return; }
    }
#else
    p.ph_lo = 0; p.ph_hi = NSTEP;
    void* args[] = {&p};
    hipError_t e = hipLaunchCooperativeKernel((const void*)mk_fwd, dim3(grid), dim3(512), args, LDS_BYTES, stream);
    if (e != hipSuccess) fprintf(stderr, "cooperative launch failed: %s (grid %d)\n", hipGetErrorString(e), grid);
#endif
}
```

```cpp
#include <hip/hip_runtime.h>
#include <hip/hip_cooperative_groups.h>
#include <cstdio>
#include <cstdint>
namespace cg = cooperative_groups;
__device__ __forceinline__ int otid() { int t = threadIdx.x; asm volatile("" : "+v"(t)); return t; }
namespace pg8 {
#define PG8_LAS __attribute__((address_space(3)))
typedef unsigned short bf16_t;
typedef short bf16x8 __attribute__((ext_vector_type(8)));
typedef float f32x4 __attribute__((ext_vector_type(4)));
typedef unsigned u32x4 __attribute__((ext_vector_type(4)));
constexpr int BM = 256, BK = 64, HALF = 128, HTB = HALF * BK * 2  , STAGE_BYTES = 8 * HTB, NXCD = 8, WGM = 8;

__host__ __device__ __forceinline__ int lds_byte(int r, int c) { const int st = (r >> 4) * 2 + (c >> 5), rr = r & 15, cc = c & 31, ob = rr * 64 + cc * 2; return st * 1024 + (ob ^ (((ob >> 9) & 1) << 5)); }
__host__ __device__ __forceinline__ void stage_rc(int b, int& R, int& C) { const int st = b / 1024, sb = b % 1024, swz = sb ^ (((sb >> 9) & 1) << 5); R = (st >> 1) * 16 + swz / 64; C = (st & 1) * 32 + (swz % 64) / 2; }
__host__ __device__ __forceinline__ int perm32(int rho) { const int n = rho >> 4, i = rho & 15; return 8 * (i >> 2) + 4 * n + (i & 3); }

struct Unit { int pm, pn; };
struct Gemm { const bf16_t* A; const bf16_t* Bt; int M, N; };

struct StaticOrder {
    int nM, nN, nwg, G, c;
    __host__ __device__ void init(int M, int N, int G_, int c_) { nM = M / BM; nN = N / BM; nwg = nM * nN; G = G_; c = c_; }
    __host__ __device__ bool next(int i, Unit& u) const {
        const long L = (long)i * G + c; if (L >= nwg) return false;
        int wgid = (int)L; { const int q = nwg / NXCD, r = nwg % NXCD, xcd = wgid % NXCD, off = wgid / NXCD; wgid = (xcd < r ? xcd * (q + 1) : r * (q + 1) + (xcd - r) * q) + off; }
        const int nig = WGM * nN, gid = wgid / nig, fm = gid * WGM, gsz = (nM - fm) < WGM ? (nM - fm) : WGM;
        u.pm = fm + ((wgid % nig) % gsz); u.pn = (wgid % nig) / gsz; return true;
    }
    __device__ __forceinline__ void a_ready(const Unit&) const {}
    __device__ __forceinline__ void done(const Unit&) const {}
};


template <class Epi, class Sched, bool ALIGN_EPI, bool SP2, int LDA, int LDB, int KDIM>
__device__ __forceinline__ void gemm_phase(PG8_LAS unsigned char* lds, const Gemm g, const Sched& S, const Epi& E) {
    const int tid = otid(), wid = __builtin_amdgcn_readfirstlane(tid >> 6), lane = tid & 63, wr = wid >> 2, wc = wid & 3, fr = lane & 15, fq = lane >> 4;
    constexpr int K = KDIM, nt = K / BK;
    unsigned voffA[2], voffB[2];
#pragma unroll
    for (int i = 0; i < 2; ++i) { int R, C; stage_rc(tid * 16 + i * 8192, R, C); const int Rb = Epi::PERM ? ((R & ~31) + perm32(R & 31)) : R;
        voffA[i] = (unsigned)(R * LDA + C) * 2u; voffB[i] = (unsigned)(Rb * LDB + C) * 2u; }
    constexpr size_t kstep = (size_t)(BK * 2);
    constexpr size_t hstepA = (size_t)HALF * LDA * 2, hstepB = (size_t)HALF * LDB * 2;
    constexpr size_t tstepA = 2 * hstepA, tstepB = 2 * hstepB;
    const unsigned ldsw = (unsigned)wid * 1024u;
    const int aoff = lds_byte(wr * 64 + fr, fq * 8), boff = lds_byte(wc * 32 + fr, fq * 8);
#define PG8_SA(b, h) (((b) * 2 + (h)) * HTB)
#define PG8_SB(b, h) ((4 + (b) * 2 + (h)) * HTB)
#define PG8_STAGE(bufoff, gbase, voff) do { _Pragma("unroll") for (int _i = 0; _i < 2; ++_i) \
        __builtin_amdgcn_global_load_lds((const unsigned*)((const char*)(gbase) + (voff)[_i]), (PG8_LAS unsigned*)(lds + (bufoff) + ldsw + _i * 8192), 16, 0, 0); } while (0)
#define PG8_LDA(dst, b, h) do { _Pragma("unroll") for (int m = 0; m < 4; ++m) _Pragma("unroll") for (int k = 0; k < 2; ++k) dst[m][k] = *(const PG8_LAS bf16x8*)(lds + PG8_SA(b, h) + aoff + m * 2048 + k * 1024); } while (0)
#define PG8_LDB(dst, b, h) do { _Pragma("unroll") for (int n = 0; n < 2; ++n) _Pragma("unroll") for (int k = 0; k < 2; ++k) dst[n][k] = *(const PG8_LAS bf16x8*)(lds + PG8_SB(b, h) + boff + n * 2048 + k * 1024); } while (0)
#define PG8_MMA(ai, bj, At, Bt) do { __builtin_amdgcn_s_setprio(1); _Pragma("unroll") for (int m = 0; m < 4; ++m) _Pragma("unroll") for (int n = 0; n < 2; ++n) _Pragma("unroll") for (int k = 0; k < 2; ++k) \
        acc[ai][bj][m][n] = __builtin_amdgcn_mfma_f32_16x16x32_bf16(Bt[n][k], At[m][k], acc[ai][bj][m][n], 0, 0, 0); __builtin_amdgcn_s_setprio(0); } while (0)
#define PG8_WAIT_V(n) asm volatile("s_waitcnt vmcnt(" #n ")" ::: "memory")
#define PG8_WAIT_L(n) asm volatile("s_waitcnt lgkmcnt(" #n ")" ::: "memory")
#define PG8_BAR __builtin_amdgcn_s_barrier()
#define PG8_SCHED __builtin_amdgcn_sched_barrier(0)
    Unit cur, nxt; int ui = 0;
    if (!S.next(0, cur)) return;
    float zf = 0.f; asm volatile("" : "+v"(zf));
    f32x4 acc[2][2][4][2];
#pragma unroll
    for (int a = 0; a < 2; ++a)
#pragma unroll
        for (int b = 0; b < 2; ++b)
#pragma unroll
            for (int m = 0; m < 4; ++m)
#pragma unroll
                for (int n = 0; n < 2; ++n) acc[a][b][m][n] = (f32x4){zf, zf, zf, zf};
    bf16x8 At[4][2], B0[2][2], B1[2][2];
    const char* cA = (const char*)g.A + (size_t)cur.pm * tstepA; const char* cB = (const char*)g.Bt + (size_t)cur.pn * tstepB;
    S.a_ready(cur);
    if constexpr (SP2) {
        PG8_STAGE(PG8_SB(0, 0), cB, voffB); PG8_STAGE(PG8_SB(0, 1), cB + hstepB, voffB); PG8_STAGE(PG8_SA(0, 0), cA, voffA); PG8_STAGE(PG8_SA(0, 1), cA + hstepA, voffA);
        if (wr == 1) PG8_BAR;
        PG8_WAIT_V(2); PG8_BAR;
        PG8_STAGE(PG8_SB(1, 0), cB + kstep, voffB); PG8_STAGE(PG8_SA(1, 0), cA + kstep, voffA); PG8_STAGE(PG8_SB(1, 1), cB + hstepB + kstep, voffB);
        PG8_WAIT_V(6); PG8_BAR;
    } else {
        PG8_STAGE(PG8_SB(0, 0), cB, voffB); PG8_STAGE(PG8_SA(0, 0), cA, voffA); PG8_STAGE(PG8_SB(0, 1), cB + hstepB, voffB); PG8_STAGE(PG8_SA(0, 1), cA + hstepA, voffA);
        if (wr == 1) PG8_BAR;
        PG8_WAIT_V(4); PG8_BAR;
        PG8_STAGE(PG8_SB(1, 0), cB + kstep, voffB); PG8_STAGE(PG8_SA(1, 0), cA + kstep, voffA); PG8_STAGE(PG8_SB(1, 1), cB + hstepB + kstep, voffB);
        PG8_WAIT_V(6); PG8_BAR;
    }
    for (;;) {
        const bool has_next = S.next(ui + 1, nxt);
        const char* nA = has_next ? (const char*)g.A + (size_t)nxt.pm * tstepA : cA; const char* nB = has_next ? (const char*)g.Bt + (size_t)nxt.pn * tstepB : cB;
#pragma nounroll
        for (int t = 0; t < nt; t += 2) {
            const bool last = (t == nt - 2);
            const char* a1 = cA + (size_t)(t + 1) * kstep;
            const char* a2 = last ? nA : cA + (size_t)(t + 2) * kstep; const char* b2 = last ? nB : cB + (size_t)(t + 2) * kstep;
            const char* a3 = a2 + kstep; const char* b3 = b2 + kstep;
            if (last && has_next) S.a_ready(nxt);
            if constexpr (SP2) {
            PG8_LDB(B0, 0, 0); PG8_LDB(B1, 0, 1); PG8_SCHED; PG8_LDA(At, 0, 0); PG8_STAGE(PG8_SA(1, 1), a1 + hstepA, voffA);
            PG8_WAIT_V(8); PG8_WAIT_L(0); PG8_BAR; PG8_MMA(0, 0, At, B0); PG8_MMA(0, 1, At, B1); PG8_BAR; PG8_SCHED;
            PG8_LDA(At, 0, 1); PG8_STAGE(PG8_SB(0, 0), b2, voffB); PG8_STAGE(PG8_SB(0, 1), b2 + hstepB, voffB); PG8_STAGE(PG8_SA(0, 0), a2, voffA);
            PG8_WAIT_V(8); PG8_WAIT_L(0); PG8_BAR; PG8_MMA(1, 0, At, B0); PG8_MMA(1, 1, At, B1); PG8_BAR; PG8_SCHED;
            PG8_LDB(B0, 1, 0); PG8_LDB(B1, 1, 1); PG8_SCHED; PG8_LDA(At, 1, 0); PG8_STAGE(PG8_SA(0, 1), a2 + hstepA, voffA);
            PG8_WAIT_V(8); PG8_WAIT_L(0); PG8_BAR; PG8_MMA(0, 0, At, B0); PG8_MMA(0, 1, At, B1); PG8_BAR; PG8_SCHED;
            PG8_LDA(At, 1, 1); PG8_STAGE(PG8_SB(1, 0), b3, voffB); PG8_STAGE(PG8_SB(1, 1), b3 + hstepB, voffB); PG8_STAGE(PG8_SA(1, 0), a3, voffA);
            PG8_WAIT_V(8); PG8_WAIT_L(0); PG8_BAR; PG8_MMA(1, 0, At, B0); PG8_MMA(1, 1, At, B1); PG8_BAR; PG8_SCHED;
            } else {
            PG8_LDB(B0, 0, 0); PG8_SCHED; PG8_LDA(At, 0, 0); PG8_STAGE(PG8_SA(1, 1), a1 + hstepA, voffA);
            PG8_WAIT_L(8); PG8_BAR; PG8_WAIT_L(0); PG8_MMA(0, 0, At, B0); PG8_BAR; PG8_SCHED;
            PG8_LDB(B1, 0, 1); PG8_STAGE(PG8_SB(0, 0), b2, voffB);
            PG8_BAR; PG8_WAIT_L(0); PG8_MMA(0, 1, At, B1); PG8_BAR;
            PG8_LDA(At, 0, 1); PG8_STAGE(PG8_SA(0, 0), a2, voffA);
            PG8_BAR; PG8_WAIT_L(0); PG8_MMA(1, 0, At, B0); PG8_BAR; PG8_SCHED;
            PG8_STAGE(PG8_SB(0, 1), b2 + hstepB, voffB);
            PG8_WAIT_V(6); PG8_BAR; PG8_MMA(1, 1, At, B1); PG8_BAR;
            PG8_LDB(B0, 1, 0); PG8_SCHED; PG8_LDA(At, 1, 0); PG8_STAGE(PG8_SA(0, 1), a2 + hstepA, voffA);
            PG8_WAIT_L(8); PG8_BAR; PG8_WAIT_L(0); PG8_MMA(0, 0, At, B0); PG8_BAR; PG8_SCHED;
            PG8_LDB(B1, 1, 1); PG8_STAGE(PG8_SB(1, 0), b3, voffB);
            PG8_BAR; PG8_WAIT_L(0); PG8_MMA(0, 1, At, B1); PG8_BAR;
            PG8_LDA(At, 1, 1); PG8_STAGE(PG8_SA(1, 0), a3, voffA);
            PG8_BAR; PG8_WAIT_L(0); PG8_MMA(1, 0, At, B0); PG8_BAR; PG8_SCHED;
            PG8_STAGE(PG8_SB(1, 1), b3 + hstepB, voffB);
            PG8_WAIT_V(6); PG8_BAR; PG8_MMA(1, 1, At, B1); PG8_BAR;
            }
        }
        if constexpr (ALIGN_EPI) { if (wr == 0) PG8_BAR; }
        if constexpr (!Epi::AFTER_DRAIN) { const int t2 = otid(); int fr2 = t2 & 15, fq2 = (t2 >> 4) & 3;
            E(acc, cur, wr, wc, fr2, fq2); S.done(cur); }
        if (!has_next) break;
#pragma unroll
        for (int a = 0; a < 2; ++a)
#pragma unroll
            for (int b = 0; b < 2; ++b)
#pragma unroll
                for (int m = 0; m < 4; ++m)
#pragma unroll
                    for (int n = 0; n < 2; ++n) acc[a][b][m][n] = (f32x4){zf, zf, zf, zf};
        cur = nxt; cA = nA; cB = nB; ++ui;
        if constexpr (ALIGN_EPI) { if (wr == 1) PG8_BAR; }
    }
    PG8_WAIT_V(0);
    if constexpr (!ALIGN_EPI) { if (wr == 0) PG8_BAR; }
    PG8_BAR;
    if constexpr (Epi::AFTER_DRAIN) { E.fused(acc, cur, wr, wc, fr, fq, lds, wid, lane); S.done(cur); }
#undef PG8_SA
#undef PG8_SB
#undef PG8_STAGE
#undef PG8_LDA
#undef PG8_LDB
#undef PG8_MMA
#undef PG8_WAIT_V
#undef PG8_WAIT_L
#undef PG8_BAR
#undef PG8_SCHED
}
}

#define LAS __attribute__((address_space(3)))
typedef unsigned short bf16;
typedef float f32x2 __attribute__((ext_vector_type(2)));
typedef float f32x4 __attribute__((ext_vector_type(4)));
typedef float f32x16 __attribute__((ext_vector_type(16)));
typedef short bf16x8 __attribute__((ext_vector_type(8)));
typedef unsigned u32x4 __attribute__((ext_vector_type(4)));
typedef unsigned u32x2 __attribute__((ext_vector_type(2)));
typedef __bf16 bf16x2_t __attribute__((ext_vector_type(2)));
#define DI __device__ __forceinline__

DI unsigned pk2(float lo, float hi) { f32x2 v = {lo, hi}; bf16x2_t b = __builtin_convertvector(v, bf16x2_t); return __builtin_bit_cast(unsigned, b); }
DI float bflo(unsigned u) { return __uint_as_float(u << 16); }
DI float bfhi(unsigned u) { return __uint_as_float(u & 0xffff0000u); }
DI u32x4 pack8(f32x4 a, f32x4 b) { u32x4 w; w.x = pk2(a[0], a[1]); w.y = pk2(a[2], a[3]); w.z = pk2(b[0], b[1]); w.w = pk2(b[2], b[3]); return w; }
DI float shx(float v, int m) { const int l = (otid() & 63) ^ m; return __builtin_bit_cast(float, __builtin_amdgcn_ds_bpermute(l << 2, __builtin_bit_cast(int, v))); }
DI float wave_sum(float v) {
#pragma unroll
    for (int o = 1; o < 64; o <<= 1) v += shx(v, o);
    return v;
}
DI float ozero() { float z = 0.f; asm volatile("" : "+v"(z)); return z; }
DI float cos_turn(float t) { return __builtin_amdgcn_cosf(t); }
DI float sin_turn(float t) { return __builtin_amdgcn_sinf(t); }
DI float fexp2(float x) { return __builtin_amdgcn_exp2f(x); }
DI float frcp(float x) { return __builtin_amdgcn_rcpf(x); }
#define LDS_WAIT() asm volatile("s_waitcnt lgkmcnt(0)" ::: "memory")

constexpr int DM = 1024, NB = 8, SEQ = 2048, DEPTH = 4, CTXL = 256;
constexpr int NLAT = NB * SEQ, NCTX = NB * CTXL, MTOK = NLAT + NCTX;
constexpr int NPROJ = 1536, DFF = 2816, MIXD = 1280, NKEY = SEQ + CTXL;
constexpr int PO_KR = 384, PO_SU = 416, PO_SV = 672, PO_POOL = 928, PO_F = 1184, IN_DIM = 1440;
constexpr float LN_EPS = 1e-6f;
constexpr float ALPHA = 1.6817928305074290f;
constexpr float QSCALE = 0.10206207261596575f * 1.4426950408889634f;

constexpr size_t WS_XRES = 0;
constexpr size_t WS_HA   = WS_XRES + (size_t)MTOK * DM * 4;
constexpr size_t WS_PROJ = WS_HA + (size_t)MTOK * DM * 2;
constexpr size_t WS_QLAT = WS_PROJ + (size_t)MTOK * NPROJ * 2;
constexpr size_t WS_QCTX = WS_QLAT + (size_t)64 * SEQ * 96 * 2;
constexpr size_t WS_K    = WS_QCTX + (size_t)64 * CTXL * 96 * 2;
constexpr size_t WS_VT   = WS_K + (size_t)64 * NKEY * 96 * 2;
constexpr size_t WS_U    = WS_PROJ;
static_assert((size_t)MTOK * DFF * 2 <= WS_VT - WS_PROJ, "U overlay");
constexpr size_t WS_GTL  = WS_VT + (size_t)64 * 64 * NKEY * 2;
constexpr size_t WS_GTC  = WS_GTL + (size_t)2048 * 4096 * 2;
constexpr size_t WS_MIX  = WS_GTC + (size_t)2048 * 512 * 2;
constexpr size_t WS_WIN  = WS_MIX + (size_t)MTOK * MIXD * 2;
constexpr size_t WS_WQK  = WS_WIN + (size_t)1536 * 1024 * 2;
constexpr size_t WS_WV   = WS_WQK + (size_t)1280 * 384 * 2;
constexpr size_t WS_WF   = WS_WV + (size_t)512 * 384 * 2;
constexpr size_t WS_WOUT = WS_WF + (size_t)512 * 256 * 2;
constexpr size_t WS_W13  = WS_WOUT + (size_t)1024 * 1280 * 2;
constexpr size_t WS_W2   = WS_W13 + (size_t)5632 * 1024 * 2;
constexpr size_t WS_WPOOL= WS_W2 + (size_t)1024 * 2816 * 2;
constexpr size_t WS_WS   = WS_WPOOL + (size_t)4 * 64 * 64 * 2;
constexpr size_t WS_CSL  = WS_WS + (size_t)4 * 128 * 128 * 2;
constexpr size_t WS_CSC  = WS_CSL + (size_t)2048 * 4096 * 2;
constexpr size_t WS_MOD  = WS_CSC + (size_t)256 * 512 * 2;
constexpr size_t WS_ROPE = WS_MOD + (size_t)4 * 9 * 6144 * 4;
constexpr size_t WS_STQ  = WS_ROPE + (size_t)2048 * 32 * 4;
constexpr size_t WS_STKV = WS_STQ + (size_t)MTOK * 4 * 4;
constexpr size_t WS_ST   = WS_STKV + (size_t)MTOK * 4 * 4;
constexpr size_t WS_XBE  = WS_ST + (size_t)MTOK * 2 * 4;
constexpr size_t WS_XBH  = WS_XBE + (size_t)72 * 256 * 4 * 8;
constexpr size_t WS_CTL  = WS_XBH + (size_t)72 * 256 * 4 * 8;
constexpr size_t CTL_BYTES = 32768;
constexpr size_t WS_END  = WS_CTL + CTL_BYTES;
constexpr int MISC_OFF = 139264;

constexpr int LDS_BYTES = 147456;

struct Params { const float* in[27]; float* out; unsigned char* ws; int ph_lo, ph_hi; };
DI const float* inp(const Params& p, int i) { asm volatile("" : "+s"(i)); return p.in[i]; }
DI unsigned char* wsp(const Params& p) { unsigned char* w = p.ws; asm volatile("" : "+s"(w)); return w; }

#define XB_TMO      128
#define XB_XCNT(j)  (256  + 64 * (j))
#define XB_XSUB(j)  (1280 + 64 * (j))
#define XB_XGEN(j)  (2304 + 64 * (j))
#define XB_TOP      3328
#define XB_TOPGEN   3392
#define XCD_BAR_WORDS 3456
#define XB_SPIN_CAP (1u << 18)

__device__ __forceinline__ unsigned xb_ld(unsigned* p)              { return __hip_atomic_load(p, __ATOMIC_RELAXED, __HIP_MEMORY_SCOPE_AGENT); }
__device__ __forceinline__ unsigned xb_add(unsigned* p, unsigned v) { return __hip_atomic_fetch_add(p, v, __ATOMIC_RELAXED, __HIP_MEMORY_SCOPE_AGENT); }
__device__ __forceinline__ unsigned xb_xcc_id() { return (unsigned)__builtin_amdgcn_s_getreg((3 << 11) | 20) & 0xFu; }
#define XB_SPIN(cond, bar) do { unsigned _sp = 0; while (cond) { __builtin_amdgcn_s_sleep(1); \
    if ((++_sp & 255u) == 0u) { if (xb_ld(&(bar)[XB_TMO])) break; if (_sp > XB_SPIN_CAP) { atomicAdd(&(bar)[XB_TMO], 1u); break; } } } } while (0)

struct XcdBarrier {
    unsigned* bar; unsigned x;
    volatile LAS unsigned* st;
};

__device__ __forceinline__ XcdBarrier xcd_barrier_post(unsigned* bar, volatile LAS unsigned* st) {
    XcdBarrier b; b.bar = bar; b.x = xb_xcc_id(); b.st = st;
    if (threadIdx.x == 0) (void)xb_add(&bar[XB_XCNT(b.x)], 1u);
    return b;
}
__device__ __forceinline__ void xcd_barrier_complete(unsigned* bar, unsigned x, unsigned& nloc, unsigned& nx) {
    const unsigned G = gridDim.x * gridDim.y * gridDim.z;
    unsigned sum, cnt, mine, sp = 0u;
    for (;;) {
        sum = 0u; cnt = 0u; mine = 0u;
#pragma unroll
        for (unsigned j = 0; j < 16; ++j) { const unsigned c = xb_ld(&bar[XB_XCNT(j)]); sum += c; cnt += (c > 0u) ? 1u : 0u; mine = (j == x) ? c : mine; }
        if (sum == G) break;
        __builtin_amdgcn_s_sleep(1);
        if ((++sp & 255u) == 0u) { if (xb_ld(&bar[XB_TMO])) break; if (sp > XB_SPIN_CAP) { atomicAdd(&bar[XB_TMO], 1u); break; } }
    }
    nloc = mine > 0u ? mine : 1u; nx = cnt > 0u ? cnt : 1u;
}

__device__ __forceinline__ void xcd_barrier(const XcdBarrier& b) {
    asm volatile("s_waitcnt vmcnt(0)" ::: "memory");
    __syncthreads();
    if (threadIdx.x == 0) {
        unsigned* bar = b.bar;
        __builtin_amdgcn_s_waitcnt(0);
        unsigned nloc = b.st[0], nx = b.st[1];
        if (nloc == 0u) { xcd_barrier_complete(bar, b.x, nloc, nx); b.st[0] = nloc; b.st[1] = nx; }
        const unsigned old = xb_add(&bar[XB_XSUB(b.x)], 1u);
        const unsigned gen = old / nloc;
        if (old + 1u == (gen + 1u) * nloc) {
            __builtin_amdgcn_fence(__ATOMIC_RELEASE, "agent");
            asm volatile("s_waitcnt vmcnt(0)" ::: "memory");
            const unsigned og = xb_add(&bar[XB_TOP], 1u);
            const unsigned tg = og / nx;
            if (og + 1u == (tg + 1u) * nx) xb_add(&bar[XB_TOPGEN], 1u);
            else XB_SPIN(xb_ld(&bar[XB_TOPGEN]) == tg, bar);
            __builtin_amdgcn_fence(__ATOMIC_ACQUIRE, "agent");
            xb_add(&bar[XB_XGEN(b.x)], 1u);
            asm volatile("s_waitcnt vmcnt(0)" ::: "memory");
        } else {
            XB_SPIN(xb_ld(&bar[XB_XGEN(b.x)]) == gen, bar);
            __builtin_amdgcn_fence(__ATOMIC_ACQUIRE, "agent");
            asm volatile("s_waitcnt vmcnt(0)" ::: "memory");
        }
    }
    __syncthreads();
}

typedef pg8::f32x4 A4;
DI void row_info(int row, int& b, int& pos, bool& lat) { lat = row < NLAT; if (lat) { b = row >> 11; pos = row & 2047; } else { b = (row - NLAT) >> 8; pos = (row - NLAT) & 255; } }

struct EpiProj {
    static constexpr bool PERM = true, AFTER_DRAIN = false;
    bf16* O; float* statq; float* statkv;
    DI void operator()(const A4 (&acc)[2][2][4][2], const pg8::Unit& u, int wr, int wc, int fr, int fq) const {
        const int row0 = u.pm * 256 + wr * 64 + fr, col0 = u.pn * 256 + wc * 32 + 8 * fq;
#pragma unroll
        for (int ai = 0; ai < 2; ++ai)
#pragma unroll
            for (int m = 0; m < 4; ++m) {
                const int row = row0 + ai * 128 + m * 16;
                bf16* rowp = O + (size_t)row * NPROJ + col0;
#pragma unroll
                for (int bj = 0; bj < 2; ++bj) *(u32x4*)(rowp + bj * 128) = pack8(acc[ai][bj][m][0], acc[ai][bj][m][1]);
                if (u.pn <= 1) {
                    float s = 0.f;
#pragma unroll
                    for (int bj = 0; bj < 2; ++bj) {
                        if (u.pn == 1 && bj == 1) continue;
#pragma unroll
                        for (int n = 0; n < 2; ++n) { const A4 x = acc[ai][bj][m][n]; s += (x[0] * x[0] + x[1] * x[1]) + (x[2] * x[2] + x[3] * x[3]); }
                    }
                    s += shx(s, 16); s += shx(s, 32);
                    if (fq == 0) { if (u.pn == 0) statq[row * 4 + wc] = s; else statkv[row * 4 + wc] = s; }
                }
            }
    }
};

struct EpiQK {
    static constexpr bool PERM = true, AFTER_DRAIN = false;
    bf16* Ql; bf16* Qc; bf16* Kb; const float* statq; const float* statkv; const float* rope;
    DI void operator()(const A4 (&acc)[2][2][4][2], const pg8::Unit& u, int wr, int wc, int fr, int fq) const {
        const int row0 = u.pm * 256 + wr * 64 + fr, col0 = u.pn * 256 + wc * 32 + 8 * fq;
        const bool isq = u.pn < 3;
#pragma unroll
        for (int ai = 0; ai < 2; ++ai)
#pragma unroll
            for (int m = 0; m < 4; ++m) {
                const int row = row0 + ai * 128 + m * 16;
                int b, pos; bool lat; row_info(row, b, pos, lat);
                const f32x4 st = *(const f32x4*)((isq ? statq : statkv) + row * 4);
                const float ss = (st[0] + st[1]) + (st[2] + st[3]);
                const float rs = isq ? rsqrtf(ss * (1.f / 256.f) + LN_EPS) * QSCALE : rsqrtf(ss * (1.f / 128.f) + LN_EPS);
#pragma unroll
                for (int bj = 0; bj < 2; ++bj) {
                    const int c = col0 + bj * 128;
                    A4 v0 = acc[ai][bj][m][0] * rs, v1 = acc[ai][bj][m][1] * rs;
                    if (isq) {
                        const int g32 = c >> 5, head = g32 / 3, part = g32 - head * 3, d0 = part * 32 + 8 * fq;
                        if (part == 2 && lat) {
                            A4 p0, p1;
#pragma unroll
                            for (int j = 0; j < 4; ++j) { p0[j] = shx(v0[j], 16); p1[j] = shx(v1[j], 16); }
                            const float* rp = rope + pos * 32 + (fq >> 1) * 8;
                            const f32x4 c0 = *(const f32x4*)rp, c1 = *(const f32x4*)(rp + 4), s0 = *(const f32x4*)(rp + 16), s1 = *(const f32x4*)(rp + 20);
                            if (fq & 1) { v0 = p0 * s0 + v0 * c0; v1 = p1 * s1 + v1 * c1; }
                            else        { v0 = v0 * c0 - p0 * s0; v1 = v1 * c1 - p1 * s1; }
                        }
                        bf16* dst = lat ? Ql + ((size_t)(b * 8 + head) * SEQ + pos) * 96 + d0 : Qc + ((size_t)(b * 8 + head) * CTXL + pos) * 96 + d0;
                        *(u32x4*)dst = pack8(v0, v1);
                    } else {
                        const int cc = c - 768, head = cc >> 6, d0 = cc & 63;
                        bf16* dst = Kb + ((size_t)(b * 8 + head) * NKEY + (lat ? CTXL + pos : pos)) * 96 + d0;
                        *(u32x4*)dst = pack8(v0, v1);
                    }
                }
            }
    }
};

DI float rstd_kv_tok(const float* statkv, int t) { const f32x4 st = *(const f32x4*)(statkv + t * 4); return rsqrtf(((st[0] + st[1]) + (st[2] + st[3])) * (1.f / 128.f) + LN_EPS); }

struct EpiVt {
    static constexpr bool PERM = true, AFTER_DRAIN = false;
    bf16* Vt; const float* statkv;
    DI void operator()(const A4 (&acc)[2][2][4][2], const pg8::Unit& u, int wr, int wc, int fr, int fq) const {
        const int row0 = u.pm * 256 + wr * 64 + fr, col0 = u.pn * 256 + wc * 32 + 8 * fq;
#pragma unroll
        for (int bj = 0; bj < 2; ++bj) {
            const int t0 = col0 + bj * 128;
            int b, pos; bool lat; row_info(t0, b, pos, lat);
            A4 r0, r1;
#pragma unroll
            for (int j = 0; j < 4; ++j) { r0[j] = rstd_kv_tok(statkv, t0 + j); r1[j] = rstd_kv_tok(statkv, t0 + 4 + j); }
#pragma unroll
            for (int ai = 0; ai < 2; ++ai)
#pragma unroll
                for (int m = 0; m < 4; ++m) {
                    const int row = row0 + ai * 128 + m * 16, head = row >> 6, dv = row & 63;
                    bf16* dst = Vt + ((size_t)(b * 8 + head) * 64 + dv) * NKEY + (lat ? CTXL + pos : pos);
                    *(u32x4*)dst = pack8(acc[ai][bj][m][0] * r0, acc[ai][bj][m][1] * r1);
                }
        }
    }
};

struct EpiGt {
    static constexpr bool PERM = true, AFTER_DRAIN = false;
    bf16* Gl; bf16* Gc;
    DI void operator()(const A4 (&acc)[2][2][4][2], const pg8::Unit& u, int wr, int wc, int fr, int fq) const {
        const int row0 = u.pm * 256 + wr * 64 + fr, col0 = u.pn * 256 + wc * 32 + 8 * fq;
#pragma unroll
        for (int bj = 0; bj < 2; ++bj) {
            const int t0 = col0 + bj * 128;
            int b, pos; bool lat; row_info(t0, b, pos, lat);
#pragma unroll
            for (int ai = 0; ai < 2; ++ai)
#pragma unroll
                for (int m = 0; m < 4; ++m) {
                    const int row = row0 + ai * 128 + m * 16, n = row & 255, half = row >> 8;
                    bf16* dst = lat ? Gl + (size_t)(b * 256 + n) * 4096 + half * 2048 + pos : Gc + (size_t)(b * 256 + n) * 512 + half * 256 + pos;
                    *(u32x4*)dst = pack8(acc[ai][bj][m][0], acc[ai][bj][m][1]);
                }
        }
    }
};

struct EpiDft {
    static constexpr bool PERM = true, AFTER_DRAIN = false;
    bf16* mix; int row_base, rows_per_b;
    DI void operator()(const A4 (&acc)[2][2][4][2], const pg8::Unit& u, int wr, int wc, int fr, int fq) const {
        const int row0 = u.pm * 256 + wr * 64 + fr, n0 = wc * 32 + 8 * fq;
#pragma unroll
        for (int ai = 0; ai < 2; ++ai)
#pragma unroll
            for (int m = 0; m < 4; ++m) {
                const int k = row0 + ai * 128 + m * 16;
                bf16* rowp = mix + (size_t)(row_base + u.pn * rows_per_b + k) * MIXD + 1024 + n0;
#pragma unroll
                for (int bj = 0; bj < 2; ++bj) *(u32x4*)(rowp + bj * 128) = pack8(acc[ai][bj][m][0], acc[ai][bj][m][1]);
            }
    }
};

struct EpiRes {
    static constexpr bool PERM = true, AFTER_DRAIN = false;
    const float* Xin; float* Xout; const float* ST; const float* lg; const float* lb; const float* modl; int goff; int pm_off;
    DI void operator()(const A4 (&acc)[2][2][4][2], const pg8::Unit& u, int wr, int wc, int fr, int fq) const {
        const int row0 = u.pm * 256 + wr * 64 + fr, col0 = u.pn * 256 + wc * 32 + 8 * fq;
        const int bidx = (u.pm + pm_off < 64) ? ((u.pm + pm_off) >> 3) : 8;
        const float* gp = modl + bidx * 6144 + goff + col0;
        const bool has_ln = lg != nullptr;
#pragma unroll
        for (int bj = 0; bj < 2; ++bj) {
            const f32x4 g0 = *(const f32x4*)(gp + bj * 128), g1 = *(const f32x4*)(gp + bj * 128 + 4);
            f32x4 ga0 = (f32x4){ALPHA, ALPHA, ALPHA, ALPHA}, ga1 = ga0, be0 = (f32x4){0.f, 0.f, 0.f, 0.f}, be1 = be0;
            if (has_ln) { ga0 = *(const f32x4*)(lg + col0 + bj * 128) * ALPHA; ga1 = *(const f32x4*)(lg + col0 + bj * 128 + 4) * ALPHA;
                          be0 = *(const f32x4*)(lb + col0 + bj * 128) * ALPHA; be1 = *(const f32x4*)(lb + col0 + bj * 128 + 4) * ALPHA; }
            f32x4 x0[8], x1[8]; f32x2 st[8];
#define EPR_ROW(q) (row0 + ((q) >> 2) * 128 + ((q) & 3) * 16)
#define EPR_LOAD(q) do { const float* rin = Xin + (size_t)EPR_ROW(q) * DM + col0 + bj * 128; x0[q] = *(const f32x4*)rin; x1[q] = *(const f32x4*)(rin + 4); \
                         st[q] = has_ln ? *(const f32x2*)(ST + 2 * EPR_ROW(q)) : (f32x2){0.f, 1.f}; } while (0)
            EPR_LOAD(0); EPR_LOAD(1);
#pragma unroll
            for (int q = 0; q < 8; ++q) {
                if (q + 2 < 8) EPR_LOAD(q + 2);
                float* rout = Xout + (size_t)EPR_ROW(q) * DM + col0 + bj * 128;
                *(f32x4*)rout = (x0[q] - st[q][0]) * st[q][1] * ga0 + be0 + g0 * acc[q >> 2][bj][q & 3][0];
                *(f32x4*)(rout + 4) = (x1[q] - st[q][0]) * st[q][1] * ga1 + be1 + g1 * acc[q >> 2][bj][q & 3][1];
                __builtin_amdgcn_sched_barrier(0);
            }
#undef EPR_LOAD
#undef EPR_ROW
        }
    }
};

DI f32x4 silu4(f32x4 a) { f32x4 r; for (int j = 0; j < 4; ++j) r[j] = a[j] * frcp(1.f + fexp2(-1.4426950408889634f * a[j])); return r; }
struct EpiSwiglu {
    static constexpr bool PERM = true, AFTER_DRAIN = false;
    bf16* U;
    DI void operator()(const A4 (&acc)[2][2][4][2], const pg8::Unit& u, int wr, int wc, int fr, int fq) const {
        const int row0 = u.pm * 256 + wr * 64 + fr, col0 = u.pn * 128 + wc * 32 + 8 * fq;
#pragma unroll
        for (int ai = 0; ai < 2; ++ai)
#pragma unroll
            for (int m = 0; m < 4; ++m) {
                const f32x4 h0 = silu4(acc[ai][0][m][0]) * acc[ai][1][m][0], h1 = silu4(acc[ai][0][m][1]) * acc[ai][1][m][1];
                *(u32x4*)(U + (size_t)(row0 + ai * 128 + m * 16) * DFF + col0) = pack8(h0, h1);
            }
    }
};

template <int M, int N> struct StaticOrderT {
    static constexpr int nM = M / 256, nN = N / 256, nwg = nM * nN;
    int G, c;
    static DI void map(int L, pg8::Unit& u) {
        int wgid = L; { constexpr int q = nwg / 8, r = nwg % 8; const int xcd = wgid % 8, off = wgid / 8; wgid = (xcd < r ? xcd * (q + 1) : r * (q + 1) + (xcd - r) * q) + off; }
        constexpr int nig = 8 * nN; const int gid = wgid / nig, fm = gid * 8, gsz = (nM - fm) < 8 ? (nM - fm) : 8;
        if constexpr (nM % 8 == 0) { u.pm = fm + ((wgid % nig) & 7); u.pn = (wgid % nig) >> 3; }
        else { u.pm = fm + ((wgid % nig) % gsz); u.pn = (wgid % nig) / gsz; }
    }
    DI bool next(int i, pg8::Unit& u) const { const int L = i * G + c; if (L >= nwg) return false; map(L, u); return true; }
    DI void a_ready(const pg8::Unit&) const {}
    DI void done(const pg8::Unit&) const {}
};
constexpr int CW_GCTX = 3584;
struct SchedG {
    int c; unsigned* cnt;
    DI bool next(int i, pg8::Unit& u) const {
        int L;
        if (c < 224) { L = c + 224 * i; if (L >= 1456) return false; }
        else { if (i >= 4) return false; L = 1456 + (c - 224) + 32 * i; }
        if (L < 176) { u.pm = 64 + (L & 7); u.pn = L >> 3; }
        else StaticOrderT<NLAT, 2 * DFF>::map(L - 176, u);
        return true;
    }
    DI void a_ready(const pg8::Unit&) const {}
    DI void done(const pg8::Unit& u) const {
        if (u.pm >= 64) {
            asm volatile("s_waitcnt vmcnt(0)" ::: "memory");
            __syncthreads();
            if (otid() == 0) { __builtin_amdgcn_fence(__ATOMIC_RELEASE, "agent"); asm volatile("s_waitcnt vmcnt(0)" ::: "memory"); (void)xb_add(cnt, 1u); }
        }
    }
};
constexpr int CW_ECTX = 3648;
DI void publish_block(unsigned* cnt) {
    asm volatile("s_waitcnt vmcnt(0)" ::: "memory");
    __syncthreads();
    if (otid() == 0) { __builtin_amdgcn_fence(__ATOMIC_RELEASE, "agent"); asm volatile("s_waitcnt vmcnt(0)" ::: "memory"); (void)xb_add(cnt, 1u); }
}
template <int M, int N> struct StaticOrderSig {
    int G, c; unsigned* cnt;
    DI bool next(int i, pg8::Unit& u) const { const int L = i * G + c; if (L >= StaticOrderT<M, N>::nwg) return false; StaticOrderT<M, N>::map(L, u); return true; }
    DI void a_ready(const pg8::Unit&) const {}
    DI void done(const pg8::Unit&) const { publish_block(cnt); }
};
constexpr int CW_QUAD_E = 4096, CW_QUAD_H = 4096 + 72 * 16;
DI void quad_wait(unsigned* cnt, unsigned target) {
    publish_block(cnt);
    if (otid() == 0) { unsigned sp = 0; while (xb_ld(cnt) < target) { __builtin_amdgcn_s_sleep(1); if (++sp > (1u << 22)) break; }
        __builtin_amdgcn_fence(__ATOMIC_ACQUIRE, "agent"); asm volatile("s_waitcnt vmcnt(0)" ::: "memory"); }
    __syncthreads();
}
struct EpiResLN {
    static constexpr bool PERM = true, AFTER_DRAIN = false;
    const Params& p; int l, kind  , ctx  ; bool lastl; LAS unsigned char* lds;
    DI void operator()(const A4 (&acc)[2][2][4][2], const pg8::Unit& u, int wr, int wc, int fr, int fq) const {
        unsigned char* ws = wsp(p);
        const int roff = ctx ? NLAT : 0, pm_off = ctx ? 64 : 0;
        float* XRESp = (float*)(ws + WS_XRES) + (size_t)roff * DM; float* STp = (float*)(ws + WS_ST) + 2 * roff; bf16* HAp = (bf16*)(ws + WS_HA) + (size_t)roff * DM;
        const float* modl = (const float*)(ws + WS_MOD) + (size_t)l * 9 * 6144;
        const float* Xin = (kind == 0 && l == 0) ? (ctx ? inp(p, 2) : inp(p, 0)) : XRESp; float* Xout = XRESp; const float* STin = STp; float* STout = STp;
        const float* lg = (kind == 0) ? (l == 0 ? nullptr : inp(p, 25) + (l - 1) * DM) : inp(p, 20) + l * DM;
        const float* lb = (kind == 0) ? (l == 0 ? nullptr : inp(p, 26) + (l - 1) * DM) : inp(p, 21) + l * DM;
        const int goff = (kind == 0) ? 2048 : 5120;
        const float* lg2 = (kind == 0) ? inp(p, 20) + l * DM : inp(p, 25) + l * DM; const float* lb2 = (kind == 0) ? inp(p, 21) + l * DM : inp(p, 26) + l * DM;
        const bool to_out = (kind == 1) && lastl;
        bf16* HAo = to_out ? nullptr : HAp; float* OUTo = to_out ? p.out : nullptr;
        const float* mod2 = (kind == 0 || lastl) ? modl : modl + 9 * 6144; const int sc_off = (kind == 0) ? 4096 : 1024, sh_off = (kind == 0) ? 3072 : 0;
        float* XB = (float*)(ws + (kind == 0 ? WS_XBE : WS_XBH)); unsigned* cnt = (unsigned*)(ws + WS_CTL) + (kind == 0 ? CW_QUAD_E : CW_QUAD_H); const unsigned target = 4u * (unsigned)(l + 1);
        const int urow0 = u.pm * 256 + wr * 64, ucol0 = u.pn * 256 + wc * 32, col0 = ucol0 + 8 * fq;
        const unsigned loff = (unsigned)(fr * DM + 8 * fq);
        const int bidx = (u.pm + pm_off < 64) ? ((u.pm + pm_off) >> 3) : 8;
        const float* gp = modl + bidx * 6144 + goff + col0;
        const bool has_ln = lg != nullptr;
        A4 y[2][2][4][2];
#define EPR_UROW(q) (urow0 + ((q) >> 2) * 128 + ((q) & 3) * 16)
#define EPR_ROW(q) (EPR_UROW(q) + fr)
#pragma unroll
        for (int bj = 0; bj < 2; ++bj) {
            const f32x4 g0 = *(const f32x4*)(gp + bj * 128), g1 = *(const f32x4*)(gp + bj * 128 + 4);
            f32x4 ga0 = (f32x4){ALPHA, ALPHA, ALPHA, ALPHA}, ga1 = ga0, be0 = (f32x4){0.f, 0.f, 0.f, 0.f}, be1 = be0;
            if (has_ln) { ga0 = *(const f32x4*)(lg + col0 + bj * 128) * ALPHA; ga1 = *(const f32x4*)(lg + col0 + bj * 128 + 4) * ALPHA;
                          be0 = *(const f32x4*)(lb + col0 + bj * 128) * ALPHA; be1 = *(const f32x4*)(lb + col0 + bj * 128 + 4) * ALPHA; }
#pragma unroll
            for (int q = 0; q < 8; ++q) {
                const float* rin = Xin + ((size_t)EPR_UROW(q) * DM + ucol0 + bj * 128) + loff; float* rout = Xout + ((size_t)EPR_UROW(q) * DM + ucol0 + bj * 128) + loff;
                const f32x4 x0 = *(const f32x4*)rin, x1 = *(const f32x4*)(rin + 4);
                f32x2 st = (f32x2){0.f, 1.f}; if (has_ln) st = *(const f32x2*)(STin + 2 * EPR_ROW(q));
                const f32x4 y0 = (x0 - st[0]) * st[1] * ga0 + be0 + g0 * acc[q >> 2][bj][q & 3][0];
                const f32x4 y1 = (x1 - st[0]) * st[1] * ga1 + be1 + g1 * acc[q >> 2][bj][q & 3][1];
                y[q >> 2][bj][q & 3][0] = y0; y[q >> 2][bj][q & 3][1] = y1;
                *(f32x4*)rout = y0; *(f32x4*)(rout + 4) = y1;
            }
        }
        LAS f32x2* P = (LAS f32x2*)(lds + 131072);
        LAS f32x2* S2 = (LAS f32x2*)(lds + MISC_OFF + 512);
#pragma unroll
        for (int q = 0; q < 8; ++q) {
            const int ai = q >> 2, m = q & 3;
            float s = 0.f;
#pragma unroll
            for (int bj = 0; bj < 2; ++bj)
#pragma unroll
                for (int n = 0; n < 2; ++n) { const A4 v = y[ai][bj][m][n]; s += (v[0] + v[1]) + (v[2] + v[3]); }
            s += shx(s, 16); s += shx(s, 32);
            const float mw = s * (1.f / 64.f); float qq = 0.f;
#pragma unroll
            for (int bj = 0; bj < 2; ++bj)
#pragma unroll
                for (int n = 0; n < 2; ++n) { const A4 d = y[ai][bj][m][n] - mw; qq += (d[0] * d[0] + d[1] * d[1]) + (d[2] * d[2] + d[3] * d[3]); }
            qq += shx(qq, 16); qq += shx(qq, 32);
            if (fq == 0) P[(ai * 128 + wr * 64 + m * 16 + fr) * 4 + wc] = (f32x2){mw, qq};
        }
        __syncthreads();
        const int t = otid(), panel = u.pm + pm_off;
        f32x2* xb = (f32x2*)XB + ((size_t)panel * 256) * 4;
        if (t < 256) {
            const f32x2 a = P[t * 4], b = P[t * 4 + 1], c = P[t * 4 + 2], d = P[t * 4 + 3];
            const float mb = (a[0] + b[0] + c[0] + d[0]) * 0.25f;
            const float m2 = (a[1] + b[1] + c[1] + d[1]) + 64.f * ((a[0] - mb) * (a[0] - mb) + (b[0] - mb) * (b[0] - mb) + (c[0] - mb) * (c[0] - mb) + (d[0] - mb) * (d[0] - mb));
            xb[t * 4 + u.pn] = (f32x2){mb, m2};
        }
        quad_wait(cnt + 16 * panel, target);
        if (t < 256) {
            const f32x2 a = xb[t * 4], b = xb[t * 4 + 1], c = xb[t * 4 + 2], d = xb[t * 4 + 3];
            const float mean = (a[0] + b[0] + c[0] + d[0]) * 0.25f;
            const float m2 = (a[1] + b[1] + c[1] + d[1]) + 256.f * ((a[0] - mean) * (a[0] - mean) + (b[0] - mean) * (b[0] - mean) + (c[0] - mean) * (c[0] - mean) + (d[0] - mean) * (d[0] - mean));
            const f32x2 st = (f32x2){mean, rsqrtf(m2 * (1.f / DM) + LN_EPS)};
            S2[t] = st;
            if (u.pn == 0) *(f32x2*)(STout + 2 * (u.pm * 256 + t)) = st;
        }
        __syncthreads();
        const float* mp = mod2 + bidx * 6144 + col0;
#pragma unroll
        for (int bj = 0; bj < 2; ++bj) {
            const f32x4 l0 = *(const f32x4*)(lg2 + col0 + bj * 128), l1 = *(const f32x4*)(lg2 + col0 + bj * 128 + 4);
            const f32x4 b0 = *(const f32x4*)(lb2 + col0 + bj * 128), b1 = *(const f32x4*)(lb2 + col0 + bj * 128 + 4);
            f32x4 sc0 = (f32x4){0.f, 0.f, 0.f, 0.f}, sc1 = sc0, sh0 = sc0, sh1 = sc0;
            if (HAo) { sc0 = *(const f32x4*)(mp + sc_off + bj * 128); sc1 = *(const f32x4*)(mp + sc_off + bj * 128 + 4); sh0 = *(const f32x4*)(mp + sh_off + bj * 128); sh1 = *(const f32x4*)(mp + sh_off + bj * 128 + 4); }
#pragma unroll
            for (int q = 0; q < 8; ++q) {
                const f32x2 st = S2[(q >> 2) * 128 + wr * 64 + (q & 3) * 16 + fr];
                const f32x4 x0 = (y[q >> 2][bj][q & 3][0] - st[0]) * st[1] * l0 + b0, x1 = (y[q >> 2][bj][q & 3][1] - st[0]) * st[1] * l1 + b1;
                if (HAo) *(u32x4*)(HAo + ((size_t)EPR_UROW(q) * DM + ucol0 + bj * 128) + loff) = pack8(x0 * (sc0 + 1.f) + sh0, x1 * (sc1 + 1.f) + sh1);
                else { float* o = OUTo + ((size_t)EPR_UROW(q) * DM + ucol0 + bj * 128) + loff; *(f32x4*)o = x0; *(f32x4*)(o + 4) = x1; }
            }
        }
#undef EPR_ROW
#undef EPR_UROW
        __syncthreads();
    }
};
struct SchedHC {
    int c; unsigned* cnt; unsigned target;
    DI bool next(int i, pg8::Unit& u) const { if (i > 0 || c < 224 || c >= 256) return false; const int k = c - 224; u.pm = k & 7; u.pn = k >> 3; return true; }
    DI void a_ready(const pg8::Unit&) const {
        if (otid() == 0) { unsigned sp = 0; while (xb_ld(cnt) < target) { __builtin_amdgcn_s_sleep(1); if (++sp > (1u << 22)) break; }
            __builtin_amdgcn_fence(__ATOMIC_ACQUIRE, "agent"); asm volatile("s_waitcnt vmcnt(0)" ::: "memory"); }
        __syncthreads();
    }
    DI void done(const pg8::Unit&) const {}
};
template <int LDA, int LDB, int KDIM, class Sched, class Epi> DI void run_gemm_s(LAS unsigned char* lds, const bf16* A, const bf16* Bt, int M, int N, const Sched& S, const Epi& E) {
    pg8::Gemm g{A, Bt, M, N};
    pg8::gemm_phase<Epi, Sched, true, true, LDA, LDB, KDIM>(lds, g, S, E);
    __syncthreads();
}
template <int LDA, int LDB, int KDIM, int M, int N, class Epi> DI void run_gemm(LAS unsigned char* lds, const bf16* A, const bf16* Bt, int G, int c, const Epi& E) {
    pg8::Gemm g{A, Bt, M, N};
    StaticOrderT<M, N> S; S.G = G; S.c = c;
    pg8::gemm_phase<Epi, StaticOrderT<M, N>, true, true, LDA, LDB, KDIM>(lds, g, S, E);
    __syncthreads();
}

template <int NR> DI void row_pass_n(const float* const (&src)[NR], const float* lg, const float* lb, float* const (&dstx)[NR], bf16* const (&dsth)[NR],
                                     const float* const (&sc)[NR], const float* const (&sh)[NR], float* const (&stat)[NR], bool has_stat, bool has_x, bool has_h, int lane) {
    f32x4 v[NR][4]; float s[NR];
#pragma unroll
    for (int r = 0; r < NR; ++r) { const f32x4* xr = (const f32x4*)src[r] + lane; s[r] = 0.f;
#pragma unroll
        for (int j = 0; j < 4; ++j) { v[r][j] = xr[64 * j]; } }
    if (lg) {
#pragma unroll
        for (int r = 0; r < NR; ++r)
#pragma unroll
            for (int j = 0; j < 4; ++j) s[r] += (v[r][j][0] + v[r][j][1]) + (v[r][j][2] + v[r][j][3]);
#pragma unroll
        for (int o = 1; o < 64; o <<= 1)
#pragma unroll
            for (int r = 0; r < NR; ++r) s[r] += shx(s[r], o);
        float s2[NR];
#pragma unroll
        for (int r = 0; r < NR; ++r) { const float mean = s[r] * (1.f / DM); s2[r] = 0.f;
#pragma unroll
            for (int j = 0; j < 4; ++j) { v[r][j] = v[r][j] - mean; s2[r] += (v[r][j][0] * v[r][j][0] + v[r][j][1] * v[r][j][1]) + (v[r][j][2] * v[r][j][2] + v[r][j][3] * v[r][j][3]); } }
#pragma unroll
        for (int o = 1; o < 64; o <<= 1)
#pragma unroll
            for (int r = 0; r < NR; ++r) s2[r] += shx(s2[r], o);
#pragma unroll
        for (int j = 0; j < 4; ++j) { const f32x4 gg = ((const f32x4*)lg)[lane + 64 * j], bb = ((const f32x4*)lb)[lane + 64 * j];
#pragma unroll
            for (int r = 0; r < NR; ++r) { const float rstd = rsqrtf(s2[r] * (1.f / DM) + LN_EPS); v[r][j] = v[r][j] * rstd * gg + bb; } }
        if (has_stat) {
#pragma unroll
            for (int r = 0; r < NR; ++r) if (lane == 0) { f32x2 st2; st2[0] = s[r] * (1.f / DM); st2[1] = rsqrtf(s2[r] * (1.f / DM) + LN_EPS); *(f32x2*)stat[r] = st2; }
        }
    }
    if (has_x) {
#pragma unroll
        for (int r = 0; r < NR; ++r)
#pragma unroll
            for (int j = 0; j < 4; ++j) ((f32x4*)dstx[r])[lane + 64 * j] = v[r][j];
    }
    if (has_h) {
#pragma unroll
        for (int r = 0; r < NR; ++r)
#pragma unroll
            for (int j = 0; j < 4; ++j) {
                const f32x4 a = ((const f32x4*)sc[r])[lane + 64 * j], d = ((const f32x4*)sh[r])[lane + 64 * j];
                const f32x4 h = v[r][j] * (a + 1.f) + d;
                u32x2 w; w.x = pk2(h[0], h[1]); w.y = pk2(h[2], h[3]);
                ((u32x2*)dsth[r])[lane + 64 * j] = w;
            }
    }
}
DI void rows_phase(const Params& p, int mode, int nrows, const float* lg, const float* lb, const float* modl, int sc_off, int sh_off, int gw, int ngw, int lane) {
    float* XRES = (float*)(wsp(p) + WS_XRES); bf16* HA = (bf16*)(wsp(p) + WS_HA); float* STA = (float*)(wsp(p) + WS_ST);
    constexpr int NR = 3;
    for (int row0 = gw; row0 < nrows; row0 += NR * ngw) {
        const float* src[NR]; float* dx[NR]; bf16* dh[NR]; const float* sc[NR]; const float* sh[NR]; float* stp[NR];
#pragma unroll
        for (int r = 0; r < NR; ++r) {
            int row = row0 + r * ngw; if (row >= nrows) row = row0;
            const int bidx = row < NLAT ? (row >> 11) : 8;
            src[r] = (mode == 0) ? (row < NLAT ? inp(p, 0) + (size_t)row * DM : inp(p, 2) + (size_t)(row - NLAT) * DM) : XRES + (size_t)row * DM;
            dx[r] = p.out + (size_t)(row < NLAT ? row : 0) * DM; dh[r] = HA + (size_t)row * DM; stp[r] = STA + 2 * row;
            sc[r] = modl + bidx * 6144 + sc_off; sh[r] = modl + bidx * 6144 + sh_off;
        }
        row_pass_n<NR>(src, lg, lb, dx, dh, sc, sh, stp, mode == 1, mode == 2, mode != 2, lane);
    }
}

template <class RM> DI void tr_item(const float* W, int ldsrc, int k0, int n0, bf16* dst, int lddst, int coloff, const float* kscale, RM rm, LAS float* scr, int lane) {
    {
        const int kq = lane >> 3, nq = lane & 7;
        f32x4 wv[8];
#pragma unroll
        for (int i = 0; i < 8; ++i) wv[i] = *(const f32x4*)(W + (size_t)(k0 + 8 * i + kq) * ldsrc + n0 + 4 * nq);
#pragma unroll
        for (int i = 0; i < 8; ++i) { const int kk = 8 * i + kq; f32x4 w = wv[i]; if (kscale) w = w * kscale[k0 + kk];
            LAS float* d = scr + kk * 33 + 4 * nq; d[0] = w[0]; d[1] = w[1]; d[2] = w[2]; d[3] = w[3]; }
    }
    LDS_WAIT(); asm volatile("" ::: "memory");
    const int c = lane & 7;
#pragma unroll
    for (int j = 0; j < 4; ++j) { const int n = (lane >> 3) + 8 * j; const LAS float* s = scr + (8 * c) * 33 + n;
        u32x4 o; o.x = pk2(s[0 * 33], s[1 * 33]); o.y = pk2(s[2 * 33], s[3 * 33]); o.z = pk2(s[4 * 33], s[5 * 33]); o.w = pk2(s[6 * 33], s[7 * 33]);
        *(u32x4*)(dst + (size_t)rm(n0 + n) * lddst + coloff + k0 + 8 * c) = o; }
    LDS_WAIT(); asm volatile("" ::: "memory");
}
struct RmId { int off; DI int operator()(int n) const { return n + off; } };
struct RmFfn { int off; DI int operator()(int n) const { return 256 * (n >> 7) + (n & 127) + off; } };

DI void zero_rect(bf16* dst, int ld, int row0, int nrows, int col0, int ncols, int gtid, int gthreads) {
    const int cpr = ncols >> 3, total = nrows * cpr; const unsigned zu = __float_as_uint(ozero());
    for (int e = gtid; e < total; e += gthreads) { const int r = e / cpr, cc = e - r * cpr; *(u32x4*)(dst + (size_t)(row0 + r) * ld + col0 + cc * 8) = (u32x4){zu, zu, zu, zu}; }
}

DI void phase_convert(const Params& p, int l, LAS unsigned char* lds, int gw, int ngw, int lane, int gtid, int gthreads) {
    unsigned char* ws = wsp(p);
    LAS float* scr = (LAS float*)(lds + (otid() >> 6) * 16384);
    bf16* Wtin = (bf16*)(ws + WS_WIN); bf16* Wtqk = (bf16*)(ws + WS_WQK); bf16* Wtv = (bf16*)(ws + WS_WV); bf16* Wtf = (bf16*)(ws + WS_WF);
    bf16* Wtout = (bf16*)(ws + WS_WOUT); bf16* Wt13 = (bf16*)(ws + WS_W13); bf16* Wt2 = (bf16*)(ws + WS_W2); bf16* Wtpool = (bf16*)(ws + WS_WPOOL); bf16* Wsb = (bf16*)(ws + WS_WS);
    const float* w_in = inp(p, 6) + (size_t)l * 1024 * 1440; const float* qn = inp(p, 7) + l * 256; const float* w_uq = inp(p, 8) + (size_t)l * 256 * 768;
    const float* kvn = inp(p, 9) + l * 128; const float* w_uk = inp(p, 10) + (size_t)l * 128 * 512; const float* w_uv = inp(p, 11) + (size_t)l * 128 * 512;
    const float* w_sp = inp(p, 14) + (size_t)l * 4 * 128 * 128; const float* w_pool = inp(p, 16) + (size_t)l * 4 * 64 * 64; const float* w_f = inp(p, 18) + (size_t)l * 256 * 256;
    const float* w_out = inp(p, 19) + (size_t)l * 1280 * 1024; const float* w1 = inp(p, 22) + (size_t)l * 1024 * DFF; const float* w3 = inp(p, 23) + (size_t)l * 1024 * DFF; const float* w2 = inp(p, 24) + (size_t)l * DFF * 1024;
    constexpr int I_IN = 16 * 45, I_UQ = 4 * 24, I_UK = 2 * 16, I_UV = 2 * 16, I_OUT = 20 * 32, I_F1 = 16 * 88, I_F3 = 16 * 88, I_F2 = 44 * 32, I_POOL = 8;
    constexpr int NITEMS = I_IN + I_UQ + I_UK + I_UV + I_OUT + I_F1 + I_F3 + I_F2 + I_POOL;
    for (int it = gw; it < NITEMS; it += ngw) {
        int r = it;
        if (r < I_IN) { tr_item(w_in, 1440, 64 * (r / 45), 32 * (r % 45), Wtin, 1024, 0, nullptr, RmId{0}, scr, lane); continue; } r -= I_IN;
        if (r < I_UQ) { tr_item(w_uq, 768, 64 * (r / 24), 32 * (r % 24), Wtqk, 384, 0, qn, RmId{0}, scr, lane); continue; } r -= I_UQ;
        if (r < I_UK) { tr_item(w_uk, 512, 64 * (r / 16), 32 * (r % 16), Wtqk, 384, 256, kvn, RmId{768}, scr, lane); continue; } r -= I_UK;
        if (r < I_UV) { tr_item(w_uv, 512, 64 * (r / 16), 32 * (r % 16), Wtv, 384, 256, kvn, RmId{0}, scr, lane); continue; } r -= I_UV;
        if (r < I_OUT) { tr_item(w_out, 1024, 64 * (r / 32), 32 * (r % 32), Wtout, 1280, 0, nullptr, RmId{0}, scr, lane); continue; } r -= I_OUT;
        if (r < I_F1) { tr_item(w1, DFF, 64 * (r / 88), 32 * (r % 88), Wt13, 1024, 0, nullptr, RmFfn{0}, scr, lane); continue; } r -= I_F1;
        if (r < I_F3) { tr_item(w3, DFF, 64 * (r / 88), 32 * (r % 88), Wt13, 1024, 0, nullptr, RmFfn{128}, scr, lane); continue; } r -= I_F3;
        if (r < I_F2) { tr_item(w2, 1024, 64 * (r / 32), 32 * (r % 32), Wt2, DFF, 0, nullptr, RmId{0}, scr, lane); continue; } r -= I_F2;
        { const int gi = r >> 1; tr_item(w_pool + gi * 4096, 64, 0, 32 * (r & 1), Wtpool + gi * 4096, 64, 0, nullptr, RmId{0}, scr, lane); }
    }
    zero_rect(Wtin, 1024, 1440, 96, 0, 1024, gtid, gthreads);
    zero_rect(Wtqk, 384, 0, 768, 256, 128, gtid, gthreads);
    zero_rect(Wtqk, 384, 768, 512, 0, 256, gtid, gthreads);
    zero_rect(Wtv, 384, 0, 512, 0, 256, gtid, gthreads);
    for (int e = gtid; e < 4 * 128 * 128 / 4; e += gthreads) { const f32x4 v = ((const f32x4*)w_sp)[e]; u32x2 w; w.x = pk2(v[0], v[1]); w.y = pk2(v[2], v[3]); ((u32x2*)Wsb)[e] = w; }
    for (int e = gtid; e < 256 * 256; e += gthreads) {
        const int n = e & 255, gc = e >> 8, g = gc >> 6, c = gc & 63;
        float sc_ = 0.f, ss_ = 0.f;
        for (int m = 0; m < 64; ++m) { const float w = w_f[(size_t)(g * 64 + m) * 256 + n]; const float a = (float)((m * c) & 63) * (1.f / 64.f); sc_ += cos_turn(a) * w; ss_ += sin_turn(a) * w; }
        Wtf[(size_t)n * 256 + gc] = (bf16)(pk2(sc_, 0.f) & 0xffffu); Wtf[(size_t)(256 + n) * 256 + gc] = (bf16)(pk2(-ss_, 0.f) & 0xffffu);
    }
}

DI void phase_prologue(const Params& p, LAS unsigned char* lds, int G, int bid) {
    const int tid = otid();
    LAS float* S = (LAS float*)lds;
    LAS float* red = (LAS float*)(lds + 40960);
    const float* cvec = inp(p, 1); const float* ccv = inp(p, 3); const float* w_mod = inp(p, 4); const float* b_mod = inp(p, 5);
    float* MOD = (float*)(wsp(p) + WS_MOD);
    for (int i = tid; i < 9 * 1024; i += 512) { const float v = i < 8192 ? cvec[i] : ccv[i - 8192]; S[i] = v * frcp(1.f + fexp2(-1.4426950408889634f * v)); }
    __syncthreads();
    for (int item = bid; item < 4 * 48; item += G) {
        const int l = item / 48, n0 = (item - l * 48) * 128, lane = tid & 63, ks = tid >> 6, kp = lane >> 5, c4 = (lane & 31) * 4;
        const float* W = w_mod + (size_t)l * 1024 * 6144 + n0 + c4;
        f32x4 acc[9];
#pragma unroll
        for (int r = 0; r < 9; ++r) acc[r] = (f32x4){0.f, 0.f, 0.f, 0.f};
#pragma unroll 16
        for (int i = 0; i < 64; ++i) {
            const int k = ks * 128 + 2 * i + kp;
            const f32x4 w = *(const f32x4*)(W + (size_t)k * 6144);
#pragma unroll
            for (int r = 0; r < 9; ++r) acc[r] = acc[r] + w * S[r * 1024 + k];
        }
        LAS float* rr = red + ((ks * 2 + kp) * 9) * 128 + c4;
#pragma unroll
        for (int r = 0; r < 9; ++r) { rr[r * 128 + 0] = acc[r][0]; rr[r * 128 + 1] = acc[r][1]; rr[r * 128 + 2] = acc[r][2]; rr[r * 128 + 3] = acc[r][3]; }
        __syncthreads();
        for (int o = tid; o < 9 * 128; o += 512) {
            const int r = o >> 7, jj = o & 127; float s = b_mod[l * 6144 + n0 + jj];
#pragma unroll
            for (int k2 = 0; k2 < 16; ++k2) s += red[k2 * 1152 + o];
            MOD[(size_t)(l * 9 + r) * 6144 + n0 + jj] = s;
        }
        __syncthreads();
    }
    const int gtid = bid * 512 + tid, gthreads = G * 512;
    bf16* CSL = (bf16*)(wsp(p) + WS_CSL); bf16* CSC = (bf16*)(wsp(p) + WS_CSC);
    for (int ch = gtid; ch < 1048576 + 16384; ch += gthreads) {
        float v[8];
        if (ch < 1048576) {
            const int k = ch >> 9, l0 = (ch & 511) * 8, half = l0 >> 11, lb = l0 & 2047; const float scale = 0.00276213586400995f;
#pragma unroll
            for (int j = 0; j < 8; ++j) { const float a = (float)((k * (lb + j)) & 2047) * (1.f / 2048.f); v[j] = (half ? sin_turn(a) : cos_turn(a)) * scale; }
            u32x4 w; w.x = pk2(v[0], v[1]); w.y = pk2(v[2], v[3]); w.z = pk2(v[4], v[5]); w.w = pk2(v[6], v[7]);
            *(u32x4*)(CSL + (size_t)k * 4096 + l0) = w;
        } else {
            const int c2 = ch - 1048576, k = c2 >> 6, l0 = (c2 & 63) * 8, half = l0 >> 8, lb = l0 & 255; const float scale = 1.f / 128.f;
#pragma unroll
            for (int j = 0; j < 8; ++j) { const float a = (float)((k * (lb + j)) & 255) * (1.f / 256.f); v[j] = (half ? sin_turn(a) : cos_turn(a)) * scale; }
            u32x4 w; w.x = pk2(v[0], v[1]); w.y = pk2(v[2], v[3]); w.z = pk2(v[4], v[5]); w.w = pk2(v[6], v[7]);
            *(u32x4*)(CSC + (size_t)k * 512 + l0) = w;
        }
    }
    float* ROPE = (float*)(wsp(p) + WS_ROPE);
    for (int e = gtid; e < 2048 * 16; e += gthreads) {
        const int pos = e >> 4, f = e & 15, axis = f >> 3, fi = f & 7;
        const float coord = (float)(axis ? (pos & 63) : (pos >> 6));
        const float inv = fexp2(-(float)fi * (13.287712379549449f / 8.f));
        const float ang = coord * inv * 0.15915494309189535f;
        ROPE[pos * 32 + f] = cos_turn(ang); ROPE[pos * 32 + 16 + f] = sin_turn(ang);
    }
}

DI f32x4 mfma16(bf16x8 a, bf16x8 b, f32x4 c) { return __builtin_amdgcn_mfma_f32_16x16x32_bf16(a, b, c, 0, 0, 0); }
DI f32x16 mfma32(bf16x8 a, bf16x8 b, f32x16 c) { return __builtin_amdgcn_mfma_f32_32x32x16_bf16(a, b, c, 0, 0, 0); }

DI void sgu_item(const Params& p, int l, int ci, int g, LAS unsigned char* lds) {
    const int tid = otid(), lane = tid & 63, w = tid >> 6;
    const bf16* proj = (const bf16*)(wsp(p) + WS_PROJ); bf16* mix = (bf16*)(wsp(p) + WS_MIX); const bf16* Wsb = (const bf16*)(wsp(p) + WS_WS);
    const float* gam = inp(p, 12) + l * 256; const float* bet = inp(p, 13) + l * 256; const float* bsp = inp(p, 15) + l * 512;
    constexpr int PITCH = 136;
    LAS bf16* vnT = (LAS bf16*)lds;
    const int r0 = ci * 128;
    const int fr = lane & 15, fq = lane >> 4, pp = 16 * w + fr, tok = r0 + pp;
    bf16x8 wfr[4]; u32x2 uu[4];
#pragma unroll
    for (int ks = 0; ks < 4; ++ks) wfr[ks] = *(const bf16x8*)(Wsb + (size_t)(g * 128 + pp) * 128 + ks * 32 + fq * 8);
#pragma unroll
    for (int ct = 0; ct < 4; ++ct) uu[ct] = *(const u32x2*)(proj + (size_t)tok * NPROJ + PO_SU + g * 64 + ct * 16 + fq * 4);
    const float bs = bsp[g * 128 + pp];
    {
        const int q = tid >> 2, j = tid & 3;
        const u32x4* src = (const u32x4*)(proj + (size_t)(r0 + q) * NPROJ + PO_SV + j * 64);
        float v[64]; float s = 0.f;
#pragma unroll
        for (int i = 0; i < 8; ++i) { const u32x4 x = src[i];
            v[8 * i + 0] = bflo(x.x); v[8 * i + 1] = bfhi(x.x); v[8 * i + 2] = bflo(x.y); v[8 * i + 3] = bfhi(x.y);
            v[8 * i + 4] = bflo(x.z); v[8 * i + 5] = bfhi(x.z); v[8 * i + 6] = bflo(x.w); v[8 * i + 7] = bfhi(x.w); }
#pragma unroll
        for (int i = 0; i < 64; ++i) s += v[i];
        s += shx(s, 1); s += shx(s, 2);
        const float mean = s * (1.f / 256.f); float s2 = 0.f;
#pragma unroll
        for (int i = 0; i < 64; ++i) { v[i] -= mean; s2 += v[i] * v[i]; }
        s2 += shx(s2, 1); s2 += shx(s2, 2);
        const float rstd = rsqrtf(s2 * (1.f / 256.f) + LN_EPS);
        if (j == g) {
#pragma unroll
            for (int c = 0; c < 64; ++c) { const float vn = v[c] * rstd * gam[g * 64 + c] + bet[g * 64 + c]; vnT[c * PITCH + q] = (bf16)(pk2(vn, 0.f) & 0xffffu); }
        }
    }
    __syncthreads();
    {
        f32x4 acc[4]; const float zf = ozero();
#pragma unroll
        for (int ct = 0; ct < 4; ++ct) acc[ct] = (f32x4){zf, zf, zf, zf};
#pragma unroll
        for (int ks = 0; ks < 4; ++ks) {
            const bf16x8 bfr = wfr[ks];
#pragma unroll
            for (int ct = 0; ct < 4; ++ct) { const bf16x8 afr = *(const LAS bf16x8*)(vnT + (ct * 16 + fr) * PITCH + ks * 32 + fq * 8); acc[ct] = mfma16(afr, bfr, acc[ct]); }
        }
#pragma unroll
        for (int ct = 0; ct < 4; ++ct) {
            const int c0 = g * 64 + ct * 16 + fq * 4;
            u32x2 o; o.x = pk2(bflo(uu[ct].x) * (acc[ct][0] + bs), bfhi(uu[ct].x) * (acc[ct][1] + bs)); o.y = pk2(bflo(uu[ct].y) * (acc[ct][2] + bs), bfhi(uu[ct].y) * (acc[ct][3] + bs));
            *(u32x2*)(mix + (size_t)tok * MIXD + 512 + c0) = o;
        }
    }
    __syncthreads();
}

DI void pool_item(const Params& p, int l, int ti, int gi, LAS unsigned char* lds) {
    const int tid = otid(), lane = tid & 63, w = tid >> 6;
    const bf16* proj = (const bf16*)(wsp(p) + WS_PROJ); bf16* mix = (bf16*)(wsp(p) + WS_MIX); const bf16* Wtp = (const bf16*)(wsp(p) + WS_WPOOL) + gi * 4096;
    const float* pscale = inp(p, 17) + l * 256 + gi * 64;
    LAS float* Pl = (LAS float*)lds;
    LAS bf16* Dl = (LAS bf16*)(lds + 40960);
    const int r0 = ti * 128, half = 1 << gi;
    int sb, se; if (r0 < NLAT) { sb = r0 & ~2047; se = sb + 2048; } else { sb = NLAT + ((r0 - NLAT) & ~255); se = sb + 256; }
    const unsigned zu = __float_as_uint(ozero());
    const int fr = lane & 15, fq = lane >> 4;
    bf16x8 wfr[2][4]; f32x4 psc[4];
#pragma unroll
    for (int ks = 0; ks < 2; ++ks)
#pragma unroll
        for (int nt = 0; nt < 4; ++nt) wfr[ks][nt] = *(const bf16x8*)(Wtp + (nt * 16 + fr) * 64 + ks * 32 + fq * 8);
#pragma unroll
    for (int nt = 0; nt < 4; ++nt) psc[nt] = *(const f32x4*)(pscale + nt * 16 + fq * 4);
    for (int e = tid; e < 144 * 8; e += 512) {
        const int rr = e >> 3, c8 = (e & 7) * 8, r = r0 - 8 + rr;
        u32x4 x = (u32x4){zu, zu, zu, zu};
        if (r >= sb && r < se) x = *(const u32x4*)(proj + (size_t)r * NPROJ + PO_POOL + gi * 64 + c8);
        LAS float* d = Pl + rr * 65 + c8;
        d[0] = bflo(x.x); d[1] = bfhi(x.x); d[2] = bflo(x.y); d[3] = bfhi(x.y); d[4] = bflo(x.z); d[5] = bfhi(x.z); d[6] = bflo(x.w); d[7] = bfhi(x.w);
    }
    __syncthreads();
    {
        const int c = tid & 63, t0 = (tid >> 6) * 16;
        float s = 0.f;
        for (int rr = t0 + 8 - half; rr < t0 + 8 + half; ++rr) s += Pl[rr * 65 + c];
        float add[15], sub[15], ctr[16];
#pragma unroll
        for (int i = 0; i < 15; ++i) { add[i] = Pl[(t0 + i + 8 + half) * 65 + c]; sub[i] = Pl[(t0 + i + 8 - half) * 65 + c]; }
#pragma unroll
        for (int i = 0; i < 16; ++i) ctr[i] = Pl[(t0 + i + 8) * 65 + c];
#pragma unroll
        for (int i = 0; i < 16; ++i) {
            const int r = r0 + t0 + i;
            const int lo = max(r - half, sb), hi = min(r + half, se);
            const float d = s * frcp((float)(hi - lo)) - ctr[i];
            Dl[(t0 + i) * 72 + c] = (bf16)(pk2(d, 0.f) & 0xffffu);
            if (i < 15) s += add[i] - sub[i];
        }
    }
    __syncthreads();
    {
        const int t = 16 * w + fr;
        f32x4 acc[4]; const float zf = ozero();
#pragma unroll
        for (int nt = 0; nt < 4; ++nt) acc[nt] = (f32x4){zf, zf, zf, zf};
#pragma unroll
        for (int ks = 0; ks < 2; ++ks) {
            const bf16x8 bfr = *(const LAS bf16x8*)(Dl + t * 72 + ks * 32 + fq * 8);
#pragma unroll
            for (int nt = 0; nt < 4; ++nt) acc[nt] = mfma16(wfr[ks][nt], bfr, acc[nt]);
        }
#pragma unroll
        for (int nt = 0; nt < 4; ++nt) {
            const int n0 = nt * 16 + fq * 4; const f32x4 sc = psc[nt];
            u32x2 o; o.x = pk2(acc[nt][0] * sc[0], acc[nt][1] * sc[1]); o.y = pk2(acc[nt][2] * sc[2], acc[nt][3] * sc[3]);
            *(u32x2*)(mix + (size_t)(r0 + t) * MIXD + 768 + gi * 64 + n0) = o;
        }
    }
    __syncthreads();
}

DI void krope_items(const Params& p, int gtid, int gthreads) {
    const bf16* proj = (const bf16*)(wsp(p) + WS_PROJ); bf16* Kb = (bf16*)(wsp(p) + WS_K); const float* rope = (const float*)(wsp(p) + WS_ROPE);
    for (int e = gtid; e < MTOK * 2; e += gthreads) {
        const int row = e >> 1, axis = e & 1;
        int b, pos; bool lat; row_info(row, b, pos, lat);
        const u32x4 x1 = *(const u32x4*)(proj + (size_t)row * NPROJ + PO_KR + axis * 16), x2 = *(const u32x4*)(proj + (size_t)row * NPROJ + PO_KR + axis * 16 + 8);
        u32x4 o1 = x1, o2 = x2;
        if (lat) {
            const float* rp = rope + pos * 32 + axis * 8;
            float a[8], c[8], cs[8], sn[8];
            a[0] = bflo(x1.x); a[1] = bfhi(x1.x); a[2] = bflo(x1.y); a[3] = bfhi(x1.y); a[4] = bflo(x1.z); a[5] = bfhi(x1.z); a[6] = bflo(x1.w); a[7] = bfhi(x1.w);
            c[0] = bflo(x2.x); c[1] = bfhi(x2.x); c[2] = bflo(x2.y); c[3] = bfhi(x2.y); c[4] = bflo(x2.z); c[5] = bfhi(x2.z); c[6] = bflo(x2.w); c[7] = bfhi(x2.w);
#pragma unroll
            for (int j = 0; j < 8; ++j) { cs[j] = rp[j]; sn[j] = rp[16 + j]; }
            float y1[8], y2[8];
#pragma unroll
            for (int j = 0; j < 8; ++j) { y1[j] = a[j] * cs[j] - c[j] * sn[j]; y2[j] = a[j] * sn[j] + c[j] * cs[j]; }
            o1.x = pk2(y1[0], y1[1]); o1.y = pk2(y1[2], y1[3]); o1.z = pk2(y1[4], y1[5]); o1.w = pk2(y1[6], y1[7]);
            o2.x = pk2(y2[0], y2[1]); o2.y = pk2(y2[2], y2[3]); o2.z = pk2(y2[4], y2[5]); o2.w = pk2(y2[6], y2[7]);
        }
        const int key = lat ? CTXL + pos : pos;
#pragma unroll
        for (int h = 0; h < 8; ++h) { bf16* dst = Kb + ((size_t)(b * 8 + h) * NKEY + key) * 96 + 64 + axis * 16; *(u32x4*)dst = o1; *(u32x4*)(dst + 8) = o2; }
    }
}

DI int swap23(int r) { return (r & ~12) | ((r & 4) << 1) | ((r & 8) >> 1); }
DI void attn_item(const bf16* Qp, const bf16* Kp, const bf16* Vtp, int nkeys, bf16* outp  , LAS unsigned char* lds) {
    const int tid = otid(), lane = tid & 63, w = tid >> 6, r = lane & 31, hh = lane >> 5, gk = w >> 2, wq = w & 3;
    constexpr int KP = 208, VP = 144, KT = 64 * KP, VT = 64 * VP;
    LAS unsigned char* Kl = lds; LAS unsigned char* Vl = lds + 4 * KT;
    bf16x8 qf[6];
#pragma unroll
    for (int kk = 0; kk < 6; ++kk) qf[kk] = *(const bf16x8*)(Qp + (size_t)(32 * wq + r) * 96 + kk * 16 + hh * 8);
    const float zf = ozero();
    f32x16 o0, o1;
#pragma unroll
    for (int i = 0; i < 16; ++i) { o0[i] = zf; o1[i] = zf; }
    float mrun = -60.f, lrun = zf;
    unsigned kg[3], kl[3], vg[2], vl[2];
#pragma unroll
    for (int i = 0; i < 3; ++i) { const int c = tid + 512 * i, tile = c / 768, cc = c - tile * 768, row = cc / 12, col = cc - row * 12;
        kg[i] = (unsigned)((tile * 64 + row) * 96 + col * 8); kl[i] = (unsigned)(tile * KT + swap23(row) * KP + col * 16); }
#pragma unroll
    for (int i = 0; i < 2; ++i) { const int c = tid + 512 * i, tile = c >> 9, cc = c & 511, dv = cc >> 3, col = cc & 7;
        vg[i] = (unsigned)(dv * NKEY + tile * 64 + col * 8); vl[i] = (unsigned)(tile * VT + dv * VP + col * 16); }
    const int npairs = nkeys >> 7;
    u32x4 sk[3], sv[2];
#pragma unroll
    for (int i = 0; i < 3; ++i) sk[i] = *(const u32x4*)(Kp + kg[i]);
#pragma unroll
    for (int i = 0; i < 2; ++i) sv[i] = *(const u32x4*)(Vtp + vg[i]);
#pragma unroll
    for (int i = 0; i < 3; ++i) *(LAS u32x4*)(Kl + kl[i]) = sk[i];
#pragma unroll
    for (int i = 0; i < 2; ++i) *(LAS u32x4*)(Vl + vl[i]) = sv[i];
    __syncthreads();
    for (int kp = 0; kp < npairs; ++kp) {
        const int cur = kp & 1;
        if (kp + 1 < npairs) {
            const bf16* kgp = Kp + (size_t)(kp + 1) * 128 * 96; const bf16* vgp = Vtp + (kp + 1) * 128;
#pragma unroll
            for (int i = 0; i < 3; ++i) sk[i] = *(const u32x4*)(kgp + kg[i]);
#pragma unroll
            for (int i = 0; i < 2; ++i) sv[i] = *(const u32x4*)(vgp + vg[i]);
        }
        const LAS unsigned char* kb = Kl + (cur * 2 + gk) * KT; const LAS unsigned char* vb = Vl + (cur * 2 + gk) * VT;
        f32x16 s0, s1; const float negm = -mrun;
#pragma unroll
        for (int i = 0; i < 16; ++i) { s0[i] = negm; s1[i] = negm; }
#pragma unroll
        for (int kk = 0; kk < 6; ++kk) {
            const bf16x8 ka0 = *(const LAS bf16x8*)(kb + r * KP + kk * 32 + hh * 16);
            const bf16x8 ka1 = *(const LAS bf16x8*)(kb + (32 + r) * KP + kk * 32 + hh * 16);
            s0 = mfma32(ka0, qf[kk], s0); s1 = mfma32(ka1, qf[kk], s1);
        }
        float mx = s0[0];
#pragma unroll
        for (int i = 1; i < 16; ++i) mx = fmaxf(mx, s0[i]);
#pragma unroll
        for (int i = 0; i < 16; ++i) mx = fmaxf(mx, s1[i]);
        if (__builtin_amdgcn_ballot_w64(mx > 6.f) != 0ull) {
            mx = fmaxf(mx, shx(mx, 32));
            const float dm = fmaxf(mx, 0.f), alpha = fexp2(-dm);
            mrun += dm; lrun *= alpha;
#pragma unroll
            for (int i = 0; i < 16; ++i) { s0[i] -= dm; s1[i] -= dm; o0[i] *= alpha; o1[i] *= alpha; }
        }
        float ls = 0.f;
#pragma unroll
        for (int i = 0; i < 16; ++i) { s0[i] = fexp2(s0[i]); s1[i] = fexp2(s1[i]); ls += s0[i] + s1[i]; }
        lrun += ls;
        bf16x8 pf[2][2];
#pragma unroll
        for (int s2 = 0; s2 < 2; ++s2) {
            u32x4 a, b2;
            a.x = pk2(s0[8 * s2 + 0], s0[8 * s2 + 1]); a.y = pk2(s0[8 * s2 + 2], s0[8 * s2 + 3]); a.z = pk2(s0[8 * s2 + 4], s0[8 * s2 + 5]); a.w = pk2(s0[8 * s2 + 6], s0[8 * s2 + 7]);
            b2.x = pk2(s1[8 * s2 + 0], s1[8 * s2 + 1]); b2.y = pk2(s1[8 * s2 + 2], s1[8 * s2 + 3]); b2.z = pk2(s1[8 * s2 + 4], s1[8 * s2 + 5]); b2.w = pk2(s1[8 * s2 + 6], s1[8 * s2 + 7]);
            pf[0][s2] = __builtin_bit_cast(bf16x8, a); pf[1][s2] = __builtin_bit_cast(bf16x8, b2);
        }
#pragma unroll
        for (int d = 0; d < 2; ++d)
#pragma unroll
            for (int s2 = 0; s2 < 2; ++s2) {
                const bf16x8 v0 = *(const LAS bf16x8*)(vb + r * VP + (d * 32 + s2 * 16 + hh * 8) * 2);
                const bf16x8 v1 = *(const LAS bf16x8*)(vb + (32 + r) * VP + (d * 32 + s2 * 16 + hh * 8) * 2);
                o0 = mfma32(v0, pf[d][s2], o0); o1 = mfma32(v1, pf[d][s2], o1);
            }
        if (kp + 1 < npairs) {
            LAS unsigned char* kn = Kl + (cur ^ 1) * 2 * KT; LAS unsigned char* vn = Vl + (cur ^ 1) * 2 * VT;
#pragma unroll
            for (int i = 0; i < 3; ++i) *(LAS u32x4*)(kn + kl[i]) = sk[i];
#pragma unroll
            for (int i = 0; i < 2; ++i) *(LAS u32x4*)(vn + vl[i]) = sv[i];
        }
        __syncthreads();
    }
    lrun += shx(lrun, 32);
    LAS float* mg = (LAS float*)lds + wq * (34 * 64) + lane;
    if (gk == 1) {
#pragma unroll
        for (int i = 0; i < 16; ++i) { mg[i * 64] = o0[i]; mg[(16 + i) * 64] = o1[i]; }
        mg[32 * 64] = mrun; mg[33 * 64] = lrun;
    }
    __syncthreads();
    if (gk == 0) {
        const float m1 = mg[32 * 64], l1 = mg[33 * 64];
        const float m = fmaxf(mrun, m1), a0 = fexp2(mrun - m), a1 = fexp2(m1 - m);
        const float inv = frcp(lrun * a0 + l1 * a1), c0 = a0 * inv, c1 = a1 * inv;
        bf16* orow = outp + (size_t)(32 * wq + r) * MIXD;
#pragma unroll
        for (int i4 = 0; i4 < 4; ++i4) {
            u32x2 a, b2;
            a.x = pk2(o0[4 * i4] * c0 + mg[(4 * i4) * 64] * c1, o0[4 * i4 + 1] * c0 + mg[(4 * i4 + 1) * 64] * c1);
            a.y = pk2(o0[4 * i4 + 2] * c0 + mg[(4 * i4 + 2) * 64] * c1, o0[4 * i4 + 3] * c0 + mg[(4 * i4 + 3) * 64] * c1);
            b2.x = pk2(o1[4 * i4] * c0 + mg[(16 + 4 * i4) * 64] * c1, o1[4 * i4 + 1] * c0 + mg[(16 + 4 * i4 + 1) * 64] * c1);
            b2.y = pk2(o1[4 * i4 + 2] * c0 + mg[(16 + 4 * i4 + 2) * 64] * c1, o1[4 * i4 + 3] * c0 + mg[(16 + 4 * i4 + 3) * 64] * c1);
            *(u32x2*)(orow + 8 * i4 + 4 * hh) = a; *(u32x2*)(orow + 32 + 8 * i4 + 4 * hh) = b2;
        }
    }
    __syncthreads();
}

DI void attn_any(const Params& p, int item, LAS unsigned char* lds) {
    unsigned char* ws = wsp(p);
    const bool isl = item < 1024;
    const int bh = isl ? (item >> 4) : ((item - 1024) >> 1), qb = isl ? (item & 15) : ((item - 1024) & 1), b = bh >> 3, h = bh & 7;
    const bf16* Qp = isl ? (const bf16*)(ws + WS_QLAT) + ((size_t)bh * SEQ + qb * 128) * 96 : (const bf16*)(ws + WS_QCTX) + ((size_t)bh * CTXL + qb * 128) * 96;
    const bf16* Kp = (const bf16*)(ws + WS_K) + (size_t)bh * NKEY * 96;
    const bf16* Vtp = (const bf16*)(ws + WS_VT) + (size_t)bh * 64 * NKEY;
    bf16* outp = (bf16*)(ws + WS_MIX) + (size_t)(isl ? (b * SEQ + qb * 128) : (NLAT + b * CTXL + qb * 128)) * MIXD + h * 64;
    attn_item(Qp, Kp, Vtp, isl ? NKEY : CTXL, outp, lds);
    if (!isl) publish_block((unsigned*)(ws + WS_CTL) + CW_ECTX);
}

#ifndef PROBE_REP_SUB
#define PROBE_REP_SUB -1
#endif
#ifndef PROBE_SYNCS
#define PROBE_SYNCS 0
#endif
constexpr int NSUB = 13 + (PROBE_REP_SUB >= 0 ? 1 : 0), NSTEP = 2 + NSUB * DEPTH;
__global__ void __launch_bounds__(512, 2) mk_fwd(Params p) {
    extern __shared__ __attribute__((aligned(16))) unsigned char lds_raw[];
    LAS unsigned char* lds = (LAS unsigned char*)lds_raw;
    cg::grid_group grid = cg::this_grid();
    volatile LAS unsigned* MISC = (volatile LAS unsigned*)(lds + MISC_OFF);
    if (threadIdx.x < 4) MISC[threadIdx.x] = 0u;
    __syncthreads();
    (void)xcd_barrier_post((unsigned*)(p.ws + WS_CTL), MISC);
    if (p.in[1] == nullptr) grid.sync();
    int st0 = p.ph_lo; asm volatile("" : "+s"(st0));
    for (int st = st0; ; st = __builtin_amdgcn_readfirstlane(st + 1)) {
        int ph_hi = p.ph_hi, ph_lo = p.ph_lo; asm volatile("" : "+s"(ph_hi), "+s"(ph_lo));
        if (st >= ph_hi) break;
        int G = gridDim.x, bid = blockIdx.x; asm volatile("" : "+s"(G), "+s"(bid));
        const int vcu = (G % 8 == 0) ? (bid % 8) * (G / 8) + bid / 8 : bid;
        const int ngw = G * 8, gthreads = G * 512;
        const int l = (st - 1) / NSUB, subx = (st - 1) - l * NSUB, sub = (st == 0) ? 100 : (st == NSTEP - 1) ? 101 : ((PROBE_REP_SUB >= 0 && subx > PROBE_REP_SUB) ? subx - 1 : subx);
        const bool need_sync = !(sub == 3 || sub == 4 || sub == 5 || sub == 7 || sub == 8 || sub == 100 || ((sub == 10 || sub == 101) && gridDim.x == 256));
        if (st > ph_lo && need_sync) { XcdBarrier xb2; xb2.bar = (unsigned*)(wsp(p) + WS_CTL); xb2.x = xb_xcc_id(); xb2.st = (volatile LAS unsigned*)(lds + MISC_OFF); xcd_barrier(xb2); }
        unsigned char* ws = wsp(p);
        float* XRES = (float*)(ws + WS_XRES); bf16* HA = (bf16*)(ws + WS_HA); bf16* PROJ = (bf16*)(ws + WS_PROJ);
        bf16* MIX = (bf16*)(ws + WS_MIX); bf16* U = (bf16*)(ws + WS_U);
        const float* MOD = (const float*)(ws + WS_MOD);
        float* STQ = (float*)(ws + WS_STQ); float* STKV = (float*)(ws + WS_STKV);
        const bool last = (l == DEPTH - 1);
        const int Mtail = last ? NLAT : MTOK;
        const float* modl = MOD + (size_t)l * 9 * 6144;

        switch (sub) {
        case 100: phase_prologue(p, lds, G, bid); break;
        case 101: {
            const int tid = otid(), lane = tid & 63, gw = bid * 8 + (tid >> 6), gtid = bid * 512 + tid; (void)lane; (void)gw; (void)gtid;
            if (G != 256) rows_phase(p, 2, NLAT, inp(p, 25) + (DEPTH - 1) * DM, inp(p, 26) + (DEPTH - 1) * DM, modl, 0, 0, gw, ngw, lane);
        } break;
        case 0: {
            const int tid = otid(), lane = tid & 63, gw = bid * 8 + (tid >> 6), gtid = bid * 512 + tid; (void)lane; (void)gw; (void)gtid;
            const float* lg = (l == 0) ? nullptr : inp(p, 25) + (l - 1) * DM; const float* lb = (l == 0) ? nullptr : inp(p, 26) + (l - 1) * DM;
            if (l == 0 || G != 256) rows_phase(p, l == 0 ? 0 : 1, MTOK, lg, lb, modl, 1024, 0, gw, ngw, lane);
            phase_convert(p, l, lds, gw, ngw, lane, gtid, gthreads);
        } break;
        case 1: {
            EpiProj E{PROJ, STQ, STKV};
            run_gemm<DM, DM, DM, MTOK, NPROJ>(lds, HA, (const bf16*)(ws + WS_WIN), G, bid, E);
        } break;
        case 2: {
            EpiQK E{(bf16*)(ws + WS_QLAT), (bf16*)(ws + WS_QCTX), (bf16*)(ws + WS_K), STQ, STKV, (const float*)(ws + WS_ROPE)};
            run_gemm<NPROJ, 384, 384, MTOK, 1280>(lds, PROJ, (const bf16*)(ws + WS_WQK), G, bid, E);
        } break;
        case 3: {
            EpiVt E{(bf16*)(ws + WS_VT), STKV};
            run_gemm<384, NPROJ, 384, 512, MTOK>(lds, (const bf16*)(ws + WS_WV), PROJ, G, (bid + G - 104) % G, E);
        } break;
        case 4: {
            EpiGt E{(bf16*)(ws + WS_GTL), (bf16*)(ws + WS_GTC)};
            run_gemm<256, NPROJ, 256, 512, MTOK>(lds, (const bf16*)(ws + WS_WF), PROJ + PO_F, G, (bid + G - 104) % G, E);
        } break;
        case 5: {
            const int tid = otid(), lane = tid & 63, gw = bid * 8 + (tid >> 6), gtid = bid * 512 + tid; (void)lane; (void)gw; (void)gtid;
            int first, cnt;
            if (G == 256) { if (bid < 104) { first = bid * 5; cnt = 5; } else if (bid < 248) { first = 520 + (bid - 104) * 4; cnt = 4; } else { first = 1096 + (bid - 248) * 7; cnt = 7; } }
            else { first = bid; cnt = (1152 - bid + G - 1) / G; }
            for (int k = 0; k < cnt; ++k) { const int it = (G == 256) ? first + k : first + k * G;
                if (it < 576) sgu_item(p, l, it >> 2, it & 3, lds); else pool_item(p, l, (it - 576) >> 2, (it - 576) & 3, lds); }
            krope_items(p, gtid, gthreads);
        } break;
        case 6: {
            EpiDft E{MIX, 0, SEQ};
            run_gemm<4096, 4096, 4096, 2048, 2048>(lds, (const bf16*)(ws + WS_CSL), (const bf16*)(ws + WS_GTL), G, vcu, E);
        } break;
        case 7: {
            if (!last) { EpiDft E{MIX, NLAT, CTXL};
              StaticOrderSig<256, 2048> S{G, (vcu + G - 64) % G, (unsigned*)(ws + WS_CTL) + CW_ECTX};
              run_gemm_s<512, 512, 512>(lds, (const bf16*)(ws + WS_CSC), (const bf16*)(ws + WS_GTC), 256, 2048, S, E); }
        } break;
        case 8: {
            if (G == 256) {
                int first, cnt, citem = -1;
                if (vcu < 64) { first = 2 * vcu; cnt = 2; } else if (vcu < 72) { first = 128 + 5 * (vcu - 64); cnt = 5; }
                else if (vcu < 104) { first = 168 + 3 * (vcu - 72); cnt = 3; } else { first = 264 + 5 * (vcu - 104); cnt = 5; if (!last && vcu < 232) citem = 1024 + (vcu - 104); }
                if (citem >= 0) attn_any(p, citem, lds);
                for (int k = 0; k < cnt; ++k) attn_any(p, first + k, lds);
                if (!last) {
                    SchedHC S{vcu + 152, (unsigned*)(ws + WS_CTL) + CW_ECTX, 136u * (unsigned)(l + 1)};
                    EpiResLN E2{p, l, 0, 1, last, lds};
                    run_gemm_s<MIXD, MIXD, MIXD>(lds, MIX + (size_t)NLAT * MIXD, (const bf16*)(ws + WS_WOUT), NCTX, DM, S, E2);
                }
            } else {
                for (int it = vcu; it < (last ? 1024 : 1152); it += G) attn_any(p, it, lds);
            }
        } break;
        case 9: {
            if (G == 256) {
                EpiResLN E{p, l, 0, 0, last, lds};
                run_gemm<MIXD, MIXD, MIXD, NLAT, DM>(lds, MIX, (const bf16*)(ws + WS_WOUT), G, bid, E);
            } else {
                EpiRes E{(l == 0) ? inp(p, 0) : XRES, XRES, (const float*)(ws + WS_ST), (l == 0) ? nullptr : inp(p, 25) + (l - 1) * DM, (l == 0) ? nullptr : inp(p, 26) + (l - 1) * DM, modl, 2048, 0};
                if (last) run_gemm<MIXD, MIXD, MIXD, NLAT, DM>(lds, MIX, (const bf16*)(ws + WS_WOUT), G, bid, E);
                else run_gemm<MIXD, MIXD, MIXD, MTOK, DM>(lds, MIX, (const bf16*)(ws + WS_WOUT), G, bid, E);
            }
        } break;
        case 10: {
            const int tid = otid(), lane = tid & 63, gw = bid * 8 + (tid >> 6), gtid = bid * 512 + tid; (void)lane; (void)gw; (void)gtid;
            if (G != 256) rows_phase(p, 1, Mtail, inp(p, 20) + l * DM, inp(p, 21) + l * DM, modl, 4096, 3072, gw, ngw, lane);
        } break;
        case 11: {
            EpiSwiglu E{U};
            if (last || G != 256) {
                if (last) run_gemm<DM, DM, DM, NLAT, 2 * DFF>(lds, HA, (const bf16*)(ws + WS_W13), G, bid, E);
                else run_gemm<DM, DM, DM, MTOK, 2 * DFF>(lds, HA, (const bf16*)(ws + WS_W13), G, bid, E);
            } else {
                unsigned* cnt = (unsigned*)(ws + WS_CTL) + CW_GCTX;
                { SchedG S{bid, cnt}; run_gemm_s<DM, DM, DM>(lds, HA, (const bf16*)(ws + WS_W13), MTOK, 2 * DFF, S, E); }
                { SchedHC S{bid, cnt, 176u * (unsigned)(l + 1)}; EpiResLN E2{p, l, 1, 1, last, lds};
                  run_gemm_s<DFF, DFF, DFF>(lds, U + (size_t)NLAT * DFF, (const bf16*)(ws + WS_W2), NCTX, DM, S, E2); }
            }
        } break;
        case 12: {
            if (G == 256) {
                EpiResLN E{p, l, 1, 0, last, lds};
                run_gemm<DFF, DFF, DFF, NLAT, DM>(lds, U, (const bf16*)(ws + WS_W2), G, bid, E);
            } else {
                EpiRes E{XRES, XRES, (const float*)(ws + WS_ST), inp(p, 20) + l * DM, inp(p, 21) + l * DM, modl, 5120, 0};
                if (last) run_gemm<DFF, DFF, DFF, NLAT, DM>(lds, U, (const bf16*)(ws + WS_W2), G, bid, E);
                else run_gemm<DFF, DFF, DFF, MTOK, DM>(lds, U, (const bf16*)(ws + WS_W2), G, bid, E);
            }
        } break;
        }
        __syncthreads();
    }
}

#ifndef MK_SPLIT
#define MK_SPLIT 0
#endif
extern "C" void kernel_launch(void* const* d_in, const int* in_sizes, int n_in, void* d_out, int out_size, void* d_ws, size_t ws_size, hipStream_t stream) {
    static int grid = 0;
    if (grid == 0) {
        if (n_in != 27 || out_size != NLAT * DM || ws_size < WS_END) { fprintf(stderr, "kernel_launch: unexpected shapes / workspace (%d inputs, out %d, ws %zu < %zu)\n", n_in, out_size, ws_size, (size_t)WS_END); grid = -1; return; }
        int dev = 0, cus = 0, per_cu = 0;
        hipGetDevice(&dev);
        hipDeviceGetAttribute(&cus, hipDeviceAttributeMultiprocessorCount, dev);
        hipFuncSetAttribute((const void*)mk_fwd, hipFuncAttributeMaxDynamicSharedMemorySize, LDS_BYTES);
        hipOccupancyMaxActiveBlocksPerMultiprocessor(&per_cu, (const void*)mk_fwd, 512, LDS_BYTES);
        if (per_cu < 1) { fprintf(stderr, "kernel_launch: occupancy query reports %d blocks per CU\n", per_cu); per_cu = 1; }
        grid = cus >= 256 ? 256 : cus;
        (void)hipGetLastError();
    }
    if (grid < 0) return;
    if (hipMemsetAsync((char*)d_ws + WS_CTL, 0, CTL_BYTES, stream) != hipSuccess) { fprintf(stderr, "kernel_launch: memset failed\n"); return; }
    Params p{};
    for (int i = 0; i < 27; ++i) p.in[i] = (const float*)d_in[i];
    p.out = (float*)d_out; p.ws = (unsigned char*)d_ws;
#if MK_SPLIT
    for (int ph = 0; ph < NSTEP; ++ph) {
        p.ph_lo = ph; p.ph_hi = ph + 1;
        void* args[] = {&p};
        hipError_t e = hipLaunchCooperativeKernel((const void*)mk_fwd, dim3(grid), dim3(512), args, LDS_BYTES, stream);
        if (e != hipSuccess) { fprintf(stderr, "cooperative launch failed: %s\n", hipGetErrorString(e)); return; }
    }
#else
    p.ph_lo = 0; p.ph_hi = NSTEP;
    void* args[] = {&p};
    hipError_t e = hipLaunchCooperativeKernel((const void*)mk_fwd, dim3(grid), dim3(512), args, LDS_BYTES, stream);
    if (e != hipSuccess) fprintf(stderr, "cooperative launch failed: %s (grid %d)\n", hipGetErrorString(e), grid);
#endif
}
```

```cpp
#include <hip/hip_runtime.h>
#include <hip/hip_cooperative_groups.h>
#include <cstdio>
#include <cstdint>
namespace cg = cooperative_groups;
__device__ __forceinline__ int otid() { int t = threadIdx.x; asm volatile("" : "+v"(t)); return t; }
namespace pg8 {
#define PG8_LAS __attribute__((address_space(3)))
typedef unsigned short bf16_t;
typedef short bf16x8 __attribute__((ext_vector_type(8)));
typedef float f32x4 __attribute__((ext_vector_type(4)));
typedef unsigned u32x4 __attribute__((ext_vector_type(4)));
constexpr int BM = 256, BK = 64, HALF = 128, HTB = HALF * BK * 2  , STAGE_BYTES = 8 * HTB, NXCD = 8, WGM = 8;

__host__ __device__ __forceinline__ int lds_byte(int r, int c) { const int st = (r >> 4) * 2 + (c >> 5), rr = r & 15, cc = c & 31, ob = rr * 64 + cc * 2; return st * 1024 + (ob ^ (((ob >> 9) & 1) << 5)); }
__host__ __device__ __forceinline__ void stage_rc(int b, int& R, int& C) { const int st = b / 1024, sb = b % 1024, swz = sb ^ (((sb >> 9) & 1) << 5); R = (st >> 1) * 16 + swz / 64; C = (st & 1) * 32 + (swz % 64) / 2; }
__host__ __device__ __forceinline__ int perm32(int rho) { const int n = rho >> 4, i = rho & 15; return 8 * (i >> 2) + 4 * n + (i & 3); }

struct Unit { int pm, pn; };
struct Gemm { const bf16_t* A; const bf16_t* Bt; int M, N; };

struct StaticOrder {
    int nM, nN, nwg, G, c;
    __host__ __device__ void init(int M, int N, int G_, int c_) { nM = M / BM; nN = N / BM; nwg = nM * nN; G = G_; c = c_; }
    __host__ __device__ bool next(int i, Unit& u) const {
        const long L = (long)i * G + c; if (L >= nwg) return false;
        int wgid = (int)L; { const int q = nwg / NXCD, r = nwg % NXCD, xcd = wgid % NXCD, off = wgid / NXCD; wgid = (xcd < r ? xcd * (q + 1) : r * (q + 1) + (xcd - r) * q) + off; }
        const int nig = WGM * nN, gid = wgid / nig, fm = gid * WGM, gsz = (nM - fm) < WGM ? (nM - fm) : WGM;
        u.pm = fm + ((wgid % nig) % gsz); u.pn = (wgid % nig) / gsz; return true;
    }
    __device__ __forceinline__ void a_ready(const Unit&) const {}
    __device__ __forceinline__ void done(const Unit&) const {}
};


template <class Epi, class Sched, bool ALIGN_EPI, bool SP2, int LDA, int LDB, int KDIM>
__device__ __forceinline__ void gemm_phase(PG8_LAS unsigned char* lds, const Gemm g, const Sched& S, const Epi& E) {
    const int tid = otid(), wid = __builtin_amdgcn_readfirstlane(tid >> 6), lane = tid & 63, wr = wid >> 2, wc = wid & 3, fr = lane & 15, fq = lane >> 4;
    constexpr int K = KDIM, nt = K / BK;
    unsigned voffA[2], voffB[2];
#pragma unroll
    for (int i = 0; i < 2; ++i) { int R, C; stage_rc(tid * 16 + i * 8192, R, C); const int Rb = Epi::PERM ? ((R & ~31) + perm32(R & 31)) : R;
        voffA[i] = (unsigned)(R * LDA + C) * 2u; voffB[i] = (unsigned)(Rb * LDB + C) * 2u; }
    constexpr size_t kstep = (size_t)(BK * 2);
    constexpr size_t hstepA = (size_t)HALF * LDA * 2, hstepB = (size_t)HALF * LDB * 2;
    constexpr size_t tstepA = 2 * hstepA, tstepB = 2 * hstepB;
    const unsigned ldsw = (unsigned)wid * 1024u;
    const int aoff = lds_byte(wr * 64 + fr, fq * 8), boff = lds_byte(wc * 32 + fr, fq * 8);
#define PG8_SA(b, h) (((b) * 2 + (h)) * HTB)
#define PG8_SB(b, h) ((4 + (b) * 2 + (h)) * HTB)
#define PG8_STAGE(bufoff, gbase, voff) do { _Pragma("unroll") for (int _i = 0; _i < 2; ++_i) \
        __builtin_amdgcn_global_load_lds((const unsigned*)((const char*)(gbase) + (voff)[_i]), (PG8_LAS unsigned*)(lds + (bufoff) + ldsw + _i * 8192), 16, 0, 0); } while (0)
#define PG8_LDA(dst, b, h) do { _Pragma("unroll") for (int m = 0; m < 4; ++m) _Pragma("unroll") for (int k = 0; k < 2; ++k) dst[m][k] = *(const PG8_LAS bf16x8*)(lds + PG8_SA(b, h) + aoff + m * 2048 + k * 1024); } while (0)
#define PG8_LDB(dst, b, h) do { _Pragma("unroll") for (int n = 0; n < 2; ++n) _Pragma("unroll") for (int k = 0; k < 2; ++k) dst[n][k] = *(const PG8_LAS bf16x8*)(lds + PG8_SB(b, h) + boff + n * 2048 + k * 1024); } while (0)
#define PG8_MMA(ai, bj, At, Bt) do { __builtin_amdgcn_s_setprio(1); _Pragma("unroll") for (int m = 0; m < 4; ++m) _Pragma("unroll") for (int n = 0; n < 2; ++n) _Pragma("unroll") for (int k = 0; k < 2; ++k) \
        acc[ai][bj][m][n] = __builtin_amdgcn_mfma_f32_16x16x32_bf16(Bt[n][k], At[m][k], acc[ai][bj][m][n], 0, 0, 0); __builtin_amdgcn_s_setprio(0); } while (0)
#define PG8_WAIT_V(n) asm volatile("s_waitcnt vmcnt(" #n ")" ::: "memory")
#define PG8_WAIT_L(n) asm volatile("s_waitcnt lgkmcnt(" #n ")" ::: "memory")
#define PG8_BAR __builtin_amdgcn_s_barrier()
#define PG8_SCHED __builtin_amdgcn_sched_barrier(0)
    Unit cur, nxt; int ui = 0;
    if (!S.next(0, cur)) return;
    float zf = 0.f; asm volatile("" : "+v"(zf));
    f32x4 acc[2][2][4][2];
#pragma unroll
    for (int a = 0; a < 2; ++a)
#pragma unroll
        for (int b = 0; b < 2; ++b)
#pragma unroll
            for (int m = 0; m < 4; ++m)
#pragma unroll
                for (int n = 0; n < 2; ++n) acc[a][b][m][n] = (f32x4){zf, zf, zf, zf};
    bf16x8 At[4][2], B0[2][2], B1[2][2];
    const char* cA = (const char*)g.A + (size_t)cur.pm * tstepA; const char* cB = (const char*)g.Bt + (size_t)cur.pn * tstepB;
    S.a_ready(cur);
    if constexpr (SP2) {
        PG8_STAGE(PG8_SB(0, 0), cB, voffB); PG8_STAGE(PG8_SB(0, 1), cB + hstepB, voffB); PG8_STAGE(PG8_SA(0, 0), cA, voffA); PG8_STAGE(PG8_SA(0, 1), cA + hstepA, voffA);
        if (wr == 1) PG8_BAR;
        PG8_WAIT_V(2); PG8_BAR;
        PG8_STAGE(PG8_SB(1, 0), cB + kstep, voffB); PG8_STAGE(PG8_SA(1, 0), cA + kstep, voffA); PG8_STAGE(PG8_SB(1, 1), cB + hstepB + kstep, voffB);
        PG8_WAIT_V(6); PG8_BAR;
    } else {
        PG8_STAGE(PG8_SB(0, 0), cB, voffB); PG8_STAGE(PG8_SA(0, 0), cA, voffA); PG8_STAGE(PG8_SB(0, 1), cB + hstepB, voffB); PG8_STAGE(PG8_SA(0, 1), cA + hstepA, voffA);
        if (wr == 1) PG8_BAR;
        PG8_WAIT_V(4); PG8_BAR;
        PG8_STAGE(PG8_SB(1, 0), cB + kstep, voffB); PG8_STAGE(PG8_SA(1, 0), cA + kstep, voffA); PG8_STAGE(PG8_SB(1, 1), cB + hstepB + kstep, voffB);
        PG8_WAIT_V(6); PG8_BAR;
    }
    for (;;) {
        const bool has_next = S.next(ui + 1, nxt);
        const char* nA = has_next ? (const char*)g.A + (size_t)nxt.pm * tstepA : cA; const char* nB = has_next ? (const char*)g.Bt + (size_t)nxt.pn * tstepB : cB;
#pragma nounroll
        for (int t = 0; t < nt; t += 2) {
            const bool last = (t == nt - 2);
            const char* a1 = cA + (size_t)(t + 1) * kstep;
            const char* a2 = last ? nA : cA + (size_t)(t + 2) * kstep; const char* b2 = last ? nB : cB + (size_t)(t + 2) * kstep;
            const char* a3 = a2 + kstep; const char* b3 = b2 + kstep;
            if (last && has_next) S.a_ready(nxt);
            if constexpr (SP2) {
            PG8_LDB(B0, 0, 0); PG8_LDB(B1, 0, 1); PG8_SCHED; PG8_LDA(At, 0, 0); PG8_STAGE(PG8_SA(1, 1), a1 + hstepA, voffA);
            PG8_WAIT_V(8); PG8_WAIT_L(0); PG8_BAR; PG8_MMA(0, 0, At, B0); PG8_MMA(0, 1, At, B1); PG8_BAR; PG8_SCHED;
            PG8_LDA(At, 0, 1); PG8_STAGE(PG8_SB(0, 0), b2, voffB); PG8_STAGE(PG8_SB(0, 1), b2 + hstepB, voffB); PG8_STAGE(PG8_SA(0, 0), a2, voffA);
            PG8_WAIT_V(8); PG8_WAIT_L(0); PG8_BAR; PG8_MMA(1, 0, At, B0); PG8_MMA(1, 1, At, B1); PG8_BAR; PG8_SCHED;
            PG8_LDB(B0, 1, 0); PG8_LDB(B1, 1, 1); PG8_SCHED; PG8_LDA(At, 1, 0); PG8_STAGE(PG8_SA(0, 1), a2 + hstepA, voffA);
            PG8_WAIT_V(8); PG8_WAIT_L(0); PG8_BAR; PG8_MMA(0, 0, At, B0); PG8_MMA(0, 1, At, B1); PG8_BAR; PG8_SCHED;
            PG8_LDA(At, 1, 1); PG8_STAGE(PG8_SB(1, 0), b3, voffB); PG8_STAGE(PG8_SB(1, 1), b3 + hstepB, voffB); PG8_STAGE(PG8_SA(1, 0), a3, voffA);
            PG8_WAIT_V(8); PG8_WAIT_L(0); PG8_BAR; PG8_MMA(1, 0, At, B0); PG8_MMA(1, 1, At, B1); PG8_BAR; PG8_SCHED;
            } else {
            PG8_LDB(B0, 0, 0); PG8_SCHED; PG8_LDA(At, 0, 0); PG8_STAGE(PG8_SA(1, 1), a1 + hstepA, voffA);
            PG8_WAIT_L(8); PG8_BAR; PG8_WAIT_L(0); PG8_MMA(0, 0, At, B0); PG8_BAR; PG8_SCHED;
            PG8_LDB(B1, 0, 1); PG8_STAGE(PG8_SB(0, 0), b2, voffB);
            PG8_BAR; PG8_WAIT_L(0); PG8_MMA(0, 1, At, B1); PG8_BAR;
            PG8_LDA(At, 0, 1); PG8_STAGE(PG8_SA(0, 0), a2, voffA);
            PG8_BAR; PG8_WAIT_L(0); PG8_MMA(1, 0, At, B0); PG8_BAR; PG8_SCHED;
            PG8_STAGE(PG8_SB(0, 1), b2 + hstepB, voffB);
            PG8_WAIT_V(6); PG8_BAR; PG8_MMA(1, 1, At, B1); PG8_BAR;
            PG8_LDB(B0, 1, 0); PG8_SCHED; PG8_LDA(At, 1, 0); PG8_STAGE(PG8_SA(0, 1), a2 + hstepA, voffA);
            PG8_WAIT_L(8); PG8_BAR; PG8_WAIT_L(0); PG8_MMA(0, 0, At, B0); PG8_BAR; PG8_SCHED;
            PG8_LDB(B1, 1, 1); PG8_STAGE(PG8_SB(1, 0), b3, voffB);
            PG8_BAR; PG8_WAIT_L(0); PG8_MMA(0, 1, At, B1); PG8_BAR;
            PG8_LDA(At, 1, 1); PG8_STAGE(PG8_SA(1, 0), a3, voffA);
            PG8_BAR; PG8_WAIT_L(0); PG8_MMA(1, 0, At, B0); PG8_BAR; PG8_SCHED;
            PG8_STAGE(PG8_SB(1, 1), b3 + hstepB, voffB);
            PG8_WAIT_V(6); PG8_BAR; PG8_MMA(1, 1, At, B1); PG8_BAR;
            }
        }
        if constexpr (ALIGN_EPI) { if (wr == 0) PG8_BAR; }
        if constexpr (!Epi::AFTER_DRAIN) { const int t2 = otid(); int fr2 = t2 & 15, fq2 = (t2 >> 4) & 3;
            E(acc, cur, wr, wc, fr2, fq2); S.done(cur); }
        if (!has_next) break;
#pragma unroll
        for (int a = 0; a < 2; ++a)
#pragma unroll
            for (int b = 0; b < 2; ++b)
#pragma unroll
                for (int m = 0; m < 4; ++m)
#pragma unroll
                    for (int n = 0; n < 2; ++n) acc[a][b][m][n] = (f32x4){zf, zf, zf, zf};
        cur = nxt; cA = nA; cB = nB; ++ui;
        if constexpr (ALIGN_EPI) { if (wr == 1) PG8_BAR; }
    }
    PG8_WAIT_V(0);
    if constexpr (!ALIGN_EPI) { if (wr == 0) PG8_BAR; }
    PG8_BAR;
    if constexpr (Epi::AFTER_DRAIN) { E.fused(acc, cur, wr, wc, fr, fq, lds, wid, lane); S.done(cur); }
#undef PG8_SA
#undef PG8_SB
#undef PG8_STAGE
#undef PG8_LDA
#undef PG8_LDB
#undef PG8_MMA
#undef PG8_WAIT_V
#undef PG8_WAIT_L
#undef PG8_BAR
#undef PG8_SCHED
}
}

#define LAS __attribute__((address_space(3)))
typedef unsigned short bf16;
typedef float f32x2 __attribute__((ext_vector_type(2)));
typedef float f32x4 __attribute__((ext_vector_type(4)));
typedef float f32x16 __attribute__((ext_vector_type(16)));
typedef short bf16x8 __attribute__((ext_vector_type(8)));
typedef unsigned u32x4 __attribute__((ext_vector_type(4)));
typedef unsigned u32x2 __attribute__((ext_vector_type(2)));
typedef __bf16 bf16x2_t __attribute__((ext_vector_type(2)));
#define DI __device__ __forceinline__

DI unsigned pk2(float lo, float hi) { f32x2 v = {lo, hi}; bf16x2_t b = __builtin_convertvector(v, bf16x2_t); return __builtin_bit_cast(unsigned, b); }
DI float bflo(unsigned u) { return __uint_as_float(u << 16); }
DI float bfhi(unsigned u) { return __uint_as_float(u & 0xffff0000u); }
DI u32x4 pack8(f32x4 a, f32x4 b) { u32x4 w; w.x = pk2(a[0], a[1]); w.y = pk2(a[2], a[3]); w.z = pk2(b[0], b[1]); w.w = pk2(b[2], b[3]); return w; }
DI float shx(float v, int m) { const int l = (otid() & 63) ^ m; return __builtin_bit_cast(float, __builtin_amdgcn_ds_bpermute(l << 2, __builtin_bit_cast(int, v))); }
DI float wave_sum(float v) {
#pragma unroll
    for (int o = 1; o < 64; o <<= 1) v += shx(v, o);
    return v;
}
DI float ozero() { float z = 0.f; asm volatile("" : "+v"(z)); return z; }
DI float cos_turn(float t) { return __builtin_amdgcn_cosf(t); }
DI float sin_turn(float t) { return __builtin_amdgcn_sinf(t); }
DI float fexp2(float x) { return __builtin_amdgcn_exp2f(x); }
DI float frcp(float x) { return __builtin_amdgcn_rcpf(x); }
#define LDS_WAIT() asm volatile("s_waitcnt lgkmcnt(0)" ::: "memory")

constexpr int DM = 1024, NB = 8, SEQ = 2048, DEPTH = 4, CTXL = 256;
constexpr int NLAT = NB * SEQ, NCTX = NB * CTXL, MTOK = NLAT + NCTX;
constexpr int NPROJ = 1536, DFF = 2816, MIXD = 1280, NKEY = SEQ + CTXL;
constexpr int PO_KR = 384, PO_SU = 416, PO_SV = 672, PO_POOL = 928, PO_F = 1184, IN_DIM = 1440;
constexpr float LN_EPS = 1e-6f;
constexpr float ALPHA = 1.6817928305074290f;
constexpr float QSCALE = 0.10206207261596575f * 1.4426950408889634f;

constexpr size_t WS_XRES = 0;
constexpr size_t WS_HA   = WS_XRES + (size_t)MTOK * DM * 4;
constexpr size_t WS_PROJ = WS_HA + (size_t)MTOK * DM * 2;
constexpr size_t WS_QLAT = WS_PROJ + (size_t)MTOK * NPROJ * 2;
constexpr size_t WS_QCTX = WS_QLAT + (size_t)64 * SEQ * 96 * 2;
constexpr size_t WS_K    = WS_QCTX + (size_t)64 * CTXL * 96 * 2;
constexpr size_t WS_VT   = WS_K + (size_t)64 * NKEY * 96 * 2;
constexpr size_t WS_U    = WS_PROJ;
static_assert((size_t)MTOK * DFF * 2 <= WS_VT - WS_PROJ, "U overlay");
constexpr size_t WS_GTL  = WS_VT + (size_t)64 * 64 * NKEY * 2;
constexpr size_t WS_GTC  = WS_GTL + (size_t)2048 * 4096 * 2;
constexpr size_t WS_MIX  = WS_GTC + (size_t)2048 * 512 * 2;
constexpr size_t WS_WIN  = WS_MIX + (size_t)MTOK * MIXD * 2;
constexpr size_t WS_WQK  = WS_WIN + (size_t)1536 * 1024 * 2;
constexpr size_t WS_WV   = WS_WQK + (size_t)1280 * 384 * 2;
constexpr size_t WS_WF   = WS_WV + (size_t)512 * 384 * 2;
constexpr size_t WS_WOUT = WS_WF + (size_t)512 * 256 * 2;
constexpr size_t WS_W13  = WS_WOUT + (size_t)1024 * 1280 * 2;
constexpr size_t WS_W2   = WS_W13 + (size_t)5632 * 1024 * 2;
constexpr size_t WS_WPOOL= WS_W2 + (size_t)1024 * 2816 * 2;
constexpr size_t WS_WS   = WS_WPOOL + (size_t)4 * 64 * 64 * 2;
constexpr size_t WS_CSL  = WS_WS + (size_t)4 * 128 * 128 * 2;
constexpr size_t WS_CSC  = WS_CSL + (size_t)2048 * 4096 * 2;
constexpr size_t WS_MOD  = WS_CSC + (size_t)256 * 512 * 2;
constexpr size_t WS_ROPE = WS_MOD + (size_t)4 * 9 * 6144 * 4;
constexpr size_t WS_STQ  = WS_ROPE + (size_t)2048 * 32 * 4;
constexpr size_t WS_STKV = WS_STQ + (size_t)MTOK * 4 * 4;
constexpr size_t WS_ST   = WS_STKV + (size_t)MTOK * 4 * 4;
constexpr size_t WS_XBE  = WS_ST + (size_t)MTOK * 2 * 4;
constexpr size_t WS_XBH  = WS_XBE + (size_t)72 * 256 * 4 * 8;
constexpr size_t WS_CTL  = WS_XBH + (size_t)72 * 256 * 4 * 8;
constexpr size_t CTL_BYTES = 32768;
constexpr size_t WS_END  = WS_CTL + CTL_BYTES;
constexpr int MISC_OFF = 139264;

constexpr int LDS_BYTES = 147456;

struct Params { const float* in[27]; float* out; unsigned char* ws; int ph_lo, ph_hi; };
DI const float* inp(const Params& p, int i) { asm volatile("" : "+s"(i)); return p.in[i]; }
DI unsigned char* wsp(const Params& p) { unsigned char* w = p.ws; asm volatile("" : "+s"(w)); return w; }

#define XB_TMO      128
#define XB_XCNT(j)  (256  + 64 * (j))
#define XB_XSUB(j)  (1280 + 64 * (j))
#define XB_XGEN(j)  (2304 + 64 * (j))
#define XB_TOP      3328
#define XB_TOPGEN   3392
#define XCD_BAR_WORDS 3456
#define XB_SPIN_CAP (1u << 18)

__device__ __forceinline__ unsigned xb_ld(unsigned* p)              { return __hip_atomic_load(p, __ATOMIC_RELAXED, __HIP_MEMORY_SCOPE_AGENT); }
__device__ __forceinline__ unsigned xb_add(unsigned* p, unsigned v) { return __hip_atomic_fetch_add(p, v, __ATOMIC_RELAXED, __HIP_MEMORY_SCOPE_AGENT); }
__device__ __forceinline__ unsigned xb_xcc_id() { return (unsigned)__builtin_amdgcn_s_getreg((3 << 11) | 20) & 0xFu; }
#define XB_SPIN(cond, bar) do { unsigned _sp = 0; while (cond) { __builtin_amdgcn_s_sleep(1); \
    if ((++_sp & 255u) == 0u) { if (xb_ld(&(bar)[XB_TMO])) break; if (_sp > XB_SPIN_CAP) { atomicAdd(&(bar)[XB_TMO], 1u); break; } } } } while (0)

struct XcdBarrier {
    unsigned* bar; unsigned x;
    volatile LAS unsigned* st;
};

__device__ __forceinline__ XcdBarrier xcd_barrier_post(unsigned* bar, volatile LAS unsigned* st) {
    XcdBarrier b; b.bar = bar; b.x = xb_xcc_id(); b.st = st;
    if (threadIdx.x == 0) (void)xb_add(&bar[XB_XCNT(b.x)], 1u);
    return b;
}
__device__ __forceinline__ void xcd_barrier_complete(unsigned* bar, unsigned x, unsigned& nloc, unsigned& nx) {
    const unsigned G = gridDim.x * gridDim.y * gridDim.z;
    unsigned sum, cnt, mine, sp = 0u;
    for (;;) {
        sum = 0u; cnt = 0u; mine = 0u;
#pragma unroll
        for (unsigned j = 0; j < 16; ++j) { const unsigned c = xb_ld(&bar[XB_XCNT(j)]); sum += c; cnt += (c > 0u) ? 1u : 0u; mine = (j == x) ? c : mine; }
        if (sum == G) break;
        __builtin_amdgcn_s_sleep(1);
        if ((++sp & 255u) == 0u) { if (xb_ld(&bar[XB_TMO])) break; if (sp > XB_SPIN_CAP) { atomicAdd(&bar[XB_TMO], 1u); break; } }
    }
    nloc = mine > 0u ? mine : 1u; nx = cnt > 0u ? cnt : 1u;
}

__device__ __forceinline__ void xcd_barrier(const XcdBarrier& b) {
    asm volatile("s_waitcnt vmcnt(0)" ::: "memory");
    __syncthreads();
    if (threadIdx.x == 0) {
        unsigned* bar = b.bar;
        __builtin_amdgcn_s_waitcnt(0);
        unsigned nloc = b.st[0], nx = b.st[1];
        if (nloc == 0u) { xcd_barrier_complete(bar, b.x, nloc, nx); b.st[0] = nloc; b.st[1] = nx; }
        const unsigned old = xb_add(&bar[XB_XSUB(b.x)], 1u);
        const unsigned gen = old / nloc;
        if (old + 1u == (gen + 1u) * nloc) {
            __builtin_amdgcn_fence(__ATOMIC_RELEASE, "agent");
            asm volatile("s_waitcnt vmcnt(0)" ::: "memory");
            const unsigned og = xb_add(&bar[XB_TOP], 1u);
            const unsigned tg = og / nx;
            if (og + 1u == (tg + 1u) * nx) xb_add(&bar[XB_TOPGEN], 1u);
            else XB_SPIN(xb_ld(&bar[XB_TOPGEN]) == tg, bar);
            __builtin_amdgcn_fence(__ATOMIC_ACQUIRE, "agent");
            xb_add(&bar[XB_XGEN(b.x)], 1u);
            asm volatile("s_waitcnt vmcnt(0)" ::: "memory");
        } else {
            XB_SPIN(xb_ld(&bar[XB_XGEN(b.x)]) == gen, bar);
            __builtin_amdgcn_fence(__ATOMIC_ACQUIRE, "agent");
            asm volatile("s_waitcnt vmcnt(0)" ::: "memory");
        }
    }
    __syncthreads();
}

typedef pg8::f32x4 A4;
DI void row_info(int row, int& b, int& pos, bool& lat) { lat = row < NLAT; if (lat) { b = row >> 11; pos = row & 2047; } else { b = (row - NLAT) >> 8; pos = (row - NLAT) & 255; } }

struct EpiProj {
    static constexpr bool PERM = true, AFTER_DRAIN = false;
    bf16* O; float* statq; float* statkv;
    DI void operator()(const A4 (&acc)[2][2][4][2], const pg8::Unit& u, int wr, int wc, int fr, int fq) const {
        const int row0 = u.pm * 256 + wr * 64 + fr, col0 = u.pn * 256 + wc * 32 + 8 * fq;
#pragma unroll
        for (int ai = 0; ai < 2; ++ai)
#pragma unroll
            for (int m = 0; m < 4; ++m) {
                const int row = row0 + ai * 128 + m * 16;
                bf16* rowp = O + (size_t)row * NPROJ + col0;
#pragma unroll
                for (int bj = 0; bj < 2; ++bj) *(u32x4*)(rowp + bj * 128) = pack8(acc[ai][bj][m][0], acc[ai][bj][m][1]);
                if (u.pn <= 1) {
                    float s = 0.f;
#pragma unroll
                    for (int bj = 0; bj < 2; ++bj) {
                        if (u.pn == 1 && bj == 1) continue;
#pragma unroll
                        for (int n = 0; n < 2; ++n) { const A4 x = acc[ai][bj][m][n]; s += (x[0] * x[0] + x[1] * x[1]) + (x[2] * x[2] + x[3] * x[3]); }
                    }
                    s += shx(s, 16); s += shx(s, 32);
                    if (fq == 0) { if (u.pn == 0) statq[row * 4 + wc] = s; else statkv[row * 4 + wc] = s; }
                }
            }
    }
};

struct EpiQK {
    static constexpr bool PERM = true, AFTER_DRAIN = false;
    bf16* Ql; bf16* Qc; bf16* Kb; const float* statq; const float* statkv; const float* rope;
    DI void operator()(const A4 (&acc)[2][2][4][2], const pg8::Unit& u, int wr, int wc, int fr, int fq) const {
        const int row0 = u.pm * 256 + wr * 64 + fr, col0 = u.pn * 256 + wc * 32 + 8 * fq;
        const bool isq = u.pn < 3;
        const bool lat = u.pm < 64;
        const int g32a = (col0 >> 5), g32b = ((col0 + 128) >> 5);
        const bool ropeA = isq && lat && (g32a % 3 == 2), ropeB = isq && lat && (g32b % 3 == 2);
        f32x4 stv[8];
#pragma unroll
        for (int q = 0; q < 8; ++q) stv[q] = *(const f32x4*)((isq ? statq : statkv) + (row0 + (q >> 2) * 128 + (q & 3) * 16) * 4);
        f32x4 rc0[8], rc1[8], rs0[8], rs1[8];
#pragma unroll
        for (int q = 0; q < 8; ++q) {
            if ((q & 1) == 0) {
                if (ropeA || ropeB) {
#pragma unroll
                    for (int q2 = q; q2 < q + 2; ++q2) { const int pos2 = (row0 + (q2 >> 2) * 128 + (q2 & 3) * 16) & 2047; const float* rp = rope + pos2 * 32 + (fq >> 1) * 8;
                        rc0[q2] = *(const f32x4*)rp; rc1[q2] = *(const f32x4*)(rp + 4); rs0[q2] = *(const f32x4*)(rp + 16); rs1[q2] = *(const f32x4*)(rp + 20); }
                }
                __builtin_amdgcn_sched_barrier(0);
            }
            const int ai = q >> 2, m = q & 3;
            const int row = row0 + ai * 128 + m * 16;
            int b, pos; bool lat2; row_info(row, b, pos, lat2);
            const f32x4 st = stv[q];
            const float ss = (st[0] + st[1]) + (st[2] + st[3]);
            const float rs = isq ? rsqrtf(ss * (1.f / 256.f) + LN_EPS) * QSCALE : rsqrtf(ss * (1.f / 128.f) + LN_EPS);
#pragma unroll
            for (int bj = 0; bj < 2; ++bj) {
                const int c = col0 + bj * 128;
                A4 v0 = acc[ai][bj][m][0] * rs, v1 = acc[ai][bj][m][1] * rs;
                if (isq) {
                    const int g32 = c >> 5, head = g32 / 3, part = g32 - head * 3, d0 = part * 32 + 8 * fq;
                    if (bj == 0 ? ropeA : ropeB) {
                        A4 p0, p1;
#pragma unroll
                        for (int j = 0; j < 4; ++j) { p0[j] = shx(v0[j], 16); p1[j] = shx(v1[j], 16); }
                        if (fq & 1) { v0 = p0 * rs0[q] + v0 * rc0[q]; v1 = p1 * rs1[q] + v1 * rc1[q]; }
                        else        { v0 = v0 * rc0[q] - p0 * rs0[q]; v1 = v1 * rc1[q] - p1 * rs1[q]; }
                    }
                    bf16* dst = lat ? Ql + ((size_t)(b * 8 + head) * SEQ + pos) * 96 + d0 : Qc + ((size_t)(b * 8 + head) * CTXL + pos) * 96 + d0;
                    *(u32x4*)dst = pack8(v0, v1);
                } else {
                    const int cc = c - 768, head = cc >> 6, d0 = cc & 63;
                    bf16* dst = Kb + ((size_t)(b * 8 + head) * NKEY + (lat ? CTXL + pos : pos)) * 96 + d0;
                    *(u32x4*)dst = pack8(v0, v1);
                }
            }
        }
    }
};

DI float rstd_kv_tok(const float* statkv, int t) { const f32x4 st = *(const f32x4*)(statkv + t * 4); return rsqrtf(((st[0] + st[1]) + (st[2] + st[3])) * (1.f / 128.f) + LN_EPS); }

struct EpiVt {
    static constexpr bool PERM = true, AFTER_DRAIN = false;
    bf16* Vt; const float* statkv;
    DI void operator()(const A4 (&acc)[2][2][4][2], const pg8::Unit& u, int wr, int wc, int fr, int fq) const {
        const int row0 = u.pm * 256 + wr * 64 + fr, col0 = u.pn * 256 + wc * 32 + 8 * fq;
#pragma unroll
        for (int bj = 0; bj < 2; ++bj) {
            const int t0 = col0 + bj * 128;
            int b, pos; bool lat; row_info(t0, b, pos, lat);
            A4 r0, r1;
#pragma unroll
            for (int j = 0; j < 4; ++j) { r0[j] = rstd_kv_tok(statkv, t0 + j); r1[j] = rstd_kv_tok(statkv, t0 + 4 + j); }
#pragma unroll
            for (int ai = 0; ai < 2; ++ai)
#pragma unroll
                for (int m = 0; m < 4; ++m) {
                    const int row = row0 + ai * 128 + m * 16, head = row >> 6, dv = row & 63;
                    bf16* dst = Vt + ((size_t)(b * 8 + head) * 64 + dv) * NKEY + (lat ? CTXL + pos : pos);
                    *(u32x4*)dst = pack8(acc[ai][bj][m][0] * r0, acc[ai][bj][m][1] * r1);
                }
        }
    }
};

struct EpiGt {
    static constexpr bool PERM = true, AFTER_DRAIN = false;
    bf16* Gl; bf16* Gc;
    DI void operator()(const A4 (&acc)[2][2][4][2], const pg8::Unit& u, int wr, int wc, int fr, int fq) const {
        const int row0 = u.pm * 256 + wr * 64 + fr, col0 = u.pn * 256 + wc * 32 + 8 * fq;
#pragma unroll
        for (int bj = 0; bj < 2; ++bj) {
            const int t0 = col0 + bj * 128;
            int b, pos; bool lat; row_info(t0, b, pos, lat);
#pragma unroll
            for (int ai = 0; ai < 2; ++ai)
#pragma unroll
                for (int m = 0; m < 4; ++m) {
                    const int row = row0 + ai * 128 + m * 16, n = row & 255, half = row >> 8;
                    bf16* dst = lat ? Gl + (size_t)(b * 256 + n) * 4096 + half * 2048 + pos : Gc + (size_t)(b * 256 + n) * 512 + half * 256 + pos;
                    *(u32x4*)dst = pack8(acc[ai][bj][m][0], acc[ai][bj][m][1]);
                }
        }
    }
};

struct EpiDft {
    static constexpr bool PERM = true, AFTER_DRAIN = false;
    bf16* mix; int row_base, rows_per_b;
    DI void operator()(const A4 (&acc)[2][2][4][2], const pg8::Unit& u, int wr, int wc, int fr, int fq) const {
        const int row0 = u.pm * 256 + wr * 64 + fr, n0 = wc * 32 + 8 * fq;
#pragma unroll
        for (int ai = 0; ai < 2; ++ai)
#pragma unroll
            for (int m = 0; m < 4; ++m) {
                const int k = row0 + ai * 128 + m * 16;
                bf16* rowp = mix + (size_t)(row_base + u.pn * rows_per_b + k) * MIXD + 1024 + n0;
#pragma unroll
                for (int bj = 0; bj < 2; ++bj) *(u32x4*)(rowp + bj * 128) = pack8(acc[ai][bj][m][0], acc[ai][bj][m][1]);
            }
    }
};

struct EpiRes {
    static constexpr bool PERM = true, AFTER_DRAIN = false;
    const float* Xin; float* Xout; const float* ST; const float* lg; const float* lb; const float* modl; int goff; int pm_off;
    DI void operator()(const A4 (&acc)[2][2][4][2], const pg8::Unit& u, int wr, int wc, int fr, int fq) const {
        const int row0 = u.pm * 256 + wr * 64 + fr, col0 = u.pn * 256 + wc * 32 + 8 * fq;
        const int bidx = (u.pm + pm_off < 64) ? ((u.pm + pm_off) >> 3) : 8;
        const float* gp = modl + bidx * 6144 + goff + col0;
        const bool has_ln = lg != nullptr;
#pragma unroll
        for (int bj = 0; bj < 2; ++bj) {
            const f32x4 g0 = *(const f32x4*)(gp + bj * 128), g1 = *(const f32x4*)(gp + bj * 128 + 4);
            f32x4 ga0 = (f32x4){ALPHA, ALPHA, ALPHA, ALPHA}, ga1 = ga0, be0 = (f32x4){0.f, 0.f, 0.f, 0.f}, be1 = be0;
            if (has_ln) { ga0 = *(const f32x4*)(lg + col0 + bj * 128) * ALPHA; ga1 = *(const f32x4*)(lg + col0 + bj * 128 + 4) * ALPHA;
                          be0 = *(const f32x4*)(lb + col0 + bj * 128) * ALPHA; be1 = *(const f32x4*)(lb + col0 + bj * 128 + 4) * ALPHA; }
            f32x4 x0[8], x1[8]; f32x2 st[8];
#define EPR_ROW(q) (row0 + ((q) >> 2) * 128 + ((q) & 3) * 16)
#define EPR_LOAD(q) do { const float* rin = Xin + (size_t)EPR_ROW(q) * DM + col0 + bj * 128; x0[q] = *(const f32x4*)rin; x1[q] = *(const f32x4*)(rin + 4); \
                         st[q] = has_ln ? *(const f32x2*)(ST + 2 * EPR_ROW(q)) : (f32x2){0.f, 1.f}; } while (0)
            EPR_LOAD(0); EPR_LOAD(1);
#pragma unroll
            for (int q = 0; q < 8; ++q) {
                if (q + 2 < 8) EPR_LOAD(q + 2);
                float* rout = Xout + (size_t)EPR_ROW(q) * DM + col0 + bj * 128;
                *(f32x4*)rout = (x0[q] - st[q][0]) * st[q][1] * ga0 + be0 + g0 * acc[q >> 2][bj][q & 3][0];
                *(f32x4*)(rout + 4) = (x1[q] - st[q][0]) * st[q][1] * ga1 + be1 + g1 * acc[q >> 2][bj][q & 3][1];
                __builtin_amdgcn_sched_barrier(0);
            }
#undef EPR_LOAD
#undef EPR_ROW
        }
    }
};

DI f32x4 silu4(f32x4 a) { f32x4 r; for (int j = 0; j < 4; ++j) r[j] = a[j] * frcp(1.f + fexp2(-1.4426950408889634f * a[j])); return r; }
struct EpiSwiglu {
    static constexpr bool PERM = true, AFTER_DRAIN = false;
    bf16* U;
    DI void operator()(const A4 (&acc)[2][2][4][2], const pg8::Unit& u, int wr, int wc, int fr, int fq) const {
        const int row0 = u.pm * 256 + wr * 64 + fr, col0 = u.pn * 128 + wc * 32 + 8 * fq;
#pragma unroll
        for (int ai = 0; ai < 2; ++ai)
#pragma unroll
            for (int m = 0; m < 4; ++m) {
                const f32x4 h0 = silu4(acc[ai][0][m][0]) * acc[ai][1][m][0], h1 = silu4(acc[ai][0][m][1]) * acc[ai][1][m][1];
                *(u32x4*)(U + (size_t)(row0 + ai * 128 + m * 16) * DFF + col0) = pack8(h0, h1);
            }
    }
};

template <int M, int N> struct StaticOrderT {
    static constexpr int nM = M / 256, nN = N / 256, nwg = nM * nN;
    int G, c;
    static DI void map(int L, pg8::Unit& u) {
        int wgid = L; { constexpr int q = nwg / 8, r = nwg % 8; const int xcd = wgid % 8, off = wgid / 8; wgid = (xcd < r ? xcd * (q + 1) : r * (q + 1) + (xcd - r) * q) + off; }
        constexpr int nig = 8 * nN; const int gid = wgid / nig, fm = gid * 8, gsz = (nM - fm) < 8 ? (nM - fm) : 8;
        if constexpr (nM % 8 == 0) { u.pm = fm + ((wgid % nig) & 7); u.pn = (wgid % nig) >> 3; }
        else { u.pm = fm + ((wgid % nig) % gsz); u.pn = (wgid % nig) / gsz; }
    }
    DI bool next(int i, pg8::Unit& u) const { const int L = i * G + c; if (L >= nwg) return false; map(L, u); return true; }
    DI void a_ready(const pg8::Unit&) const {}
    DI void done(const pg8::Unit&) const {}
};
constexpr int CW_GCTX = 3584;
struct SchedG {
    int c; unsigned* cnt;
    DI bool next(int i, pg8::Unit& u) const {
        int L;
        if (c < 224) { L = c + 224 * i; if (L >= 1456) return false; }
        else { if (i >= 4) return false; L = 1456 + (c - 224) + 32 * i; }
        if (L < 176) { u.pm = 64 + (L & 7); u.pn = L >> 3; }
        else StaticOrderT<NLAT, 2 * DFF>::map(L - 176, u);
        return true;
    }
    DI void a_ready(const pg8::Unit&) const {}
    DI void done(const pg8::Unit& u) const {
        if (u.pm >= 64) {
            asm volatile("s_waitcnt vmcnt(0)" ::: "memory");
            __syncthreads();
            if (otid() == 0) { __builtin_amdgcn_fence(__ATOMIC_RELEASE, "agent"); asm volatile("s_waitcnt vmcnt(0)" ::: "memory"); (void)xb_add(cnt, 1u); }
        }
    }
};
constexpr int CW_ECTX = 3648;
DI void publish_block(unsigned* cnt) {
    asm volatile("s_waitcnt vmcnt(0)" ::: "memory");
    __syncthreads();
    if (otid() == 0) { __builtin_amdgcn_fence(__ATOMIC_RELEASE, "agent"); asm volatile("s_waitcnt vmcnt(0)" ::: "memory"); (void)xb_add(cnt, 1u); }
}
template <int M, int N> struct StaticOrderSig {
    int G, c; unsigned* cnt;
    DI bool next(int i, pg8::Unit& u) const { const int L = i * G + c; if (L >= StaticOrderT<M, N>::nwg) return false; StaticOrderT<M, N>::map(L, u); return true; }
    DI void a_ready(const pg8::Unit&) const {}
    DI void done(const pg8::Unit&) const { publish_block(cnt); }
};
constexpr int CW_QUAD_E = 4096, CW_QUAD_H = 4096 + 72 * 16;
DI void quad_wait(unsigned* cnt, unsigned target) {
    publish_block(cnt);
    if (otid() == 0) { unsigned sp = 0; while (xb_ld(cnt) < target) { __builtin_amdgcn_s_sleep(1); if (++sp > (1u << 22)) break; }
        __builtin_amdgcn_fence(__ATOMIC_ACQUIRE, "agent"); asm volatile("s_waitcnt vmcnt(0)" ::: "memory"); }
    __syncthreads();
}
struct EpiResLN {
    static constexpr bool PERM = true, AFTER_DRAIN = false;
    const Params& p; int l, kind  , ctx  ; bool lastl; LAS unsigned char* lds;
    DI void operator()(const A4 (&acc)[2][2][4][2], const pg8::Unit& u, int wr, int wc, int fr, int fq) const {
        unsigned char* ws = wsp(p);
        const int roff = ctx ? NLAT : 0, pm_off = ctx ? 64 : 0;
        float* XRESp = (float*)(ws + WS_XRES) + (size_t)roff * DM; float* STp = (float*)(ws + WS_ST) + 2 * roff; bf16* HAp = (bf16*)(ws + WS_HA) + (size_t)roff * DM;
        const float* modl = (const float*)(ws + WS_MOD) + (size_t)l * 9 * 6144;
        const float* Xin = (kind == 0 && l == 0) ? (ctx ? inp(p, 2) : inp(p, 0)) : XRESp; float* Xout = XRESp; const float* STin = STp; float* STout = STp;
        const float* lg = (kind == 0) ? (l == 0 ? nullptr : inp(p, 25) + (l - 1) * DM) : inp(p, 20) + l * DM;
        const float* lb = (kind == 0) ? (l == 0 ? nullptr : inp(p, 26) + (l - 1) * DM) : inp(p, 21) + l * DM;
        const int goff = (kind == 0) ? 2048 : 5120;
        const float* lg2 = (kind == 0) ? inp(p, 20) + l * DM : inp(p, 25) + l * DM; const float* lb2 = (kind == 0) ? inp(p, 21) + l * DM : inp(p, 26) + l * DM;
        const bool to_out = (kind == 1) && lastl;
        bf16* HAo = to_out ? nullptr : HAp; float* OUTo = to_out ? p.out : nullptr;
        const float* mod2 = (kind == 0 || lastl) ? modl : modl + 9 * 6144; const int sc_off = (kind == 0) ? 4096 : 1024, sh_off = (kind == 0) ? 3072 : 0;
        float* XB = (float*)(ws + (kind == 0 ? WS_XBE : WS_XBH)); unsigned* cnt = (unsigned*)(ws + WS_CTL) + (kind == 0 ? CW_QUAD_E : CW_QUAD_H); const unsigned target = 4u * (unsigned)(l + 1);
        const int urow0 = u.pm * 256 + wr * 64, ucol0 = u.pn * 256 + wc * 32, col0 = ucol0 + 8 * fq;
        const unsigned loff = (unsigned)(fr * DM + 8 * fq);
        const int bidx = (u.pm + pm_off < 64) ? ((u.pm + pm_off) >> 3) : 8;
        const float* gp = modl + bidx * 6144 + goff + col0;
        const bool has_ln = lg != nullptr;
        A4 y[2][2][4][2];
#define EPR_UROW(q) (urow0 + ((q) >> 2) * 128 + ((q) & 3) * 16)
#define EPR_ROW(q) (EPR_UROW(q) + fr)
#pragma unroll
        for (int bj = 0; bj < 2; ++bj) {
            const f32x4 g0 = *(const f32x4*)(gp + bj * 128), g1 = *(const f32x4*)(gp + bj * 128 + 4);
            f32x4 ga0 = (f32x4){ALPHA, ALPHA, ALPHA, ALPHA}, ga1 = ga0, be0 = (f32x4){0.f, 0.f, 0.f, 0.f}, be1 = be0;
            if (has_ln) { ga0 = *(const f32x4*)(lg + col0 + bj * 128) * ALPHA; ga1 = *(const f32x4*)(lg + col0 + bj * 128 + 4) * ALPHA;
                          be0 = *(const f32x4*)(lb + col0 + bj * 128) * ALPHA; be1 = *(const f32x4*)(lb + col0 + bj * 128 + 4) * ALPHA; }
#pragma unroll
            for (int q = 0; q < 8; ++q) {
                const float* rin = Xin + ((size_t)EPR_UROW(q) * DM + ucol0 + bj * 128) + loff; float* rout = Xout + ((size_t)EPR_UROW(q) * DM + ucol0 + bj * 128) + loff;
                const f32x4 x0 = *(const f32x4*)rin, x1 = *(const f32x4*)(rin + 4);
                f32x2 st = (f32x2){0.f, 1.f}; if (has_ln) st = *(const f32x2*)(STin + 2 * EPR_ROW(q));
                const f32x4 y0 = (x0 - st[0]) * st[1] * ga0 + be0 + g0 * acc[q >> 2][bj][q & 3][0];
                const f32x4 y1 = (x1 - st[0]) * st[1] * ga1 + be1 + g1 * acc[q >> 2][bj][q & 3][1];
                y[q >> 2][bj][q & 3][0] = y0; y[q >> 2][bj][q & 3][1] = y1;
                *(f32x4*)rout = y0; *(f32x4*)(rout + 4) = y1;
            }
        }
        LAS f32x2* P = (LAS f32x2*)(lds + 131072);
        LAS f32x2* S2 = (LAS f32x2*)(lds + MISC_OFF + 512);
#pragma unroll
        for (int q = 0; q < 8; ++q) {
            const int ai = q >> 2, m = q & 3;
            float s = 0.f;
#pragma unroll
            for (int bj = 0; bj < 2; ++bj)
#pragma unroll
                for (int n = 0; n < 2; ++n) { const A4 v = y[ai][bj][m][n]; s += (v[0] + v[1]) + (v[2] + v[3]); }
            s += shx(s, 16); s += shx(s, 32);
            const float mw = s * (1.f / 64.f); float qq = 0.f;
#pragma unroll
            for (int bj = 0; bj < 2; ++bj)
#pragma unroll
                for (int n = 0; n < 2; ++n) { const A4 d = y[ai][bj][m][n] - mw; qq += (d[0] * d[0] + d[1] * d[1]) + (d[2] * d[2] + d[3] * d[3]); }
            qq += shx(qq, 16); qq += shx(qq, 32);
            if (fq == 0) P[(ai * 128 + wr * 64 + m * 16 + fr) * 4 + wc] = (f32x2){mw, qq};
        }
        __syncthreads();
        const int t = otid(), panel = u.pm + pm_off;
        f32x2* xb = (f32x2*)XB + ((size_t)panel * 256) * 4;
        if (t < 256) {
            const f32x2 a = P[t * 4], b = P[t * 4 + 1], c = P[t * 4 + 2], d = P[t * 4 + 3];
            const float mb = (a[0] + b[0] + c[0] + d[0]) * 0.25f;
            const float m2 = (a[1] + b[1] + c[1] + d[1]) + 64.f * ((a[0] - mb) * (a[0] - mb) + (b[0] - mb) * (b[0] - mb) + (c[0] - mb) * (c[0] - mb) + (d[0] - mb) * (d[0] - mb));
            xb[t * 4 + u.pn] = (f32x2){mb, m2};
        }
        quad_wait(cnt + 16 * panel, target);
        if (t < 256) {
            const f32x2 a = xb[t * 4], b = xb[t * 4 + 1], c = xb[t * 4 + 2], d = xb[t * 4 + 3];
            const float mean = (a[0] + b[0] + c[0] + d[0]) * 0.25f;
            const float m2 = (a[1] + b[1] + c[1] + d[1]) + 256.f * ((a[0] - mean) * (a[0] - mean) + (b[0] - mean) * (b[0] - mean) + (c[0] - mean) * (c[0] - mean) + (d[0] - mean) * (d[0] - mean));
            const f32x2 st = (f32x2){mean, rsqrtf(m2 * (1.f / DM) + LN_EPS)};
            S2[t] = st;
            if (u.pn == 0) *(f32x2*)(STout + 2 * (u.pm * 256 + t)) = st;
        }
        __syncthreads();
        const float* mp = mod2 + bidx * 6144 + col0;
#pragma unroll
        for (int bj = 0; bj < 2; ++bj) {
            const f32x4 l0 = *(const f32x4*)(lg2 + col0 + bj * 128), l1 = *(const f32x4*)(lg2 + col0 + bj * 128 + 4);
            const f32x4 b0 = *(const f32x4*)(lb2 + col0 + bj * 128), b1 = *(const f32x4*)(lb2 + col0 + bj * 128 + 4);
            f32x4 sc0 = (f32x4){0.f, 0.f, 0.f, 0.f}, sc1 = sc0, sh0 = sc0, sh1 = sc0;
            if (HAo) { sc0 = *(const f32x4*)(mp + sc_off + bj * 128); sc1 = *(const f32x4*)(mp + sc_off + bj * 128 + 4); sh0 = *(const f32x4*)(mp + sh_off + bj * 128); sh1 = *(const f32x4*)(mp + sh_off + bj * 128 + 4); }
#pragma unroll
            for (int q = 0; q < 8; ++q) {
                const f32x2 st = S2[(q >> 2) * 128 + wr * 64 + (q & 3) * 16 + fr];
                const f32x4 x0 = (y[q >> 2][bj][q & 3][0] - st[0]) * st[1] * l0 + b0, x1 = (y[q >> 2][bj][q & 3][1] - st[0]) * st[1] * l1 + b1;
                if (HAo) *(u32x4*)(HAo + ((size_t)EPR_UROW(q) * DM + ucol0 + bj * 128) + loff) = pack8(x0 * (sc0 + 1.f) + sh0, x1 * (sc1 + 1.f) + sh1);
                else { float* o = OUTo + ((size_t)EPR_UROW(q) * DM + ucol0 + bj * 128) + loff; *(f32x4*)o = x0; *(f32x4*)(o + 4) = x1; }
            }
        }
#undef EPR_ROW
#undef EPR_UROW
        __syncthreads();
    }
};
struct SchedHC {
    int c; unsigned* cnt; unsigned target;
    DI bool next(int i, pg8::Unit& u) const { if (i > 0 || c < 224 || c >= 256) return false; const int k = c - 224; u.pm = k & 7; u.pn = k >> 3; return true; }
    DI void a_ready(const pg8::Unit&) const {
        if (otid() == 0) { unsigned sp = 0; while (xb_ld(cnt) < target) { __builtin_amdgcn_s_sleep(1); if (++sp > (1u << 22)) break; }
            __builtin_amdgcn_fence(__ATOMIC_ACQUIRE, "agent"); asm volatile("s_waitcnt vmcnt(0)" ::: "memory"); }
        __syncthreads();
    }
    DI void done(const pg8::Unit&) const {}
};
template <int LDA, int LDB, int KDIM, class Sched, class Epi> DI void run_gemm_s(LAS unsigned char* lds, const bf16* A, const bf16* Bt, int M, int N, const Sched& S, const Epi& E) {
    pg8::Gemm g{A, Bt, M, N};
    pg8::gemm_phase<Epi, Sched, true, true, LDA, LDB, KDIM>(lds, g, S, E);
    __syncthreads();
}
template <int LDA, int LDB, int KDIM, int M, int N, class Epi> DI void run_gemm(LAS unsigned char* lds, const bf16* A, const bf16* Bt, int G, int c, const Epi& E) {
    pg8::Gemm g{A, Bt, M, N};
    StaticOrderT<M, N> S; S.G = G; S.c = c;
    pg8::gemm_phase<Epi, StaticOrderT<M, N>, true, true, LDA, LDB, KDIM>(lds, g, S, E);
    __syncthreads();
}

template <int NR> DI void row_pass_n(const float* const (&src)[NR], const float* lg, const float* lb, float* const (&dstx)[NR], bf16* const (&dsth)[NR],
                                     const float* const (&sc)[NR], const float* const (&sh)[NR], float* const (&stat)[NR], bool has_stat, bool has_x, bool has_h, int lane) {
    f32x4 v[NR][4]; float s[NR];
#pragma unroll
    for (int r = 0; r < NR; ++r) { const f32x4* xr = (const f32x4*)src[r] + lane; s[r] = 0.f;
#pragma unroll
        for (int j = 0; j < 4; ++j) { v[r][j] = xr[64 * j]; } }
    if (lg) {
#pragma unroll
        for (int r = 0; r < NR; ++r)
#pragma unroll
            for (int j = 0; j < 4; ++j) s[r] += (v[r][j][0] + v[r][j][1]) + (v[r][j][2] + v[r][j][3]);
#pragma unroll
        for (int o = 1; o < 64; o <<= 1)
#pragma unroll
            for (int r = 0; r < NR; ++r) s[r] += shx(s[r], o);
        float s2[NR];
#pragma unroll
        for (int r = 0; r < NR; ++r) { const float mean = s[r] * (1.f / DM); s2[r] = 0.f;
#pragma unroll
            for (int j = 0; j < 4; ++j) { v[r][j] = v[r][j] - mean; s2[r] += (v[r][j][0] * v[r][j][0] + v[r][j][1] * v[r][j][1]) + (v[r][j][2] * v[r][j][2] + v[r][j][3] * v[r][j][3]); } }
#pragma unroll
        for (int o = 1; o < 64; o <<= 1)
#pragma unroll
            for (int r = 0; r < NR; ++r) s2[r] += shx(s2[r], o);
#pragma unroll
        for (int j = 0; j < 4; ++j) { const f32x4 gg = ((const f32x4*)lg)[lane + 64 * j], bb = ((const f32x4*)lb)[lane + 64 * j];
#pragma unroll
            for (int r = 0; r < NR; ++r) { const float rstd = rsqrtf(s2[r] * (1.f / DM) + LN_EPS); v[r][j] = v[r][j] * rstd * gg + bb; } }
        if (has_stat) {
#pragma unroll
            for (int r = 0; r < NR; ++r) if (lane == 0) { f32x2 st2; st2[0] = s[r] * (1.f / DM); st2[1] = rsqrtf(s2[r] * (1.f / DM) + LN_EPS); *(f32x2*)stat[r] = st2; }
        }
    }
    if (has_x) {
#pragma unroll
        for (int r = 0; r < NR; ++r)
#pragma unroll
            for (int j = 0; j < 4; ++j) ((f32x4*)dstx[r])[lane + 64 * j] = v[r][j];
    }
    if (has_h) {
#pragma unroll
        for (int r = 0; r < NR; ++r)
#pragma unroll
            for (int j = 0; j < 4; ++j) {
                const f32x4 a = ((const f32x4*)sc[r])[lane + 64 * j], d = ((const f32x4*)sh[r])[lane + 64 * j];
                const f32x4 h = v[r][j] * (a + 1.f) + d;
                u32x2 w; w.x = pk2(h[0], h[1]); w.y = pk2(h[2], h[3]);
                ((u32x2*)dsth[r])[lane + 64 * j] = w;
            }
    }
}
DI void rows_phase(const Params& p, int mode, int nrows, const float* lg, const float* lb, const float* modl, int sc_off, int sh_off, int gw, int ngw, int lane) {
    float* XRES = (float*)(wsp(p) + WS_XRES); bf16* HA = (bf16*)(wsp(p) + WS_HA); float* STA = (float*)(wsp(p) + WS_ST);
    constexpr int NR = 3;
    for (int row0 = gw; row0 < nrows; row0 += NR * ngw) {
        const float* src[NR]; float* dx[NR]; bf16* dh[NR]; const float* sc[NR]; const float* sh[NR]; float* stp[NR];
#pragma unroll
        for (int r = 0; r < NR; ++r) {
            int row = row0 + r * ngw; if (row >= nrows) row = row0;
            const int bidx = row < NLAT ? (row >> 11) : 8;
            src[r] = (mode == 0) ? (row < NLAT ? inp(p, 0) + (size_t)row * DM : inp(p, 2) + (size_t)(row - NLAT) * DM) : XRES + (size_t)row * DM;
            dx[r] = p.out + (size_t)(row < NLAT ? row : 0) * DM; dh[r] = HA + (size_t)row * DM; stp[r] = STA + 2 * row;
            sc[r] = modl + bidx * 6144 + sc_off; sh[r] = modl + bidx * 6144 + sh_off;
        }
        row_pass_n<NR>(src, lg, lb, dx, dh, sc, sh, stp, mode == 1, mode == 2, mode != 2, lane);
    }
}

template <class RM> DI void tr_item(const float* W, int ldsrc, int k0, int n0, bf16* dst, int lddst, int coloff, const float* kscale, RM rm, LAS float* scr, int lane) {
    {
        const int kq = lane >> 3, nq = lane & 7;
        f32x4 wv[8];
#pragma unroll
        for (int i = 0; i < 8; ++i) wv[i] = *(const f32x4*)(W + (size_t)(k0 + 8 * i + kq) * ldsrc + n0 + 4 * nq);
#pragma unroll
        for (int i = 0; i < 8; ++i) { const int kk = 8 * i + kq; f32x4 w = wv[i]; if (kscale) w = w * kscale[k0 + kk];
            LAS float* d = scr + kk * 33 + 4 * nq; d[0] = w[0]; d[1] = w[1]; d[2] = w[2]; d[3] = w[3]; }
    }
    LDS_WAIT(); asm volatile("" ::: "memory");
    const int c = lane & 7;
#pragma unroll
    for (int j = 0; j < 4; ++j) { const int n = (lane >> 3) + 8 * j; const LAS float* s = scr + (8 * c) * 33 + n;
        u32x4 o; o.x = pk2(s[0 * 33], s[1 * 33]); o.y = pk2(s[2 * 33], s[3 * 33]); o.z = pk2(s[4 * 33], s[5 * 33]); o.w = pk2(s[6 * 33], s[7 * 33]);
        *(u32x4*)(dst + (size_t)rm(n0 + n) * lddst + coloff + k0 + 8 * c) = o; }
    LDS_WAIT(); asm volatile("" ::: "memory");
}
struct RmId { int off; DI int operator()(int n) const { return n + off; } };
struct RmFfn { int off; DI int operator()(int n) const { return 256 * (n >> 7) + (n & 127) + off; } };

DI void zero_rect(bf16* dst, int ld, int row0, int nrows, int col0, int ncols, int gtid, int gthreads) {
    const int cpr = ncols >> 3, total = nrows * cpr; const unsigned zu = __float_as_uint(ozero());
    for (int e = gtid; e < total; e += gthreads) { const int r = e / cpr, cc = e - r * cpr; *(u32x4*)(dst + (size_t)(row0 + r) * ld + col0 + cc * 8) = (u32x4){zu, zu, zu, zu}; }
}

DI void phase_convert(const Params& p, int l, LAS unsigned char* lds, int gw, int ngw, int lane, int gtid, int gthreads) {
    unsigned char* ws = wsp(p);
    LAS float* scr = (LAS float*)(lds + (otid() >> 6) * 16384);
    bf16* Wtin = (bf16*)(ws + WS_WIN); bf16* Wtqk = (bf16*)(ws + WS_WQK); bf16* Wtv = (bf16*)(ws + WS_WV); bf16* Wtf = (bf16*)(ws + WS_WF);
    bf16* Wtout = (bf16*)(ws + WS_WOUT); bf16* Wt13 = (bf16*)(ws + WS_W13); bf16* Wt2 = (bf16*)(ws + WS_W2); bf16* Wtpool = (bf16*)(ws + WS_WPOOL); bf16* Wsb = (bf16*)(ws + WS_WS);
    const float* w_in = inp(p, 6) + (size_t)l * 1024 * 1440; const float* qn = inp(p, 7) + l * 256; const float* w_uq = inp(p, 8) + (size_t)l * 256 * 768;
    const float* kvn = inp(p, 9) + l * 128; const float* w_uk = inp(p, 10) + (size_t)l * 128 * 512; const float* w_uv = inp(p, 11) + (size_t)l * 128 * 512;
    const float* w_sp = inp(p, 14) + (size_t)l * 4 * 128 * 128; const float* w_pool = inp(p, 16) + (size_t)l * 4 * 64 * 64; const float* w_f = inp(p, 18) + (size_t)l * 256 * 256;
    const float* w_out = inp(p, 19) + (size_t)l * 1280 * 1024; const float* w1 = inp(p, 22) + (size_t)l * 1024 * DFF; const float* w3 = inp(p, 23) + (size_t)l * 1024 * DFF; const float* w2 = inp(p, 24) + (size_t)l * DFF * 1024;
    constexpr int I_IN = 16 * 45, I_UQ = 4 * 24, I_UK = 2 * 16, I_UV = 2 * 16, I_OUT = 20 * 32, I_F1 = 16 * 88, I_F3 = 16 * 88, I_F2 = 44 * 32, I_POOL = 8;
    constexpr int NITEMS = I_IN + I_UQ + I_UK + I_UV + I_OUT + I_F1 + I_F3 + I_F2 + I_POOL;
    for (int it = gw; it < NITEMS; it += ngw) {
        int r = it;
        if (r < I_IN) { tr_item(w_in, 1440, 64 * (r / 45), 32 * (r % 45), Wtin, 1024, 0, nullptr, RmId{0}, scr, lane); continue; } r -= I_IN;
        if (r < I_UQ) { tr_item(w_uq, 768, 64 * (r / 24), 32 * (r % 24), Wtqk, 384, 0, qn, RmId{0}, scr, lane); continue; } r -= I_UQ;
        if (r < I_UK) { tr_item(w_uk, 512, 64 * (r / 16), 32 * (r % 16), Wtqk, 384, 256, kvn, RmId{768}, scr, lane); continue; } r -= I_UK;
        if (r < I_UV) { tr_item(w_uv, 512, 64 * (r / 16), 32 * (r % 16), Wtv, 384, 256, kvn, RmId{0}, scr, lane); continue; } r -= I_UV;
        if (r < I_OUT) { tr_item(w_out, 1024, 64 * (r / 32), 32 * (r % 32), Wtout, 1280, 0, nullptr, RmId{0}, scr, lane); continue; } r -= I_OUT;
        if (r < I_F1) { tr_item(w1, DFF, 64 * (r / 88), 32 * (r % 88), Wt13, 1024, 0, nullptr, RmFfn{0}, scr, lane); continue; } r -= I_F1;
        if (r < I_F3) { tr_item(w3, DFF, 64 * (r / 88), 32 * (r % 88), Wt13, 1024, 0, nullptr, RmFfn{128}, scr, lane); continue; } r -= I_F3;
        if (r < I_F2) { tr_item(w2, 1024, 64 * (r / 32), 32 * (r % 32), Wt2, DFF, 0, nullptr, RmId{0}, scr, lane); continue; } r -= I_F2;
        { const int gi = r >> 1; tr_item(w_pool + gi * 4096, 64, 0, 32 * (r & 1), Wtpool + gi * 4096, 64, 0, nullptr, RmId{0}, scr, lane); }
    }
    zero_rect(Wtin, 1024, 1440, 96, 0, 1024, gtid, gthreads);
    zero_rect(Wtqk, 384, 0, 768, 256, 128, gtid, gthreads);
    zero_rect(Wtqk, 384, 768, 512, 0, 256, gtid, gthreads);
    zero_rect(Wtv, 384, 0, 512, 0, 256, gtid, gthreads);
    for (int e = gtid; e < 4 * 128 * 128 / 4; e += gthreads) { const f32x4 v = ((const f32x4*)w_sp)[e]; u32x2 w; w.x = pk2(v[0], v[1]); w.y = pk2(v[2], v[3]); ((u32x2*)Wsb)[e] = w; }
    for (int e = gtid; e < 256 * 256; e += gthreads) {
        const int n = e & 255, gc = e >> 8, g = gc >> 6, c = gc & 63;
        float sc_ = 0.f, ss_ = 0.f;
        for (int m = 0; m < 64; ++m) { const float w = w_f[(size_t)(g * 64 + m) * 256 + n]; const float a = (float)((m * c) & 63) * (1.f / 64.f); sc_ += cos_turn(a) * w; ss_ += sin_turn(a) * w; }
        Wtf[(size_t)n * 256 + gc] = (bf16)(pk2(sc_, 0.f) & 0xffffu); Wtf[(size_t)(256 + n) * 256 + gc] = (bf16)(pk2(-ss_, 0.f) & 0xffffu);
    }
}

DI void phase_prologue(const Params& p, LAS unsigned char* lds, int G, int bid) {
    const int tid = otid();
    LAS float* S = (LAS float*)lds;
    LAS float* red = (LAS float*)(lds + 40960);
    const float* cvec = inp(p, 1); const float* ccv = inp(p, 3); const float* w_mod = inp(p, 4); const float* b_mod = inp(p, 5);
    float* MOD = (float*)(wsp(p) + WS_MOD);
    for (int i = tid; i < 9 * 1024; i += 512) { const float v = i < 8192 ? cvec[i] : ccv[i - 8192]; S[i] = v * frcp(1.f + fexp2(-1.4426950408889634f * v)); }
    __syncthreads();
    for (int item = bid; item < 4 * 48; item += G) {
        const int l = item / 48, n0 = (item - l * 48) * 128, lane = tid & 63, ks = tid >> 6, kp = lane >> 5, c4 = (lane & 31) * 4;
        const float* W = w_mod + (size_t)l * 1024 * 6144 + n0 + c4;
        f32x4 acc[9];
#pragma unroll
        for (int r = 0; r < 9; ++r) acc[r] = (f32x4){0.f, 0.f, 0.f, 0.f};
#pragma unroll 16
        for (int i = 0; i < 64; ++i) {
            const int k = ks * 128 + 2 * i + kp;
            const f32x4 w = *(const f32x4*)(W + (size_t)k * 6144);
#pragma unroll
            for (int r = 0; r < 9; ++r) acc[r] = acc[r] + w * S[r * 1024 + k];
        }
        LAS float* rr = red + ((ks * 2 + kp) * 9) * 128 + c4;
#pragma unroll
        for (int r = 0; r < 9; ++r) { rr[r * 128 + 0] = acc[r][0]; rr[r * 128 + 1] = acc[r][1]; rr[r * 128 + 2] = acc[r][2]; rr[r * 128 + 3] = acc[r][3]; }
        __syncthreads();
        for (int o = tid; o < 9 * 128; o += 512) {
            const int r = o >> 7, jj = o & 127; float s = b_mod[l * 6144 + n0 + jj];
#pragma unroll
            for (int k2 = 0; k2 < 16; ++k2) s += red[k2 * 1152 + o];
            MOD[(size_t)(l * 9 + r) * 6144 + n0 + jj] = s;
        }
        __syncthreads();
    }
    const int gtid = bid * 512 + tid, gthreads = G * 512;
    bf16* CSL = (bf16*)(wsp(p) + WS_CSL); bf16* CSC = (bf16*)(wsp(p) + WS_CSC);
    for (int ch = gtid; ch < 1048576 + 16384; ch += gthreads) {
        float v[8];
        if (ch < 1048576) {
            const int k = ch >> 9, l0 = (ch & 511) * 8, half = l0 >> 11, lb = l0 & 2047; const float scale = 0.00276213586400995f;
#pragma unroll
            for (int j = 0; j < 8; ++j) { const float a = (float)((k * (lb + j)) & 2047) * (1.f / 2048.f); v[j] = (half ? sin_turn(a) : cos_turn(a)) * scale; }
            u32x4 w; w.x = pk2(v[0], v[1]); w.y = pk2(v[2], v[3]); w.z = pk2(v[4], v[5]); w.w = pk2(v[6], v[7]);
            *(u32x4*)(CSL + (size_t)k * 4096 + l0) = w;
        } else {
            const int c2 = ch - 1048576, k = c2 >> 6, l0 = (c2 & 63) * 8, half = l0 >> 8, lb = l0 & 255; const float scale = 1.f / 128.f;
#pragma unroll
            for (int j = 0; j < 8; ++j) { const float a = (float)((k * (lb + j)) & 255) * (1.f / 256.f); v[j] = (half ? sin_turn(a) : cos_turn(a)) * scale; }
            u32x4 w; w.x = pk2(v[0], v[1]); w.y = pk2(v[2], v[3]); w.z = pk2(v[4], v[5]); w.w = pk2(v[6], v[7]);
            *(u32x4*)(CSC + (size_t)k * 512 + l0) = w;
        }
    }
    float* ROPE = (float*)(wsp(p) + WS_ROPE);
    for (int e = gtid; e < 2048 * 16; e += gthreads) {
        const int pos = e >> 4, f = e & 15, axis = f >> 3, fi = f & 7;
        const float coord = (float)(axis ? (pos & 63) : (pos >> 6));
        const float inv = fexp2(-(float)fi * (13.287712379549449f / 8.f));
        const float ang = coord * inv * 0.15915494309189535f;
        ROPE[pos * 32 + f] = cos_turn(ang); ROPE[pos * 32 + 16 + f] = sin_turn(ang);
    }
}

DI f32x4 mfma16(bf16x8 a, bf16x8 b, f32x4 c) { return __builtin_amdgcn_mfma_f32_16x16x32_bf16(a, b, c, 0, 0, 0); }
DI f32x16 mfma32(bf16x8 a, bf16x8 b, f32x16 c) { return __builtin_amdgcn_mfma_f32_32x32x16_bf16(a, b, c, 0, 0, 0); }

DI void sgu_item(const Params& p, int l, int ci, int g, LAS unsigned char* lds) {
    const int tid = otid(), lane = tid & 63, w = tid >> 6;
    const bf16* proj = (const bf16*)(wsp(p) + WS_PROJ); bf16* mix = (bf16*)(wsp(p) + WS_MIX); const bf16* Wsb = (const bf16*)(wsp(p) + WS_WS);
    const float* gam = inp(p, 12) + l * 256; const float* bet = inp(p, 13) + l * 256; const float* bsp = inp(p, 15) + l * 512;
    constexpr int PITCH = 136;
    LAS bf16* vnT = (LAS bf16*)lds;
    const int r0 = ci * 128;
    const int fr = lane & 15, fq = lane >> 4, pp = 16 * w + fr, tok = r0 + pp;
    bf16x8 wfr[4]; u32x2 uu[4];
#pragma unroll
    for (int ks = 0; ks < 4; ++ks) wfr[ks] = *(const bf16x8*)(Wsb + (size_t)(g * 128 + pp) * 128 + ks * 32 + fq * 8);
#pragma unroll
    for (int ct = 0; ct < 4; ++ct) uu[ct] = *(const u32x2*)(proj + (size_t)tok * NPROJ + PO_SU + g * 64 + ct * 16 + fq * 4);
    const float bs = bsp[g * 128 + pp];
    {
        const int q = tid >> 2, j = tid & 3;
        const u32x4* src = (const u32x4*)(proj + (size_t)(r0 + q) * NPROJ + PO_SV + j * 64);
        float v[64]; float s = 0.f;
#pragma unroll
        for (int i = 0; i < 8; ++i) { const u32x4 x = src[i];
            v[8 * i + 0] = bflo(x.x); v[8 * i + 1] = bfhi(x.x); v[8 * i + 2] = bflo(x.y); v[8 * i + 3] = bfhi(x.y);
            v[8 * i + 4] = bflo(x.z); v[8 * i + 5] = bfhi(x.z); v[8 * i + 6] = bflo(x.w); v[8 * i + 7] = bfhi(x.w); }
#pragma unroll
        for (int i = 0; i < 64; ++i) s += v[i];
        s += shx(s, 1); s += shx(s, 2);
        const float mean = s * (1.f / 256.f); float s2 = 0.f;
#pragma unroll
        for (int i = 0; i < 64; ++i) { v[i] -= mean; s2 += v[i] * v[i]; }
        s2 += shx(s2, 1); s2 += shx(s2, 2);
        const float rstd = rsqrtf(s2 * (1.f / 256.f) + LN_EPS);
        if (j == g) {
#pragma unroll
            for (int c = 0; c < 64; ++c) { const float vn = v[c] * rstd * gam[g * 64 + c] + bet[g * 64 + c]; vnT[c * PITCH + q] = (bf16)(pk2(vn, 0.f) & 0xffffu); }
        }
    }
    __syncthreads();
    {
        f32x4 acc[4]; const float zf = ozero();
#pragma unroll
        for (int ct = 0; ct < 4; ++ct) acc[ct] = (f32x4){zf, zf, zf, zf};
#pragma unroll
        for (int ks = 0; ks < 4; ++ks) {
            const bf16x8 bfr = wfr[ks];
#pragma unroll
            for (int ct = 0; ct < 4; ++ct) { const bf16x8 afr = *(const LAS bf16x8*)(vnT + (ct * 16 + fr) * PITCH + ks * 32 + fq * 8); acc[ct] = mfma16(afr, bfr, acc[ct]); }
        }
#pragma unroll
        for (int ct = 0; ct < 4; ++ct) {
            const int c0 = g * 64 + ct * 16 + fq * 4;
            u32x2 o; o.x = pk2(bflo(uu[ct].x) * (acc[ct][0] + bs), bfhi(uu[ct].x) * (acc[ct][1] + bs)); o.y = pk2(bflo(uu[ct].y) * (acc[ct][2] + bs), bfhi(uu[ct].y) * (acc[ct][3] + bs));
            *(u32x2*)(mix + (size_t)tok * MIXD + 512 + c0) = o;
        }
    }
    __syncthreads();
}

DI void pool_item(const Params& p, int l, int ti, int gi, LAS unsigned char* lds) {
    const int tid = otid(), lane = tid & 63, w = tid >> 6;
    const bf16* proj = (const bf16*)(wsp(p) + WS_PROJ); bf16* mix = (bf16*)(wsp(p) + WS_MIX); const bf16* Wtp = (const bf16*)(wsp(p) + WS_WPOOL) + gi * 4096;
    const float* pscale = inp(p, 17) + l * 256 + gi * 64;
    LAS float* Pl = (LAS float*)lds;
    LAS bf16* Dl = (LAS bf16*)(lds + 40960);
    const int r0 = ti * 128, half = 1 << gi;
    int sb, se; if (r0 < NLAT) { sb = r0 & ~2047; se = sb + 2048; } else { sb = NLAT + ((r0 - NLAT) & ~255); se = sb + 256; }
    const unsigned zu = __float_as_uint(ozero());
    const int fr = lane & 15, fq = lane >> 4;
    bf16x8 wfr[2][4]; f32x4 psc[4];
#pragma unroll
    for (int ks = 0; ks < 2; ++ks)
#pragma unroll
        for (int nt = 0; nt < 4; ++nt) wfr[ks][nt] = *(const bf16x8*)(Wtp + (nt * 16 + fr) * 64 + ks * 32 + fq * 8);
#pragma unroll
    for (int nt = 0; nt < 4; ++nt) psc[nt] = *(const f32x4*)(pscale + nt * 16 + fq * 4);
    for (int e = tid; e < 144 * 8; e += 512) {
        const int rr = e >> 3, c8 = (e & 7) * 8, r = r0 - 8 + rr;
        u32x4 x = (u32x4){zu, zu, zu, zu};
        if (r >= sb && r < se) x = *(const u32x4*)(proj + (size_t)r * NPROJ + PO_POOL + gi * 64 + c8);
        LAS float* d = Pl + rr * 65 + c8;
        d[0] = bflo(x.x); d[1] = bfhi(x.x); d[2] = bflo(x.y); d[3] = bfhi(x.y); d[4] = bflo(x.z); d[5] = bfhi(x.z); d[6] = bflo(x.w); d[7] = bfhi(x.w);
    }
    __syncthreads();
    {
        const int c = tid & 63, t0 = (tid >> 6) * 16;
        float s = 0.f;
        for (int rr = t0 + 8 - half; rr < t0 + 8 + half; ++rr) s += Pl[rr * 65 + c];
        float add[15], sub[15], ctr[16];
#pragma unroll
        for (int i = 0; i < 15; ++i) { add[i] = Pl[(t0 + i + 8 + half) * 65 + c]; sub[i] = Pl[(t0 + i + 8 - half) * 65 + c]; }
#pragma unroll
        for (int i = 0; i < 16; ++i) ctr[i] = Pl[(t0 + i + 8) * 65 + c];
#pragma unroll
        for (int i = 0; i < 16; ++i) {
            const int r = r0 + t0 + i;
            const int lo = max(r - half, sb), hi = min(r + half, se);
            const float d = s * frcp((float)(hi - lo)) - ctr[i];
            Dl[(t0 + i) * 72 + c] = (bf16)(pk2(d, 0.f) & 0xffffu);
            if (i < 15) s += add[i] - sub[i];
        }
    }
    __syncthreads();
    {
        const int t = 16 * w + fr;
        f32x4 acc[4]; const float zf = ozero();
#pragma unroll
        for (int nt = 0; nt < 4; ++nt) acc[nt] = (f32x4){zf, zf, zf, zf};
#pragma unroll
        for (int ks = 0; ks < 2; ++ks) {
            const bf16x8 bfr = *(const LAS bf16x8*)(Dl + t * 72 + ks * 32 + fq * 8);
#pragma unroll
            for (int nt = 0; nt < 4; ++nt) acc[nt] = mfma16(wfr[ks][nt], bfr, acc[nt]);
        }
#pragma unroll
        for (int nt = 0; nt < 4; ++nt) {
            const int n0 = nt * 16 + fq * 4; const f32x4 sc = psc[nt];
            u32x2 o; o.x = pk2(acc[nt][0] * sc[0], acc[nt][1] * sc[1]); o.y = pk2(acc[nt][2] * sc[2], acc[nt][3] * sc[3]);
            *(u32x2*)(mix + (size_t)(r0 + t) * MIXD + 768 + gi * 64 + n0) = o;
        }
    }
    __syncthreads();
}

DI void krope_items(const Params& p, int gtid, int gthreads) {
    const bf16* proj = (const bf16*)(wsp(p) + WS_PROJ); bf16* Kb = (bf16*)(wsp(p) + WS_K); const float* rope = (const float*)(wsp(p) + WS_ROPE);
    for (int e = gtid; e < MTOK * 2; e += gthreads) {
        const int row = e >> 1, axis = e & 1;
        int b, pos; bool lat; row_info(row, b, pos, lat);
        const u32x4 x1 = *(const u32x4*)(proj + (size_t)row * NPROJ + PO_KR + axis * 16), x2 = *(const u32x4*)(proj + (size_t)row * NPROJ + PO_KR + axis * 16 + 8);
        u32x4 o1 = x1, o2 = x2;
        if (lat) {
            const float* rp = rope + pos * 32 + axis * 8;
            float a[8], c[8], cs[8], sn[8];
            a[0] = bflo(x1.x); a[1] = bfhi(x1.x); a[2] = bflo(x1.y); a[3] = bfhi(x1.y); a[4] = bflo(x1.z); a[5] = bfhi(x1.z); a[6] = bflo(x1.w); a[7] = bfhi(x1.w);
            c[0] = bflo(x2.x); c[1] = bfhi(x2.x); c[2] = bflo(x2.y); c[3] = bfhi(x2.y); c[4] = bflo(x2.z); c[5] = bfhi(x2.z); c[6] = bflo(x2.w); c[7] = bfhi(x2.w);
#pragma unroll
            for (int j = 0; j < 8; ++j) { cs[j] = rp[j]; sn[j] = rp[16 + j]; }
            float y1[8], y2[8];
#pragma unroll
            for (int j = 0; j < 8; ++j) { y1[j] = a[j] * cs[j] - c[j] * sn[j]; y2[j] = a[j] * sn[j] + c[j] * cs[j]; }
            o1.x = pk2(y1[0], y1[1]); o1.y = pk2(y1[2], y1[3]); o1.z = pk2(y1[4], y1[5]); o1.w = pk2(y1[6], y1[7]);
            o2.x = pk2(y2[0], y2[1]); o2.y = pk2(y2[2], y2[3]); o2.z = pk2(y2[4], y2[5]); o2.w = pk2(y2[6], y2[7]);
        }
        const int key = lat ? CTXL + pos : pos;
#pragma unroll
        for (int h = 0; h < 8; ++h) { bf16* dst = Kb + ((size_t)(b * 8 + h) * NKEY + key) * 96 + 64 + axis * 16; *(u32x4*)dst = o1; *(u32x4*)(dst + 8) = o2; }
    }
}

DI int swap23(int r) { return (r & ~12) | ((r & 4) << 1) | ((r & 8) >> 1); }
DI void attn_item(const bf16* Qp, const bf16* Kp, const bf16* Vtp, int nkeys, bf16* outp  , LAS unsigned char* lds) {
    const int tid = otid(), lane = tid & 63, w = tid >> 6, r = lane & 31, hh = lane >> 5, gk = w >> 2, wq = w & 3;
    constexpr int KP = 208, VP = 144, KT = 64 * KP, VT = 64 * VP;
    LAS unsigned char* Kl = lds; LAS unsigned char* Vl = lds + 4 * KT;
    bf16x8 qf[6];
#pragma unroll
    for (int kk = 0; kk < 6; ++kk) qf[kk] = *(const bf16x8*)(Qp + (size_t)(32 * wq + r) * 96 + kk * 16 + hh * 8);
    const float zf = ozero();
    f32x16 o0, o1;
#pragma unroll
    for (int i = 0; i < 16; ++i) { o0[i] = zf; o1[i] = zf; }
    float mrun = -60.f, lrun = zf;
    unsigned kg[3], kl[3], vg[2], vl[2];
#pragma unroll
    for (int i = 0; i < 3; ++i) { const int c = tid + 512 * i, tile = c / 768, cc = c - tile * 768, row = cc / 12, col = cc - row * 12;
        kg[i] = (unsigned)((tile * 64 + row) * 96 + col * 8); kl[i] = (unsigned)(tile * KT + swap23(row) * KP + col * 16); }
#pragma unroll
    for (int i = 0; i < 2; ++i) { const int c = tid + 512 * i, tile = c >> 9, cc = c & 511, dv = cc >> 3, col = cc & 7;
        vg[i] = (unsigned)(dv * NKEY + tile * 64 + col * 8); vl[i] = (unsigned)(tile * VT + dv * VP + col * 16); }
    const int npairs = nkeys >> 7;
    u32x4 sk[3], sv[2];
#pragma unroll
    for (int i = 0; i < 3; ++i) sk[i] = *(const u32x4*)(Kp + kg[i]);
#pragma unroll
    for (int i = 0; i < 2; ++i) sv[i] = *(const u32x4*)(Vtp + vg[i]);
#pragma unroll
    for (int i = 0; i < 3; ++i) *(LAS u32x4*)(Kl + kl[i]) = sk[i];
#pragma unroll
    for (int i = 0; i < 2; ++i) *(LAS u32x4*)(Vl + vl[i]) = sv[i];
    __syncthreads();
    for (int kp = 0; kp < npairs; ++kp) {
        const int cur = kp & 1;
        if (kp + 1 < npairs) {
            const bf16* kgp = Kp + (size_t)(kp + 1) * 128 * 96; const bf16* vgp = Vtp + (kp + 1) * 128;
#pragma unroll
            for (int i = 0; i < 3; ++i) sk[i] = *(const u32x4*)(kgp + kg[i]);
#pragma unroll
            for (int i = 0; i < 2; ++i) sv[i] = *(const u32x4*)(vgp + vg[i]);
        }
        const LAS unsigned char* kb = Kl + (cur * 2 + gk) * KT; const LAS unsigned char* vb = Vl + (cur * 2 + gk) * VT;
        f32x16 s0, s1; const float negm = -mrun;
#pragma unroll
        for (int i = 0; i < 16; ++i) { s0[i] = negm; s1[i] = negm; }
#pragma unroll
        for (int kk = 0; kk < 6; ++kk) {
            const bf16x8 ka0 = *(const LAS bf16x8*)(kb + r * KP + kk * 32 + hh * 16);
            const bf16x8 ka1 = *(const LAS bf16x8*)(kb + (32 + r) * KP + kk * 32 + hh * 16);
            s0 = mfma32(ka0, qf[kk], s0); s1 = mfma32(ka1, qf[kk], s1);
        }
        float mx = s0[0];
#pragma unroll
        for (int i = 1; i < 16; ++i) mx = fmaxf(mx, s0[i]);
#pragma unroll
        for (int i = 0; i < 16; ++i) mx = fmaxf(mx, s1[i]);
        if (__builtin_amdgcn_ballot_w64(mx > 6.f) != 0ull) {
            mx = fmaxf(mx, shx(mx, 32));
            const float dm = fmaxf(mx, 0.f), alpha = fexp2(-dm);
            mrun += dm; lrun *= alpha;
#pragma unroll
            for (int i = 0; i < 16; ++i) { s0[i] -= dm; s1[i] -= dm; o0[i] *= alpha; o1[i] *= alpha; }
        }
        float ls = 0.f;
#pragma unroll
        for (int i = 0; i < 16; ++i) { s0[i] = fexp2(s0[i]); s1[i] = fexp2(s1[i]); ls += s0[i] + s1[i]; }
        lrun += ls;
        bf16x8 pf[2][2];
#pragma unroll
        for (int s2 = 0; s2 < 2; ++s2) {
            u32x4 a, b2;
            a.x = pk2(s0[8 * s2 + 0], s0[8 * s2 + 1]); a.y = pk2(s0[8 * s2 + 2], s0[8 * s2 + 3]); a.z = pk2(s0[8 * s2 + 4], s0[8 * s2 + 5]); a.w = pk2(s0[8 * s2 + 6], s0[8 * s2 + 7]);
            b2.x = pk2(s1[8 * s2 + 0], s1[8 * s2 + 1]); b2.y = pk2(s1[8 * s2 + 2], s1[8 * s2 + 3]); b2.z = pk2(s1[8 * s2 + 4], s1[8 * s2 + 5]); b2.w = pk2(s1[8 * s2 + 6], s1[8 * s2 + 7]);
            pf[0][s2] = __builtin_bit_cast(bf16x8, a); pf[1][s2] = __builtin_bit_cast(bf16x8, b2);
        }
#pragma unroll
        for (int d = 0; d < 2; ++d)
#pragma unroll
            for (int s2 = 0; s2 < 2; ++s2) {
                const bf16x8 v0 = *(const LAS bf16x8*)(vb + r * VP + (d * 32 + s2 * 16 + hh * 8) * 2);
                const bf16x8 v1 = *(const LAS bf16x8*)(vb + (32 + r) * VP + (d * 32 + s2 * 16 + hh * 8) * 2);
                o0 = mfma32(v0, pf[d][s2], o0); o1 = mfma32(v1, pf[d][s2], o1);
            }
        if (kp + 1 < npairs) {
            LAS unsigned char* kn = Kl + (cur ^ 1) * 2 * KT; LAS unsigned char* vn = Vl + (cur ^ 1) * 2 * VT;
#pragma unroll
            for (int i = 0; i < 3; ++i) *(LAS u32x4*)(kn + kl[i]) = sk[i];
#pragma unroll
            for (int i = 0; i < 2; ++i) *(LAS u32x4*)(vn + vl[i]) = sv[i];
        }
        __syncthreads();
    }
    lrun += shx(lrun, 32);
    LAS float* mg = (LAS float*)lds + wq * (34 * 64) + lane;
    if (gk == 1) {
#pragma unroll
        for (int i = 0; i < 16; ++i) { mg[i * 64] = o0[i]; mg[(16 + i) * 64] = o1[i]; }
        mg[32 * 64] = mrun; mg[33 * 64] = lrun;
    }
    __syncthreads();
    if (gk == 0) {
        const float m1 = mg[32 * 64], l1 = mg[33 * 64];
        const float m = fmaxf(mrun, m1), a0 = fexp2(mrun - m), a1 = fexp2(m1 - m);
        const float inv = frcp(lrun * a0 + l1 * a1), c0 = a0 * inv, c1 = a1 * inv;
        bf16* orow = outp + (size_t)(32 * wq + r) * MIXD;
#pragma unroll
        for (int i4 = 0; i4 < 4; ++i4) {
            u32x2 a, b2;
            a.x = pk2(o0[4 * i4] * c0 + mg[(4 * i4) * 64] * c1, o0[4 * i4 + 1] * c0 + mg[(4 * i4 + 1) * 64] * c1);
            a.y = pk2(o0[4 * i4 + 2] * c0 + mg[(4 * i4 + 2) * 64] * c1, o0[4 * i4 + 3] * c0 + mg[(4 * i4 + 3) * 64] * c1);
            b2.x = pk2(o1[4 * i4] * c0 + mg[(16 + 4 * i4) * 64] * c1, o1[4 * i4 + 1] * c0 + mg[(16 + 4 * i4 + 1) * 64] * c1);
            b2.y = pk2(o1[4 * i4 + 2] * c0 + mg[(16 + 4 * i4 + 2) * 64] * c1, o1[4 * i4 + 3] * c0 + mg[(16 + 4 * i4 + 3) * 64] * c1);
            *(u32x2*)(orow + 8 * i4 + 4 * hh) = a; *(u32x2*)(orow + 32 + 8 * i4 + 4 * hh) = b2;
        }
    }
    __syncthreads();
}

DI void attn_any(const Params& p, int item, LAS unsigned char* lds) {
    unsigned char* ws = wsp(p);
    const bool isl = item < 1024;
    const int bh = isl ? (item >> 4) : ((item - 1024) >> 1), qb = isl ? (item & 15) : ((item - 1024) & 1), b = bh >> 3, h = bh & 7;
    const bf16* Qp = isl ? (const bf16*)(ws + WS_QLAT) + ((size_t)bh * SEQ + qb * 128) * 96 : (const bf16*)(ws + WS_QCTX) + ((size_t)bh * CTXL + qb * 128) * 96;
    const bf16* Kp = (const bf16*)(ws + WS_K) + (size_t)bh * NKEY * 96;
    const bf16* Vtp = (const bf16*)(ws + WS_VT) + (size_t)bh * 64 * NKEY;
    bf16* outp = (bf16*)(ws + WS_MIX) + (size_t)(isl ? (b * SEQ + qb * 128) : (NLAT + b * CTXL + qb * 128)) * MIXD + h * 64;
    attn_item(Qp, Kp, Vtp, isl ? NKEY : CTXL, outp, lds);
    if (!isl) publish_block((unsigned*)(ws + WS_CTL) + CW_ECTX);
}

#ifndef PROBE_REP_SUB
#define PROBE_REP_SUB -1
#endif
#ifndef PROBE_SYNCS
#define PROBE_SYNCS 0
#endif
constexpr int NSUB = 13 + (PROBE_REP_SUB >= 0 ? 1 : 0), NSTEP = 2 + NSUB * DEPTH;
__global__ void __launch_bounds__(512, 2) mk_fwd(Params p) {
    extern __shared__ __attribute__((aligned(16))) unsigned char lds_raw[];
    LAS unsigned char* lds = (LAS unsigned char*)lds_raw;
    cg::grid_group grid = cg::this_grid();
    volatile LAS unsigned* MISC = (volatile LAS unsigned*)(lds + MISC_OFF);
    if (threadIdx.x < 4) MISC[threadIdx.x] = 0u;
    __syncthreads();
    (void)xcd_barrier_post((unsigned*)(p.ws + WS_CTL), MISC);
    if (p.in[1] == nullptr) grid.sync();
    int st0 = p.ph_lo; asm volatile("" : "+s"(st0));
    for (int st = st0; ; st = __builtin_amdgcn_readfirstlane(st + 1)) {
        int ph_hi = p.ph_hi, ph_lo = p.ph_lo; asm volatile("" : "+s"(ph_hi), "+s"(ph_lo));
        if (st >= ph_hi) break;
        int G = gridDim.x, bid = blockIdx.x; asm volatile("" : "+s"(G), "+s"(bid));
        const int vcu = (G % 8 == 0) ? (bid % 8) * (G / 8) + bid / 8 : bid;
        const int ngw = G * 8, gthreads = G * 512;
        const int l = (st - 1) / NSUB, subx = (st - 1) - l * NSUB, sub = (st == 0) ? 100 : (st == NSTEP - 1) ? 101 : ((PROBE_REP_SUB >= 0 && subx > PROBE_REP_SUB) ? subx - 1 : subx);
        const bool need_sync = !(sub == 3 || sub == 4 || sub == 5 || sub == 7 || sub == 8 || sub == 100 || ((sub == 10 || sub == 101) && gridDim.x == 256));
        if (st > ph_lo && need_sync) { XcdBarrier xb2; xb2.bar = (unsigned*)(wsp(p) + WS_CTL); xb2.x = xb_xcc_id(); xb2.st = (volatile LAS unsigned*)(lds + MISC_OFF); xcd_barrier(xb2); }
        unsigned char* ws = wsp(p);
        float* XRES = (float*)(ws + WS_XRES); bf16* HA = (bf16*)(ws + WS_HA); bf16* PROJ = (bf16*)(ws + WS_PROJ);
        bf16* MIX = (bf16*)(ws + WS_MIX); bf16* U = (bf16*)(ws + WS_U);
        const float* MOD = (const float*)(ws + WS_MOD);
        float* STQ = (float*)(ws + WS_STQ); float* STKV = (float*)(ws + WS_STKV);
        const bool last = (l == DEPTH - 1);
        const int Mtail = last ? NLAT : MTOK;
        const float* modl = MOD + (size_t)l * 9 * 6144;

        switch (sub) {
        case 100: phase_prologue(p, lds, G, bid); break;
        case 101: {
            const int tid = otid(), lane = tid & 63, gw = bid * 8 + (tid >> 6), gtid = bid * 512 + tid; (void)lane; (void)gw; (void)gtid;
            if (G != 256) rows_phase(p, 2, NLAT, inp(p, 25) + (DEPTH - 1) * DM, inp(p, 26) + (DEPTH - 1) * DM, modl, 0, 0, gw, ngw, lane);
        } break;
        case 0: {
            const int tid = otid(), lane = tid & 63, gw = bid * 8 + (tid >> 6), gtid = bid * 512 + tid; (void)lane; (void)gw; (void)gtid;
            const float* lg = (l == 0) ? nullptr : inp(p, 25) + (l - 1) * DM; const float* lb = (l == 0) ? nullptr : inp(p, 26) + (l - 1) * DM;
            if (l == 0 || G != 256) rows_phase(p, l == 0 ? 0 : 1, MTOK, lg, lb, modl, 1024, 0, gw, ngw, lane);
            phase_convert(p, l, lds, gw, ngw, lane, gtid, gthreads);
        } break;
        case 1: {
            EpiProj E{PROJ, STQ, STKV};
            run_gemm<DM, DM, DM, MTOK, NPROJ>(lds, HA, (const bf16*)(ws + WS_WIN), G, bid, E);
        } break;
        case 2: {
            EpiQK E{(bf16*)(ws + WS_QLAT), (bf16*)(ws + WS_QCTX), (bf16*)(ws + WS_K), STQ, STKV, (const float*)(ws + WS_ROPE)};
            run_gemm<NPROJ, 384, 384, MTOK, 1280>(lds, PROJ, (const bf16*)(ws + WS_WQK), G, bid, E);
        } break;
        case 3: {
            EpiVt E{(bf16*)(ws + WS_VT), STKV};
            run_gemm<384, NPROJ, 384, 512, MTOK>(lds, (const bf16*)(ws + WS_WV), PROJ, G, (bid + G - 104) % G, E);
        } break;
        case 4: {
            EpiGt E{(bf16*)(ws + WS_GTL), (bf16*)(ws + WS_GTC)};
            run_gemm<256, NPROJ, 256, 512, MTOK>(lds, (const bf16*)(ws + WS_WF), PROJ + PO_F, G, (bid + G - 104) % G, E);
        } break;
        case 5: {
            const int tid = otid(), lane = tid & 63, gw = bid * 8 + (tid >> 6), gtid = bid * 512 + tid; (void)lane; (void)gw; (void)gtid;
            int first, cnt;
            if (G == 256) { if (bid < 104) { first = bid * 5; cnt = 5; } else if (bid < 248) { first = 520 + (bid - 104) * 4; cnt = 4; } else { first = 1096 + (bid - 248) * 7; cnt = 7; } }
            else { first = bid; cnt = (1152 - bid + G - 1) / G; }
            for (int k = 0; k < cnt; ++k) { const int it = (G == 256) ? first + k : first + k * G;
                if (it < 576) sgu_item(p, l, it >> 2, it & 3, lds); else pool_item(p, l, (it - 576) >> 2, (it - 576) & 3, lds); }
            krope_items(p, gtid, gthreads);
        } break;
        case 6: {
            EpiDft E{MIX, 0, SEQ};
            run_gemm<4096, 4096, 4096, 2048, 2048>(lds, (const bf16*)(ws + WS_CSL), (const bf16*)(ws + WS_GTL), G, vcu, E);
        } break;
        case 7: {
            if (!last) { EpiDft E{MIX, NLAT, CTXL};
              StaticOrderSig<256, 2048> S{G, (vcu + G - 64) % G, (unsigned*)(ws + WS_CTL) + CW_ECTX};
              run_gemm_s<512, 512, 512>(lds, (const bf16*)(ws + WS_CSC), (const bf16*)(ws + WS_GTC), 256, 2048, S, E); }
        } break;
        case 8: {
            if (G == 256) {
                int first, cnt, citem = -1;
                if (vcu < 64) { first = 2 * vcu; cnt = 2; } else if (vcu < 72) { first = 128 + 5 * (vcu - 64); cnt = 5; }
                else if (vcu < 104) { first = 168 + 3 * (vcu - 72); cnt = 3; } else { first = 264 + 5 * (vcu - 104); cnt = 5; if (!last && vcu < 232) citem = 1024 + (vcu - 104); }
                if (citem >= 0) attn_any(p, citem, lds);
                for (int k = 0; k < cnt; ++k) attn_any(p, first + k, lds);
                if (!last) {
                    SchedHC S{vcu + 152, (unsigned*)(ws + WS_CTL) + CW_ECTX, 136u * (unsigned)(l + 1)};
                    EpiResLN E2{p, l, 0, 1, last, lds};
                    run_gemm_s<MIXD, MIXD, MIXD>(lds, MIX + (size_t)NLAT * MIXD, (const bf16*)(ws + WS_WOUT), NCTX, DM, S, E2);
                }
            } else {
                for (int it = vcu; it < (last ? 1024 : 1152); it += G) attn_any(p, it, lds);
            }
        } break;
        case 9: {
            if (G == 256) {
                EpiResLN E{p, l, 0, 0, last, lds};
                run_gemm<MIXD, MIXD, MIXD, NLAT, DM>(lds, MIX, (const bf16*)(ws + WS_WOUT), G, bid, E);
            } else {
                EpiRes E{(l == 0) ? inp(p, 0) : XRES, XRES, (const float*)(ws + WS_ST), (l == 0) ? nullptr : inp(p, 25) + (l - 1) * DM, (l == 0) ? nullptr : inp(p, 26) + (l - 1) * DM, modl, 2048, 0};
                if (last) run_gemm<MIXD, MIXD, MIXD, NLAT, DM>(lds, MIX, (const bf16*)(ws + WS_WOUT), G, bid, E);
                else run_gemm<MIXD, MIXD, MIXD, MTOK, DM>(lds, MIX, (const bf16*)(ws + WS_WOUT), G, bid, E);
            }
        } break;
        case 10: {
            const int tid = otid(), lane = tid & 63, gw = bid * 8 + (tid >> 6), gtid = bid * 512 + tid; (void)lane; (void)gw; (void)gtid;
            if (G != 256) rows_phase(p, 1, Mtail, inp(p, 20) + l * DM, inp(p, 21) + l * DM, modl, 4096, 3072, gw, ngw, lane);
        } break;
        case 11: {
            EpiSwiglu E{U};
            if (last || G != 256) {
                if (last) run_gemm<DM, DM, DM, NLAT, 2 * DFF>(lds, HA, (const bf16*)(ws + WS_W13), G, bid, E);
                else run_gemm<DM, DM, DM, MTOK, 2 * DFF>(lds, HA, (const bf16*)(ws + WS_W13), G, bid, E);
            } else {
                unsigned* cnt = (unsigned*)(ws + WS_CTL) + CW_GCTX;
                { SchedG S{bid, cnt}; run_gemm_s<DM, DM, DM>(lds, HA, (const bf16*)(ws + WS_W13), MTOK, 2 * DFF, S, E); }
                { SchedHC S{bid, cnt, 176u * (unsigned)(l + 1)}; EpiResLN E2{p, l, 1, 1, last, lds};
                  run_gemm_s<DFF, DFF, DFF>(lds, U + (size_t)NLAT * DFF, (const bf16*)(ws + WS_W2), NCTX, DM, S, E2); }
            }
        } break;
        case 12: {
            if (G == 256) {
                EpiResLN E{p, l, 1, 0, last, lds};
                run_gemm<DFF, DFF, DFF, NLAT, DM>(lds, U, (const bf16*)(ws + WS_W2), G, bid, E);
            } else {
                EpiRes E{XRES, XRES, (const float*)(ws + WS_ST), inp(p, 20) + l * DM, inp(p, 21) + l * DM, modl, 5120, 0};
                if (last) run_gemm<DFF, DFF, DFF, NLAT, DM>(lds, U, (const bf16*)(ws + WS_W2), G, bid, E);
                else run_gemm<DFF, DFF, DFF, MTOK, DM>(lds, U, (const bf16*)(ws + WS_W2), G, bid, E);
            }
        } break;
        }
        __syncthreads();
    }
}

#ifndef MK_SPLIT
#define MK_SPLIT 0
#endif
extern "C" void kernel_launch(void* const* d_in, const int* in_sizes, int n_in, void* d_out, int out_size, void* d_ws, size_t ws_size, hipStream_t stream) {
    static int grid = 0;
    if (grid == 0) {
        if (n_in != 27 || out_size != NLAT * DM || ws_size < WS_END) { fprintf(stderr, "kernel_launch: unexpected shapes / workspace (%d inputs, out %d, ws %zu < %zu)\n", n_in, out_size, ws_size, (size_t)WS_END); grid = -1; return; }
        int dev = 0, cus = 0, per_cu = 0;
        hipGetDevice(&dev);
        hipDeviceGetAttribute(&cus, hipDeviceAttributeMultiprocessorCount, dev);
        hipFuncSetAttribute((const void*)mk_fwd, hipFuncAttributeMaxDynamicSharedMemorySize, LDS_BYTES);
        hipOccupancyMaxActiveBlocksPerMultiprocessor(&per_cu, (const void*)mk_fwd, 512, LDS_BYTES);
        if (per_cu < 1) { fprintf(stderr, "kernel_launch: occupancy query reports %d blocks per CU\n", per_cu); per_cu = 1; }
        grid = cus >= 256 ? 256 : cus;
        (void)hipGetLastError();
    }
    if (grid < 0) return;
    if (hipMemsetAsync((char*)d_ws + WS_CTL, 0, CTL_BYTES, stream) != hipSuccess) { fprintf(stderr, "kernel_launch: memset failed\n"); return; }
    Params p{};
    for (int i = 0; i < 27; ++i) p.in[i] = (const float*)d_in[i];
    p.out = (float*)d_out; p.ws = (unsigned char*)d_ws;
#if MK_SPLIT
    for (int ph = 0; ph < NSTEP; ++ph) {
        p.ph_lo = ph; p.ph_hi = ph + 1;
        void* args[] = {&p};
        hipError_t e = hipLaunchCooperativeKernel((const void*)mk_fwd, dim3(grid), dim3(512), args, LDS_BYTES, stream);
        if (e != hipSuccess) { fprintf(stderr, "cooperative launch failed: %s\n", hipGetErrorString(e)); return; }
    }
#else
    p.ph_lo = 0; p.ph_hi = NSTEP;
    void* args[] = {&p};
    hipError_t e = hipLaunchCooperativeKernel((const void*)mk_fwd, dim3(grid), dim3(512), args, LDS_BYTES, stream);
    if (e != hipSuccess) fprintf(stderr, "cooperative launch failed: %s (grid %d)\n", hipGetErrorString(e), grid);
#endif
}
```
